# Optimizing an MI355X kernel written in HIP

```python
import jax, jax.numpy as jnp
from jax import lax
import numpy as np

D_MODEL = 2048
BATCH = 2
SEQ = 4096
DEPTH = 2

GRID_W = 64
CTX_LEN = 256
BRANCH = 1024
N_BRANCH = 3
EPS = 1e-6

RW_HEADS = 16
RW_HD = 64
RW_LORA = 64
RW_GN_EPS = 64e-5
RW_SHIFT = 3 * BRANCH + 4 * RW_LORA

AT_HEADS = 8
AT_KV = 2
AT_HD = 128
Q_BLOCK = 128
ROPE_THETA = 10000.0

ML_HEADS = 4
ML_DK = 128
ML_DV = 256
ML_CHUNK = 128
GATE_CAP = 15.0

IN_SIZES = (RW_SHIFT, BRANCH,
            AT_HEADS * AT_HD, AT_KV * AT_HD, AT_KV * AT_HD, BRANCH,
            ML_HEADS * ML_DK, ML_HEADS * ML_DK, ML_HEADS * ML_DV, BRANCH, 4 * ML_HEADS, BRANCH,
            N_BRANCH * D_MODEL)
D_IN = sum(IN_SIZES)

kernel_name = "hybrid_rwkv7_gqa_mlstm_prefix_dit_block"


def rms_norm(x, g):
    xf = x.astype(jnp.float32)
    y = xf * lax.rsqrt(jnp.mean(xf * xf, axis=-1, keepdims=True) + EPS)
    return (y * g.astype(jnp.float32)).astype(x.dtype)


def segment_neighbours(u, n_ctx):
    L = u.shape[1]
    pos = jnp.arange(L)
    zero = jnp.zeros((), u.dtype)
    prev = jnp.pad(u[:, :-1], ((0, 0), (1, 0), (0, 0)))
    nxt = jnp.pad(u[:, 1:], ((0, 0), (0, 1), (0, 0)))
    prev = jnp.where((pos == n_ctx)[None, :, None], zero, prev)
    nxt = jnp.where((pos == n_ctx - 1)[None, :, None], zero, nxt)
    return prev, nxt


def axial_rope(x, cos, sin):
    shp = x.shape
    q = AT_HD // 4
    xs = x.reshape(*shp[:-1], 2, 2, q)
    x1, x2 = xs[..., 0, :], xs[..., 1, :]
    expand = (1,) * (x.ndim - 3)
    c = cos.reshape(cos.shape[0], *expand, 2, q).astype(x.dtype)
    s = sin.reshape(sin.shape[0], *expand, 2, q).astype(x.dtype)
    return jnp.stack([x1 * c - x2 * s, x1 * s + x2 * c], axis=-2).reshape(shp)


def rwkv7_scan(r, w, a, b, k, v):
    Bsz, L, H, N = r.shape

    def step(S, inp):
        r_t, w_t, a_t, b_t, k_t, v_t = inp
        sa = jnp.einsum('bhvk,bhk->bhv', S, a_t)
        S = S * w_t[:, :, None, :] + sa[..., None] * b_t[:, :, None, :] + v_t[..., None] * k_t[:, :, None, :]
        return S, jnp.einsum('bhvk,bhk->bhv', S, r_t)

    S0 = jnp.zeros((Bsz, H, N, N), jnp.float32)
    xs = tuple(jnp.swapaxes(t, 0, 1) for t in (r, w, a, b, k, v))
    _, y = lax.scan(step, S0, xs)
    return jnp.swapaxes(y, 0, 1)


def rwkv7_branch(xr, xk, xv, xwd, xad, w_up, w0, a_up, a0, k_k, k_a, r_k, ln_w, ln_b, bwd):
    f32 = jnp.float32
    Bsz, L, _ = xr.shape
    heads = lambda t: t.astype(f32).reshape(Bsz, L, RW_HEADS, RW_HD)
    r, k, v = heads(xr), heads(xk), heads(xv)
    kk = k * k_k.astype(f32).reshape(RW_HEADS, RW_HD)
    kk = kk / jnp.maximum(jnp.linalg.norm(kk, axis=-1, keepdims=True), 1e-12)
    k_a = k_a.astype(f32).reshape(RW_HEADS, RW_HD)
    outs = []
    for d, order in ((0, None), (1, bwd)):
        wd = xwd[..., d * RW_LORA:(d + 1) * RW_LORA].astype(f32)
        ad = xad[..., d * RW_LORA:(d + 1) * RW_LORA].astype(f32)
        w_log = -jax.nn.softplus(-(w0[d].astype(f32) + jnp.tanh(wd) @ w_up[d].astype(f32))) - 0.5
        decay = heads(jnp.exp(-jnp.exp(w_log)))
        a = heads(jax.nn.sigmoid(a0[d].astype(f32) + ad @ a_up[d].astype(f32)))
        kd = k * (1.0 + (a - 1.0) * k_a)
        seqs = (r, decay, -kk, kk * a, kd, v)
        if order is not None:
            seqs = tuple(jnp.take(t, order, axis=1) for t in seqs)
        y_d = rwkv7_scan(*seqs)
        if order is not None:
            y_d = jnp.take(y_d, order, axis=1)
        outs.append(y_d)
    y = outs[0] + outs[1]
    mu = jnp.mean(y, axis=-1, keepdims=True)
    var = jnp.mean(jnp.square(y - mu), axis=-1, keepdims=True)
    y = (y - mu) * lax.rsqrt(var + RW_GN_EPS) * ln_w.astype(f32).reshape(RW_HEADS, RW_HD) \
        + ln_b.astype(f32).reshape(RW_HEADS, RW_HD)
    bonus = jnp.sum(r * k * r_k.astype(f32), axis=-1, keepdims=True) * v
    return (y + bonus).reshape(Bsz, L, BRANCH)


def gqa_branch(q, k, v, q_g, k_g, cos, sin, n_ctx):
    Bsz, L, _ = q.shape
    grp = AT_HEADS // AT_KV
    q = rms_norm(q.reshape(Bsz, L, AT_KV, grp, AT_HD), q_g)
    k = rms_norm(k.reshape(Bsz, L, AT_KV, AT_HD), k_g)
    v = v.reshape(Bsz, L, AT_KV, AT_HD)
    q = axial_rope(q, cos, sin) * (AT_HD ** -0.5)
    k = axial_rope(k, cos, sin)

    def attend(qb, keys, vals):
        s = jnp.einsum('bqgrd,bkgd->bgrqk', qb, keys).astype(jnp.float32)
        p = jax.nn.softmax(s, axis=-1).astype(vals.dtype)
        return jnp.einsum('bgrqk,bkgd->bqgrd', p, vals)

    out_c = attend(q[:, :n_ctx], k[:, :n_ctx], v[:, :n_ctx]).reshape(Bsz, n_ctx, BRANCH)
    n_lat = L - n_ctx
    nb = n_lat // Q_BLOCK
    ql = q[:, n_ctx:].reshape(Bsz, nb, Q_BLOCK, AT_KV, grp, AT_HD)
    ql = jnp.moveaxis(ql, 1, 0)
    out_l = lax.map(lambda blk: attend(blk, k, v), ql)
    out_l = jnp.moveaxis(out_l, 0, 1).reshape(Bsz, n_lat, BRANCH)
    return jnp.concatenate([out_c, out_l], axis=1)


def mlstm_chunk_scan(q, k, v, logi, logf):
    Bsz, H, L, _ = q.shape
    nc = L // ML_CHUNK
    chunks = lambda t: jnp.moveaxis(t.reshape(Bsz, H, nc, ML_CHUNK, *t.shape[3:]), 2, 0)
    tri = jnp.tril(jnp.ones((ML_CHUNK, ML_CHUNK), bool))

    def step(carry, inp):
        C, n, m = carry
        qc, kc, vc, li, lf = inp
        b = jnp.cumsum(lf, axis=-1)
        g = b[..., -1]
        dmat = jnp.where(tri, b[..., :, None] - b[..., None, :] + li[..., None, :], -jnp.inf)
        m_inter = b + m[..., None]
        m_t = jnp.maximum(m_inter, jnp.max(dmat, axis=-1))
        w_inter = jnp.exp(m_inter - m_t)
        s = jnp.einsum('bhtd,bhsd->bhts', qc, kc) * jnp.exp(dmat - m_t[..., None])
        num = w_inter[..., None] * jnp.einsum('bhtd,bhdv->bhtv', qc, C) + jnp.einsum('bhts,bhsv->bhtv', s, vc)
        den = w_inter * jnp.einsum('bhtd,bhd->bht', qc, n) + jnp.sum(s, axis=-1)
        h = num / jnp.maximum(jnp.abs(den), jnp.exp(-m_t))[..., None]
        loga = g[..., None] - b + li
        m_new = jnp.maximum(g + m, jnp.max(loga, axis=-1))
        carry_scale = jnp.exp(g + m - m_new)
        wa = jnp.exp(loga - m_new[..., None])
        C = carry_scale[..., None, None] * C + jnp.einsum('bhs,bhsd,bhsv->bhdv', wa, kc, vc)
        n = carry_scale[..., None] * n + jnp.einsum('bhs,bhsd->bhd', wa, kc)
        return (C, n, m_new), h

    init = (jnp.zeros((Bsz, H, ML_DK, ML_DV), jnp.float32),
            jnp.zeros((Bsz, H, ML_DK), jnp.float32),
            jnp.zeros((Bsz, H), jnp.float32))
    _, h = lax.scan(step, init, tuple(chunks(t) for t in (q, k, v, logi, logf)))
    return jnp.moveaxis(h, 0, 2).reshape(Bsz, H, L, ML_DV)


def mlstm_branch(q, k, v, o, gate_pre, gate_b, norm_g, bwd):
    f32 = jnp.float32
    Bsz, L, _ = q.shape
    to_heads = lambda t, dh: jnp.swapaxes(t.astype(f32).reshape(Bsz, L, ML_HEADS, dh), 1, 2)
    q = to_heads(q, ML_DK) * (ML_DK ** -0.5)
    k = to_heads(k, ML_DK)
    v = to_heads(v, ML_DV)
    pre = gate_pre.astype(f32).reshape(Bsz, L, 4, ML_HEADS) + gate_b.astype(f32)
    pre = GATE_CAP * jnp.tanh(pre / GATE_CAP)
    pre = jnp.transpose(pre, (0, 2, 3, 1))
    logi = pre[:, 0:2]
    logf = jax.nn.log_sigmoid(pre[:, 2:4])
    h_f = mlstm_chunk_scan(q, k, v, logi[:, 0], logf[:, 0])
    flip = lambda t: jnp.take(t, bwd, axis=2)
    h_b = flip(mlstm_chunk_scan(flip(q), flip(k), flip(v), flip(logi[:, 1]), flip(logf[:, 1])))
    h = jnp.swapaxes(h_f + h_b, 1, 2)
    h = rms_norm(h, norm_g.reshape(ML_HEADS, ML_DV)).reshape(Bsz, L, BRANCH)
    return jax.nn.sigmoid(o.astype(f32)) * h


def hybrid_layer(z, mod_c, mod_l, norm_g, w_in, shift_mu, rw_w_up, rw_w0, rw_a_up, rw_a0,
                 rw_k_k, rw_k_a, rw_r_k, rw_ln_w, rw_ln_b, at_q_g, at_k_g, ml_gate_b, ml_norm_g,
                 w_branch, w_out, cos, sin, bwd, n_ctx):
    Bsz, L, _ = z.shape
    sh_c, sc_c, gt_c = jnp.split(mod_c, 3, axis=-1)
    sh_l, sc_l, gt_l = jnp.split(mod_l, 3, axis=-1)
    z_c, z_l = z[:, :n_ctx], z[:, n_ctx:]
    h = jnp.concatenate([rms_norm(z_c, norm_g) * (1 + sc_c) + sh_c,
                         rms_norm(z_l, norm_g) * (1 + sc_l[:, None]) + sh_l[:, None]], axis=1)
    proj = h @ w_in
    split_idx = tuple(int(i) for i in np.cumsum(IN_SIZES)[:-1])
    (rw_s, rw_g, at_q, at_k, at_v, at_g, ml_q, ml_k, ml_v, ml_o, ml_if, ml_g, merge) = \
        jnp.split(proj, split_idx, axis=-1)

    prev, nxt = segment_neighbours(rw_s, n_ctx)
    rw_s = rw_s + shift_mu[0] * (prev - rw_s) + shift_mu[1] * (nxt - rw_s)
    xr, xk, xv, xwd, xad = jnp.split(rw_s, (BRANCH, 2 * BRANCH, 3 * BRANCH, 3 * BRANCH + 2 * RW_LORA), axis=-1)
    y_a = rwkv7_branch(xr, xk, xv, xwd, xad, rw_w_up, rw_w0, rw_a_up, rw_a0, rw_k_k, rw_k_a,
                       rw_r_k, rw_ln_w, rw_ln_b, bwd).astype(z.dtype) * jax.nn.silu(rw_g)
    y_b = gqa_branch(at_q, at_k, at_v, at_q_g, at_k_g, cos, sin, n_ctx) * jax.nn.silu(at_g)
    y_c = mlstm_branch(ml_q, ml_k, ml_v, ml_o, ml_if, ml_gate_b, ml_norm_g, bwd).astype(z.dtype) * jax.nn.silu(ml_g)

    ys = jnp.stack([y_a, y_b, y_c], axis=2)
    branch = jnp.einsum('blnc,ncd->blnd', ys, w_branch)
    gates = jax.nn.sigmoid(merge).reshape(Bsz, L, N_BRANCH, D_MODEL)
    out = jnp.sum(gates * branch, axis=2) @ w_out
    return jnp.concatenate([z_c + gt_c * out[:, :n_ctx],
                            z_l + gt_l[:, None] * out[:, n_ctx:]], axis=1)


def setup_inputs(seed: int = 0) -> dict:
    key = jax.random.key(seed)
    ks = iter(jax.random.split(key, 40))
    f32 = jnp.float32
    nrm = lambda shape, s: jax.random.normal(next(ks), shape, f32) * s
    D = D_MODEL
    x = nrm((BATCH, SEQ, D), 1.0)
    c = nrm((BATCH, D), 1.0)
    ctx = nrm((BATCH, CTX_LEN, D), 1.0)
    c_ctx = nrm((D,), 1.0)
    norm_g = 1.0 + nrm((DEPTH, D), 0.02)
    w_ada = nrm((DEPTH, D, 3 * D), 0.5 * D ** -0.5)
    b_ada = nrm((DEPTH, 3 * D), 0.01)
    w_in = nrm((DEPTH, D, D_IN), D ** -0.5)
    shift_mu = jax.random.uniform(next(ks), (DEPTH, 2, RW_SHIFT), f32, 0.1, 0.5)
    rw_w_up = nrm((DEPTH, 2, RW_LORA, BRANCH), 0.1 * RW_LORA ** -0.5)
    rw_w0 = jnp.linspace(-6.0, -1.0, BRANCH, dtype=f32)[None, None] + nrm((DEPTH, 2, BRANCH), 0.1)
    rw_a_up = nrm((DEPTH, 2, RW_LORA, BRANCH), 0.1 * RW_LORA ** -0.5)
    rw_a0 = nrm((DEPTH, 2, BRANCH), 0.1)
    rw_k_k = 0.85 + nrm((DEPTH, BRANCH), 0.02)
    rw_k_a = 1.0 + nrm((DEPTH, BRANCH), 0.02)
    rw_r_k = nrm((DEPTH, RW_HEADS, RW_HD), 0.1)
    rw_ln_w = 1.0 + nrm((DEPTH, BRANCH), 0.02)
    rw_ln_b = nrm((DEPTH, BRANCH), 0.01)
    at_q_g = 1.0 + nrm((DEPTH, AT_HD), 0.02)
    at_k_g = 1.0 + nrm((DEPTH, AT_HD), 0.02)
    ml_gate_b = jnp.concatenate(
        [nrm((DEPTH, 2, ML_HEADS), 0.1),
         jnp.linspace(3.0, 6.0, ML_HEADS, dtype=f32)[None, None] + nrm((DEPTH, 2, ML_HEADS), 0.1)], axis=1)
    ml_norm_g = 1.0 + nrm((DEPTH, BRANCH), 0.02)
    w_branch = nrm((DEPTH, N_BRANCH, BRANCH, D), BRANCH ** -0.5)
    w_out = nrm((DEPTH, D, D), D ** -0.5)
    final_g = 1.0 + nrm((D,), 0.02)
    return {"x": x, "c": c, "ctx": ctx, "c_ctx": c_ctx, "norm_g": norm_g, "w_ada": w_ada,
            "b_ada": b_ada, "w_in": w_in, "shift_mu": shift_mu, "rw_w_up": rw_w_up, "rw_w0": rw_w0,
            "rw_a_up": rw_a_up, "rw_a0": rw_a0, "rw_k_k": rw_k_k, "rw_k_a": rw_k_a, "rw_r_k": rw_r_k,
            "rw_ln_w": rw_ln_w, "rw_ln_b": rw_ln_b, "at_q_g": at_q_g, "at_k_g": at_k_g,
            "ml_gate_b": ml_gate_b, "ml_norm_g": ml_norm_g, "w_branch": w_branch, "w_out": w_out,
            "final_g": final_g}


def reference(x, c, ctx, c_ctx, norm_g, w_ada, b_ada, w_in, shift_mu, rw_w_up, rw_w0, rw_a_up,
              rw_a0, rw_k_k, rw_k_a, rw_r_k, rw_ln_w, rw_ln_b, at_q_g, at_k_g, ml_gate_b, ml_norm_g,
              w_branch, w_out, final_g):
    f32 = jnp.float32
    n_ctx = ctx.shape[1]
    n_lat = x.shape[1]
    rows = n_lat // GRID_W
    row = jnp.repeat(jnp.arange(rows), GRID_W).astype(f32)
    col = jnp.tile(jnp.arange(GRID_W), rows).astype(f32)
    inv_freq = ROPE_THETA ** (-jnp.arange(0, AT_HD // 2, 2, dtype=f32) / (AT_HD // 2))
    ang_lat = jnp.stack([row[:, None] * inv_freq, col[:, None] * inv_freq], axis=1)
    ang = jnp.concatenate([jnp.zeros((n_ctx, 2, AT_HD // 4), f32), ang_lat], axis=0)
    cos, sin = jnp.cos(ang), jnp.sin(ang)
    bwd = jnp.concatenate([jnp.arange(n_ctx)[::-1], n_ctx + jnp.arange(n_lat)[::-1]])

    z = jnp.concatenate([ctx, x], axis=1)
    for l in range(DEPTH):
        mod_l = jax.nn.silu(c) @ w_ada[l] + b_ada[l]
        mod_c = jax.nn.silu(c_ctx) @ w_ada[l] + b_ada[l]
        z = hybrid_layer(z, mod_c, mod_l, norm_g[l], w_in[l], shift_mu[l], rw_w_up[l], rw_w0[l],
                         rw_a_up[l], rw_a0[l], rw_k_k[l], rw_k_a[l], rw_r_k[l], rw_ln_w[l], rw_ln_b[l],
                         at_q_g[l], at_k_g[l], ml_gate_b[l], ml_norm_g[l], w_branch[l], w_out[l],
                         cos, sin, bwd, n_ctx)
    return rms_norm(z[:, n_ctx:], final_g)
```

```cpp
#include <hip/hip_runtime.h>
#include <hip/hip_cooperative_groups.h>
#include <cstdio>
#include <cstdint>

constexpr int D = 2048, BATCH = 2, SEQ = 4096, NCTX = 256, L = NCTX + SEQ, M = BATCH * L, DEPTH = 2;
constexpr int NIN = 17168, NP = 17152;
constexpr int BR = 1024;
constexpr int C_R = 0, C_K = 1024, C_V = 2048, C_WD = 3072, C_AD = 3200, C_RWG = 3328, C_ATQ = 4352, C_ATK = 5376, C_ATV = 5632,
              C_ATG = 5888, C_MLQ = 6912, C_MLK = 7424, C_MLV = 7936, C_MLO = 8960, C_MLG = 9984, C_MRG = 11008;
constexpr int GATE_COL = 9984;
constexpr int SIV = 9 * 64;
constexpr int SIR = 1408;

namespace cg = cooperative_groups;
typedef _Float16 f16;
typedef _Float16 f16x8 __attribute__((ext_vector_type(8)));
typedef _Float16 f16x4 __attribute__((ext_vector_type(4)));
typedef _Float16 f16x2 __attribute__((ext_vector_type(2)));
typedef float f32x4 __attribute__((ext_vector_type(4)));
typedef float f32x2 __attribute__((ext_vector_type(2)));
typedef unsigned u32x4 __attribute__((ext_vector_type(4)));

constexpr size_t MiB = 1u << 20;
constexpr size_t al(size_t x) { return (x + 255) / 256 * 256; }
constexpr size_t WS_CTL = 0;
constexpr size_t WS_MODV = 1 * MiB;
constexpr size_t WS_WIN = WS_MODV + al((size_t)2 * 3 * 6144 * 4);
constexpr size_t WS_WBR = WS_WIN + al((size_t)NP * D * 2);
constexpr size_t WS_WOUT = WS_WBR + al((size_t)3 * D * BR * 2);
constexpr size_t WS_H = WS_WOUT + al((size_t)D * D * 2);
constexpr size_t WS_QN = WS_H;
constexpr size_t WS_KN = WS_QN + al((size_t)M * 1024 * 2);
constexpr size_t WS_GPRE = WS_H + al((size_t)M * D * 2);
constexpr size_t WS_RKD = WS_GPRE + al((size_t)M * 16 * 4);
constexpr size_t WS_P = WS_RKD + al((size_t)M * 16 * 4);
constexpr size_t WS_SI = WS_P + al((size_t)M * NP * 2);
constexpr size_t WS_G3 = WS_SI;
constexpr size_t WS_MRG = WS_G3 + al((size_t)3 * M * D * 2);
constexpr size_t WS_YRW = WS_SI + al((size_t)BATCH * 16 * L * SIV * 4);
constexpr size_t WS_AO = WS_YRW + al((size_t)2 * M * 1024 * 4);
constexpr size_t WS_HM = WS_AO + al((size_t)M * 1024 * 4);
constexpr size_t WS_Y = WS_HM + al((size_t)2 * M * 1024 * 4);
constexpr size_t WS_Z = WS_Y + al((size_t)M * 3072 * 2);
constexpr size_t WS_G3B = WS_Z + al((size_t)M * D * 4);
constexpr size_t WS_END = WS_G3B + al((size_t)2 * M * D * 2);
static_assert(WS_MRG + (size_t)M * D * 2 <= WS_YRW, "G3|MERGED overlay fits in SI");
static_assert(WS_KN + (size_t)M * 512 * 2 <= WS_GPRE, "QN|KN overlay fits in H");

#ifndef PROBE_PHASE
#define PROBE_PHASE 0
#endif
constexpr int NT = 512;
constexpr int LDS_BYTES = 152 * 1024;

struct Args { const float* in[25]; float* out; unsigned char* ws; int ph_lo, ph_hi; };

__device__ __forceinline__ int ltid() { int t = threadIdx.x; asm volatile("" : "+v"(t)); return t; }
__device__ __forceinline__ int lbid() { int t = blockIdx.x; asm volatile("" : "+s"(t)); return t; }
__device__ __forceinline__ float wave_sum(float v) {
#pragma unroll
  for (int o = 32; o >= 1; o >>= 1) v += __shfl_xor(v, o);
  return v;
}
template <int CTRL> __device__ __forceinline__ float dppf(float x) { return __int_as_float(__builtin_amdgcn_update_dpp(0, __float_as_int(x), CTRL, 0xF, 0xF, true)); }
__device__ __forceinline__ float red16(float x) { x += dppf<0xB1>(x); x += dppf<0x4E>(x); x += dppf<0x141>(x); x += dppf<0x140>(x); return x; }
template <int CTRL> __device__ __forceinline__ float dppx(float x) { return __int_as_float(__builtin_amdgcn_update_dpp(0, __float_as_int(x), CTRL, 0xF, 0xF, true)); }
__device__ __forceinline__ float wsum_fast(float x) { x += dppx<0xB1>(x); x += dppx<0x4E>(x); x += dppx<0x141>(x); x += dppx<0x140>(x); x += __shfl_xor(x, 16); x += __shfl_xor(x, 32); return x; }

__device__ __forceinline__ float wave_max(float v) {
#pragma unroll
  for (int o = 32; o >= 1; o >>= 1) v = fmaxf(v, __shfl_xor(v, o));
  return v;
}
__device__ __forceinline__ float sigm_f(float x) { return __builtin_amdgcn_rcpf(1.f + __expf(-x)); }
__device__ __forceinline__ float silu_f(float x) { return x * sigm_f(x); }
__device__ __forceinline__ float tanh_f(float x) { const float t = __expf(-2.f * fabsf(x)); return copysignf((1.f - t) * __builtin_amdgcn_rcpf(1.f + t), x); }
__device__ __forceinline__ float softplus_f(float x) { return x > 20.f ? x : log1pf(expf(x)); }
__device__ __forceinline__ unsigned pkh(float lo, float hi) { f32x2 v = {lo, hi}; f16x2 h = __builtin_convertvector(v, f16x2); return __builtin_bit_cast(unsigned, h); }

__device__ __forceinline__ const float* zrow(const Args& a, int l, int m) {
  if (l > 0) return (const float*)(a.ws + WS_Z) + (size_t)m * D;
  const int b = m / L, t = m % L;
  return t < NCTX ? a.in[2] + ((size_t)b * NCTX + t) * D : a.in[0] + ((size_t)b * SEQ + (t - NCTX)) * D;
}

__device__ __forceinline__ void ph_modv(const Args& a, unsigned char* lds) {
  const int tid = ltid(), lane = tid & 63, wave = tid >> 6;
  float* sv = (float*)lds;
  float* red = sv + 3 * 2048;
  float* modv = (float*)(a.ws + WS_MODV);
  for (int i = tid; i < 3 * 2048; i += NT) { const int w = i / 2048, k = i % 2048; sv[i] = silu_f(w < 2 ? a.in[1][w * 2048 + k] : a.in[3][k]); }
  __syncthreads();
  for (int u = lbid(); u < 192; u += gridDim.x) {
    const int l = u / 96, j0 = (u % 96) * 64;
    const float* w = a.in[5] + (size_t)l * 2048 * 6144 + j0 + lane;
    float a0 = 0.f, a1 = 0.f, a2 = 0.f;
    for (int k = wave * 256; k < wave * 256 + 256; ++k) { const float wv = w[(size_t)k * 6144]; a0 += sv[k] * wv; a1 += sv[2048 + k] * wv; a2 += sv[4096 + k] * wv; }
    red[(wave * 3 + 0) * 64 + lane] = a0; red[(wave * 3 + 1) * 64 + lane] = a1; red[(wave * 3 + 2) * 64 + lane] = a2;
    __syncthreads();
    if (tid < 192) { const int i = tid >> 6; float s = a.in[6][l * 6144 + j0 + lane];
      for (int w8 = 0; w8 < 8; ++w8) s += red[(w8 * 3 + i) * 64 + lane];
      modv[(size_t)(l * 3 + i) * 6144 + j0 + lane] = s; }
    __syncthreads();
  }
}

__device__ __forceinline__ void transpose_item(const float* W, int ldw, int ncol0, int k0, f16* WT, int K, int row0, float* scr, int lane) {
#pragma unroll 8
  for (int i = 0; i < 32; ++i) { const int kk = 2 * i + (lane >> 5); scr[kk * 33 + (lane & 31)] = W[(size_t)(k0 + kk) * ldw + ncol0 + (lane & 31)]; }
  asm volatile("s_waitcnt lgkmcnt(0)" ::: "memory");
  const int c = lane & 7;
#pragma unroll
  for (int j = 0; j < 4; ++j) { const int n = (lane >> 3) + 8 * j; const float* s = scr + (8 * c) * 33 + n;
    u32x4 o; o.x = pkh(s[0 * 33], s[1 * 33]); o.y = pkh(s[2 * 33], s[3 * 33]); o.z = pkh(s[4 * 33], s[5 * 33]); o.w = pkh(s[6 * 33], s[7 * 33]);
    *(u32x4*)(WT + (size_t)(row0 + n) * K + k0 + 8 * c) = o; }
  asm volatile("s_waitcnt lgkmcnt(0)" ::: "memory");
}
__device__ __forceinline__ void ph_convert(const Args& a, int l, unsigned char* lds, int part = 3, int b0 = 0, int nb = 0) {
  const int tid = ltid(), lane = tid & 63, wave = tid >> 6;
  float* scr = (float*)lds + wave * (64 * 33);
  if (nb == 0) nb = gridDim.x;
  const int gw = (lbid() - b0) * 8 + wave, NGW = nb * 8;
  constexpr int I_IN = (D / 64) * (NP / 32), I_BR = (BR / 64) * (D / 32), I_OUT = (D / 64) * (D / 32);
  f16* WIN = (f16*)(a.ws + WS_WIN); f16* WBR = (f16*)(a.ws + WS_WBR); f16* WOUT = (f16*)(a.ws + WS_WOUT);
  for (int it = gw + ((part & 1) ? 0 : I_IN); it < ((part & 2) ? I_IN + 3 * I_BR + I_OUT : I_IN); it += NGW) {
    int r = it;
    if (r < I_IN) { const int nblk = NP / 32, kb = r / nblk, nb = r % nblk, n0 = nb * 32;
      transpose_item(a.in[7] + (size_t)l * D * NIN, NIN, n0 + (n0 >= GATE_COL ? 16 : 0), kb * 64, WIN, D, n0, scr, lane); continue; }
    r -= I_IN;
    if (r < 3 * I_BR) { const int br = r / I_BR, q = r % I_BR, nblk = D / 32, kb = q / nblk, nb = q % nblk;
      transpose_item(a.in[22] + ((size_t)l * 3 + br) * BR * D, D, nb * 32, kb * 64, WBR, BR, br * D + nb * 32, scr, lane); continue; }
    r -= 3 * I_BR;
    { const int nblk = D / 32, kb = r / nblk, nb = r % nblk;
      transpose_item(a.in[23] + (size_t)l * D * D, D, nb * 32, kb * 64, WOUT, D, nb * 32, scr, lane); }
  }
}

__device__ __forceinline__ void ph_norm(const Args& a, int l, unsigned char* lds) {
  const int tid = ltid(), lane = tid & 63, wave = tid >> 6;
  const int gw = lbid() * 8 + wave, NGW = gridDim.x * 8;
  float* wg = (float*)lds;
  { const float* w = a.in[7] + (size_t)l * D * NIN + GATE_COL;
    for (int i = tid; i < 2048 * 4; i += NT) { const int k = i >> 2, q = i & 3; const f32x4 v = *(const f32x4*)(w + (size_t)k * NIN + q * 4);
      wg[(q * 4 + 0) * 2048 + k] = v.x; wg[(q * 4 + 1) * 2048 + k] = v.y; wg[(q * 4 + 2) * 2048 + k] = v.z; wg[(q * 4 + 3) * 2048 + k] = v.w; } }
  __syncthreads();
  const float* modv = (const float*)(a.ws + WS_MODV) + (size_t)l * 3 * 6144;
  const float* ng = a.in[4] + l * D;
  f16* H = (f16*)(a.ws + WS_H); float* GP = (float*)(a.ws + WS_GPRE);
  for (int m = gw; m < M; m += NGW) {
    const int b = m / L, t = m % L; const float* zr = zrow(a, l, m);
    const float* mv = modv + (size_t)(t < NCTX ? 2 : b) * 6144;
    f32x4 v[8]; float ss = 0.f;
#pragma unroll
    for (int j = 0; j < 8; ++j) { v[j] = *(const f32x4*)(zr + 4 * (lane + 64 * j)); ss += v[j].x * v[j].x + v[j].y * v[j].y + v[j].z * v[j].z + v[j].w * v[j].w; }
    const float rstd = rsqrtf(wave_sum(ss) * (1.f / D) + 1e-6f);
#pragma unroll
    for (int j = 0; j < 8; ++j) { const int k = 4 * (lane + 64 * j);
      const f32x4 g = *(const f32x4*)(ng + k), sh = *(const f32x4*)(mv + k), sc = *(const f32x4*)(mv + 2048 + k);
      v[j] = (v[j] * rstd * g) * (1.f + sc) + sh;
      uint2 o; o.x = pkh(v[j].x, v[j].y); o.y = pkh(v[j].z, v[j].w); *(uint2*)(H + (size_t)m * D + k) = o; }
    float gsum = 0.f;
#pragma unroll 4
    for (int g = 0; g < 16; ++g) { float p = 0.f;
#pragma unroll
      for (int j = 0; j < 8; ++j) { const f32x4 w = *(const f32x4*)(wg + g * 2048 + 4 * (lane + 64 * j)); p += v[j].x * w.x + v[j].y * w.y + v[j].z * w.z + v[j].w * w.w; }
      p = wave_sum(p); if (lane == g) gsum = p; }
    if (lane < 16) GP[(size_t)m * 16 + lane] = gsum;
  }
}

template <class Epi>
__device__ __forceinline__ void tail_gemm(const f16* A, int lda, const f16* Bt, int ldb, int m0, int Mrows, int Ncols, int K, unsigned char* lds, const Epi& epi) {
  const int tid = ltid(), lane = tid & 63, wave = __builtin_amdgcn_readfirstlane(tid >> 6), fr = lane & 15, fq = lane >> 4;
  const int ntn = Ncols / 64, nun = (Mrows / 64) * ntn, KW = K / 8;
  float* part = (float*)lds;
  for (int u = lbid(); u < nun; u += (int)gridDim.x) {
    const int tm = u / ntn, tn = u % ntn;
    f32x4 acc[4][4];
#pragma unroll
    for (int i = 0; i < 4; ++i)
#pragma unroll
      for (int j = 0; j < 4; ++j) acc[i][j] = (f32x4){0.f, 0.f, 0.f, 0.f};
    const f16* ap = A + (size_t)(m0 + tm * 64 + fr) * lda + wave * KW + fq * 8; const f16* bp = Bt + (size_t)(tn * 64 + fr) * ldb + wave * KW + fq * 8;
    for (int k0 = 0; k0 < KW; k0 += 64) {
      f16x8 af[4], bf[4], an[4], bn[4];
#pragma unroll
      for (int i = 0; i < 4; ++i) { af[i] = *(const f16x8*)(ap + (size_t)i * 16 * lda + k0); bf[i] = *(const f16x8*)(bp + (size_t)i * 16 * ldb + k0);
                                    an[i] = *(const f16x8*)(ap + (size_t)i * 16 * lda + k0 + 32); bn[i] = *(const f16x8*)(bp + (size_t)i * 16 * ldb + k0 + 32); }
#pragma unroll
      for (int i = 0; i < 4; ++i)
#pragma unroll
        for (int j = 0; j < 4; ++j) { acc[i][j] = __builtin_amdgcn_mfma_f32_16x16x32_f16(af[i], bf[j], acc[i][j], 0, 0, 0); acc[i][j] = __builtin_amdgcn_mfma_f32_16x16x32_f16(an[i], bn[j], acc[i][j], 0, 0, 0); }
    }
    __syncthreads();
#pragma unroll
    for (int i = 0; i < 4; ++i)
#pragma unroll
      for (int j = 0; j < 4; ++j)
#pragma unroll
        for (int r = 0; r < 4; ++r) part[((wave * 16 + i * 4 + j) * 4 + r) * 64 + lane] = acc[i][j][r];
    __syncthreads();
#pragma unroll
    for (int q = 0; q < 2; ++q) { const int f = 2 * wave + q, i = f >> 2, j = f & 3;
#pragma unroll
      for (int r = 0; r < 4; ++r) { float v = 0.f;
#pragma unroll
        for (int w8 = 0; w8 < 8; ++w8) v += part[((w8 * 16 + f) * 4 + r) * 64 + lane];
        epi(m0 + tm * 64 + i * 16 + fq * 4 + r, tn * 64 + j * 16 + fr, v); } }
  }
}
struct EpiBranch { f16* O; const f16* P; int br; __device__ __forceinline__ void operator()(int m, int n, float v) const {
  const float g = sigm_f((float)P[(size_t)m * NP + C_MRG + br * D + n]); O[(size_t)m * D + n] = (f16)(g * v); } };
struct EpiBranchMerge { f16* MRG; const f16* G3b; const f16* P; __device__ __forceinline__ void operator()(int m, int n, float v) const {
  const float g = sigm_f((float)P[(size_t)m * NP + C_MRG + n]); MRG[(size_t)m * D + n] = (f16)(g * v + (float)G3b[(size_t)m * D + n] + (float)G3b[(size_t)M * D + (size_t)m * D + n]); } };
struct EpiOut { Args a; int l; __device__ __forceinline__ void operator()(int m, int n, float v) const {
  const int b = m / L, t = m % L; const float gt = ((const float*)(a.ws + WS_MODV))[(size_t)(l * 3 + (t < NCTX ? 2 : b)) * 6144 + 4096 + n];
  ((float*)(a.ws + WS_Z))[(size_t)m * D + n] = zrow(a, l, m)[n] + gt * v; } };


namespace pg8 {
#define PG8_LAS __attribute__((address_space(3)))
constexpr int BM = 256, BK = 64, HALF = 128, HTB = HALF * BK * 2  , STAGE_BYTES = 8 * HTB, NXCD = 8, WGM = 8;
__host__ __device__ __forceinline__ int lds_byte(int r, int c) { const int st = (r >> 4) * 2 + (c >> 5), rr = r & 15, cc = c & 31, ob = rr * 64 + cc * 2; return st * 1024 + (ob ^ (((ob >> 9) & 1) << 5)); }
__host__ __device__ __forceinline__ void stage_rc(int b, int& R, int& C) { const int st = b / 1024, sb = b % 1024, swz = sb ^ (((sb >> 9) & 1) << 5); R = (st >> 1) * 16 + swz / 64; C = (st & 1) * 32 + (swz % 64) / 2; }
__host__ __device__ __forceinline__ int perm32(int rho) { const int n = rho >> 4, i = rho & 15; return 8 * (i >> 2) + 4 * n + (i & 3); }
struct Unit { int pm, pn; };
struct Gemm { const f16* A; const f16* Bt; int lda, ldb, K, pn_grp, a_grp_cols; };
struct StaticOrder {
    int nM, nN, nwg, G, c, pn_off, nx;
    __device__ void init(int M_, int N_, int G_, int c_, int pn_off_ = 0, int nx_ = NXCD) { nM = M_ / BM; nN = N_ / BM; nwg = nM * nN; G = G_; c = c_; pn_off = pn_off_; nx = nx_; }
    __device__ bool next(int i, Unit& u) const {
        const long Lx = (long)i * G + c; if (Lx >= nwg) return false;
        int wgid = (int)Lx; { const int q = nwg / nx, r = nwg % nx, xcd = wgid % nx, off = wgid / nx; wgid = (xcd < r ? xcd * (q + 1) : r * (q + 1) + (xcd - r) * q) + off; }
        const int nig = WGM * nN, gid = wgid / nig, fm = gid * WGM, gsz = (nM - fm) < WGM ? (nM - fm) : WGM;
        u.pm = fm + ((wgid % nig) % gsz); u.pn = pn_off + (wgid % nig) / gsz; return true;
    }
};
template <class Epi>
__device__ __forceinline__ void gemm_phase(PG8_LAS unsigned char* lds, const Gemm g, const StaticOrder& S, const Epi& E) {
    const int tid = ltid(), wid = __builtin_amdgcn_readfirstlane(tid >> 6), lane = tid & 63, wr = wid >> 2, wc = wid & 3, fr = lane & 15, fq = lane >> 4;
    const int K = g.K, nt = K / BK;
    unsigned voffA[2], voffB[2];
#pragma unroll
    for (int i = 0; i < 2; ++i) { int R, C; stage_rc(tid * 16 + i * 8192, R, C); const int Rb = Epi::PERM ? ((R & ~31) + perm32(R & 31)) : R;
        voffA[i] = (unsigned)(R * g.lda + C) * 2u; voffB[i] = (unsigned)(Rb * g.ldb + C) * 2u; }
    const size_t kstep = (size_t)(BK * 2);
    const size_t hstepA = (size_t)HALF * g.lda * 2, hstepB = (size_t)HALF * g.ldb * 2;
    const size_t tstepA = 2 * hstepA, tstepB = 2 * hstepB;
    const unsigned ldsw = (unsigned)wid * 1024u;
    const int aoff = lds_byte(wr * 64 + fr, fq * 8), boff = lds_byte(wc * 32 + fr, fq * 8);
#define PG8_SA(b, h) (((b) * 2 + (h)) * HTB)
#define PG8_SB(b, h) ((4 + (b) * 2 + (h)) * HTB)
#define PG8_STAGE(bufoff, gbase, voff) do { _Pragma("unroll") for (int _i = 0; _i < 2; ++_i) \
        __builtin_amdgcn_global_load_lds((const unsigned*)((const char*)(gbase) + (voff)[_i]), (PG8_LAS unsigned*)(lds + (bufoff) + ldsw + _i * 8192), 16, 0, 0); } while (0)
#define PG8_LDA(dst, b, h) do { _Pragma("unroll") for (int m = 0; m < 4; ++m) _Pragma("unroll") for (int k = 0; k < 2; ++k) dst[m][k] = *(const PG8_LAS f16x8*)(lds + PG8_SA(b, h) + aoff + m * 2048 + k * 1024); } while (0)
#define PG8_LDB(dst, b, h) do { _Pragma("unroll") for (int n = 0; n < 2; ++n) _Pragma("unroll") for (int k = 0; k < 2; ++k) dst[n][k] = *(const PG8_LAS f16x8*)(lds + PG8_SB(b, h) + boff + n * 2048 + k * 1024); } while (0)
#define PG8_MMA(ai, bj, At, Bt) do { __builtin_amdgcn_s_setprio(1); _Pragma("unroll") for (int m = 0; m < 4; ++m) _Pragma("unroll") for (int n = 0; n < 2; ++n) _Pragma("unroll") for (int k = 0; k < 2; ++k) \
        acc[ai][bj][m][n] = __builtin_amdgcn_mfma_f32_16x16x32_f16(Bt[n][k], At[m][k], acc[ai][bj][m][n], 0, 0, 0); __builtin_amdgcn_s_setprio(0); } while (0)
#define PG8_WAIT_V(n) asm volatile("s_waitcnt vmcnt(" #n ")" ::: "memory")
#define PG8_WAIT_L(n) asm volatile("s_waitcnt lgkmcnt(" #n ")" ::: "memory")
#define PG8_BAR __builtin_amdgcn_s_barrier()
#define PG8_SCHED __builtin_amdgcn_sched_barrier(0)
#define PG8_UA(u) ((const char*)g.A + (size_t)(u).pm * tstepA + (size_t)((u).pn / g.pn_grp) * g.a_grp_cols * 2)
#define PG8_UB(u) ((const char*)g.Bt + (size_t)(u).pn * tstepB)
    Unit cur, nxt; int ui = 0;
    if (!S.next(0, cur)) return;
    f32x4 acc[2][2][4][2];
#pragma unroll
    for (int a = 0; a < 2; ++a)
#pragma unroll
        for (int b = 0; b < 2; ++b)
#pragma unroll
            for (int m = 0; m < 4; ++m)
#pragma unroll
                for (int n = 0; n < 2; ++n) acc[a][b][m][n] = (f32x4){0.f, 0.f, 0.f, 0.f};
    f16x8 At[4][2], B0[2][2], B1[2][2];
    const char* cA = PG8_UA(cur); const char* cB = PG8_UB(cur);
    PG8_STAGE(PG8_SB(0, 0), cB, voffB); PG8_STAGE(PG8_SB(0, 1), cB + hstepB, voffB); PG8_STAGE(PG8_SA(0, 0), cA, voffA); PG8_STAGE(PG8_SA(0, 1), cA + hstepA, voffA);
    if (wr == 1) PG8_BAR;
    PG8_WAIT_V(2); PG8_BAR;
    PG8_STAGE(PG8_SB(1, 0), cB + kstep, voffB); PG8_STAGE(PG8_SA(1, 0), cA + kstep, voffA); PG8_STAGE(PG8_SB(1, 1), cB + hstepB + kstep, voffB);
    PG8_WAIT_V(6); PG8_BAR;
    for (;;) {
        const bool has_next = S.next(ui + 1, nxt);
        const char* nA = has_next ? PG8_UA(nxt) : cA; const char* nB = has_next ? PG8_UB(nxt) : cB;
        for (int t = 0; t < nt; t += 2) {
            const bool last = (t == nt - 2);
            const char* a1 = cA + (size_t)(t + 1) * kstep;
            const char* a2 = last ? nA : cA + (size_t)(t + 2) * kstep; const char* b2 = last ? nB : cB + (size_t)(t + 2) * kstep;
            const char* a3 = a2 + kstep; const char* b3 = b2 + kstep;
            PG8_LDB(B0, 0, 0); PG8_LDB(B1, 0, 1); PG8_SCHED; PG8_LDA(At, 0, 0); PG8_STAGE(PG8_SA(1, 1), a1 + hstepA, voffA);
            PG8_WAIT_V(8); PG8_WAIT_L(0); PG8_BAR; PG8_MMA(0, 0, At, B0); PG8_MMA(0, 1, At, B1); PG8_BAR; PG8_SCHED;
            PG8_LDA(At, 0, 1); PG8_STAGE(PG8_SB(0, 0), b2, voffB); PG8_STAGE(PG8_SB(0, 1), b2 + hstepB, voffB); PG8_STAGE(PG8_SA(0, 0), a2, voffA);
            PG8_WAIT_V(8); PG8_WAIT_L(0); PG8_BAR; PG8_MMA(1, 0, At, B0); PG8_MMA(1, 1, At, B1); PG8_BAR; PG8_SCHED;
            PG8_LDB(B0, 1, 0); PG8_LDB(B1, 1, 1); PG8_SCHED; PG8_LDA(At, 1, 0); PG8_STAGE(PG8_SA(0, 1), a2 + hstepA, voffA);
            PG8_WAIT_V(8); PG8_WAIT_L(0); PG8_BAR; PG8_MMA(0, 0, At, B0); PG8_MMA(0, 1, At, B1); PG8_BAR; PG8_SCHED;
            PG8_LDA(At, 1, 1); PG8_STAGE(PG8_SB(1, 0), b3, voffB); PG8_STAGE(PG8_SB(1, 1), b3 + hstepB, voffB); PG8_STAGE(PG8_SA(1, 0), a3, voffA);
            PG8_WAIT_V(8); PG8_WAIT_L(0); PG8_BAR; PG8_MMA(1, 0, At, B0); PG8_MMA(1, 1, At, B1); PG8_BAR; PG8_SCHED;
        }
        if (wr == 0) PG8_BAR;
        E(acc, cur, wr, wc, fr, fq);
        if (!has_next) break;
#pragma unroll
        for (int a = 0; a < 2; ++a)
#pragma unroll
            for (int b = 0; b < 2; ++b)
#pragma unroll
                for (int m = 0; m < 4; ++m)
#pragma unroll
                    for (int n = 0; n < 2; ++n) acc[a][b][m][n] = (f32x4){0.f, 0.f, 0.f, 0.f};
        cur = nxt; cA = nA; cB = nB; ++ui;
        if (wr == 1) PG8_BAR;
    }
    PG8_WAIT_V(0);
    PG8_BAR;
#undef PG8_SA
#undef PG8_SB
#undef PG8_STAGE
#undef PG8_LDA
#undef PG8_LDB
#undef PG8_MMA
#undef PG8_WAIT_V
#undef PG8_WAIT_L
#undef PG8_BAR
#undef PG8_SCHED
#undef PG8_UA
#undef PG8_UB
}
struct EpiP { static constexpr bool PERM = true; f16* O; int coff;
    __device__ __forceinline__ void operator()(const f32x4 (&acc)[2][2][4][2], const Unit& u, int wr, int wc, int fr, int fq) const {
        const int row0 = u.pm * BM + wr * 64 + fr, col0 = coff + u.pn * BM + wc * 32 + 8 * fq;
#pragma unroll
        for (int ai = 0; ai < 2; ++ai)
#pragma unroll
            for (int m = 0; m < 4; ++m) { f16* rowp = O + (size_t)(row0 + ai * HALF + m * 16) * NP + col0;
#pragma unroll
                for (int bj = 0; bj < 2; ++bj) { const f32x4 v0 = acc[ai][bj][m][0], v1 = acc[ai][bj][m][1];
                    u32x4 w; w.x = pkh(v0[0], v0[1]); w.y = pkh(v0[2], v0[3]); w.z = pkh(v1[0], v1[1]); w.w = pkh(v1[2], v1[3]);
                    *(u32x4*)(rowp + bj * HALF) = w; } }
    }
};
struct EpiBr { static constexpr bool PERM = true; f16* G3; f16* G3b; const f16* P; f16* MRG;
    __device__ __forceinline__ void operator()(const f32x4 (&acc)[2][2][4][2], const Unit& u, int wr, int wc, int fr, int fq) const {
        const int row0 = u.pm * BM + wr * 64 + fr, colg = u.pn * BM + wc * 32 + 8 * fq, br = u.pn >> 3, col0 = colg - br * D;
        f16* Ob = MRG ? MRG : G3b + (size_t)(br - 1) * M * D;
#pragma unroll
        for (int ai = 0; ai < 2; ++ai)
#pragma unroll
            for (int m = 0; m < 4; ++m) { const int row = row0 + ai * HALF + m * 16;
#pragma unroll
                for (int bj = 0; bj < 2; ++bj) { const f32x4 v0 = acc[ai][bj][m][0], v1 = acc[ai][bj][m][1];
                    const f16x8 gp = *(const f16x8*)(P + (size_t)row * NP + C_MRG + colg + bj * HALF);
                    float o[8];
#pragma unroll
                    for (int e = 0; e < 8; ++e) o[e] = (e < 4 ? v0[e] : v1[e - 4]) * __builtin_amdgcn_rcpf(1.f + __expf(-(float)gp[e]));
                    if (MRG) { const f16x8 x1 = *(const f16x8*)(G3b + (size_t)row * D + col0 + bj * HALF), x2 = *(const f16x8*)(G3b + (size_t)M * D + (size_t)row * D + col0 + bj * HALF);
#pragma unroll
                        for (int e = 0; e < 8; ++e) o[e] += (float)x1[e] + (float)x2[e]; }
                    u32x4 w; w.x = pkh(o[0], o[1]); w.y = pkh(o[2], o[3]); w.z = pkh(o[4], o[5]); w.w = pkh(o[6], o[7]);
                    *(u32x4*)(Ob + (size_t)row * D + col0 + bj * HALF) = w; } }
    }
};
struct EpiZ { static constexpr bool PERM = false; Args a; int l;
    __device__ __forceinline__ void operator()(const f32x4 (&acc)[2][2][4][2], const Unit& u, int wr, int wc, int fr, int fq) const {
        const int row0 = u.pm * BM + wr * 64 + fr, col0 = u.pn * BM + wc * 32 + 4 * fq;
        float* Z = (float*)(a.ws + WS_Z); const float* modv = (const float*)(a.ws + WS_MODV) + (size_t)l * 3 * 6144 + 4096;
#pragma unroll
        for (int ai = 0; ai < 2; ++ai)
#pragma unroll
            for (int m = 0; m < 4; ++m) { const int row = row0 + ai * HALF + m * 16; const int b = row / L, t = row % L;
                const float* zr = zrow(a, l, row); const float* gt = modv + (size_t)(t < NCTX ? 2 : b) * 6144;
#pragma unroll
                for (int bj = 0; bj < 2; ++bj)
#pragma unroll
                    for (int n = 0; n < 2; ++n) { const int c = col0 + bj * HALF + n * 16;
                        const f32x4 zo = *(const f32x4*)(zr + c), gv = *(const f32x4*)(gt + c);
                        *(f32x4*)(Z + (size_t)row * D + c) = zo + gv * acc[ai][bj][m][n]; } }
    }
};
}

__device__ __forceinline__ float shifted(const f16* P, const float* mu, int m, int col) {
  const int t = m % L; const float s = (float)P[(size_t)m * NP + col];
  const float pv = (t == 0 || t == NCTX) ? 0.f : (float)P[(size_t)(m - 1) * NP + col];
  const float nx = (t == L - 1 || t == NCTX - 1) ? 0.f : (float)P[(size_t)(m + 1) * NP + col];
  return s + mu[col] * (pv - s) + mu[3328 + col] * (nx - s);
}
namespace pp {
constexpr int WTP = 72, RAWP = 456, XAP = 72;
constexpr int OFF_WT = 0, OFF_RAW = OFF_WT + 4 * 64 * WTP * 2, OFF_XA = OFF_RAW + 34 * RAWP * 2, OFF_SH = OFF_XA + 4 * 32 * XAP * 2, OFF_NR = OFF_SH + 3 * 32 * 64 * 4, OFF_CST = OFF_NR + 256, OFF_END = OFF_CST + 1344 * 4;
static_assert(OFF_END <= LDS_BYTES, "prep LDS");
}
__device__ __forceinline__ void ph_prep(const Args& a, int l, unsigned char* lds, int part = 3, int b0 = 0, int nb = 0) {
  using namespace pp;
  const int tid = ltid(), lane = tid & 63, wave = __builtin_amdgcn_readfirstlane(tid >> 6), fr = lane & 15, fq = lane >> 4;
  const f16* P = (const f16*)(a.ws + WS_P);
  const float* mu = a.in[8] + (size_t)l * 2 * 3328;
  f16* WT = (f16*)(lds + OFF_WT); f16* RAW = (f16*)(lds + OFF_RAW); f16* XA = (f16*)(lds + OFF_XA); float* SH = (float*)(lds + OFF_SH); float* NRI = (float*)(lds + OFF_NR); float* CST = (float*)(lds + OFF_CST);
  float* RKD = (float*)(a.ws + WS_RKD);
  int cur_h = -1;
  const int NU = 272 * 16;
  f16x8 pre[4];
#define PREP_LOAD(u_) do { const int h_ = (u_) & 15, m0_ = ((u_) >> 4) * 32; \
    _Pragma("unroll") for (int i = 0; i < 4; ++i) { const int q = tid + NT * i; if (q < 34 * 56) { const int row = q / 56, cu = q % 56; int mm = m0_ - 1 + row; mm = mm < 0 ? 0 : (mm > M - 1 ? M - 1 : mm); \
      const int col = cu < 24 ? (cu >> 3) * 1024 + h_ * 64 + (cu & 7) * 8 : C_WD + (cu - 24) * 8; pre[i] = *(const f16x8*)(P + (size_t)mm * NP + col); } } } while (0)
  if ((part & 1) && lbid() < NU) PREP_LOAD(lbid());
  if (part & 1)
  for (int u = lbid(); u < NU; u += gridDim.x) {
    const int tid = ltid(), lane = tid & 63, wave = __builtin_amdgcn_readfirstlane(tid >> 6), fr = lane & 15, fq = lane >> 4;
    const int h = u & 15, m0 = (u >> 4) * 32, b = m0 / L, t0 = m0 % L;
    __syncthreads();
    if (h != cur_h) { cur_h = h;
#pragma unroll 4
      for (int i = tid; i < 4 * 64 * 64; i += NT) { const int mt = i >> 12, j = (i >> 6) & 63, c = i & 63, d = mt >> 1;
        const float* src = (mt & 1) ? a.in[11] : a.in[9];
        WT[(mt * 64 + c) * WTP + j] = (f16)src[(((size_t)l * 2 + d) * 64 + j) * 1024 + h * 64 + c]; }
      for (int i = tid; i < 1344; i += NT) { float v;
        if (i < 512) v = mu[(i >> 8) * 3328 + C_WD + (i & 255)];
        else if (i < 896) { const int q = i - 512, w1 = q / 192, e = q % 192; v = mu[w1 * 3328 + (e >> 6) * 1024 + h * 64 + (e & 63)]; }
        else if (i < 960) v = a.in[13][l * 1024 + h * 64 + (i - 896)];
        else if (i < 1024) v = a.in[14][l * 1024 + h * 64 + (i - 960)];
        else if (i < 1088) v = a.in[15][l * 1024 + h * 64 + (i - 1024)];
        else if (i < 1216) { const int q = i - 1088; v = a.in[10][(l * 2 + (q >> 6)) * 1024 + h * 64 + (q & 63)]; }
        else { const int q = i - 1216; v = a.in[12][(l * 2 + (q >> 6)) * 1024 + h * 64 + (q & 63)]; }
        CST[i] = v; } }
#pragma unroll
    for (int i = 0; i < 4; ++i) { const int q = tid + NT * i; if (q < 34 * 56) { const int row = q / 56, cu = q % 56;
      *(f16x8*)(RAW + row * RAWP + (cu < 24 ? cu * 8 : 192 + (cu - 24) * 8)) = pre[i]; } }
    __syncthreads();
    if (u + (int)gridDim.x < NU) PREP_LOAD(u + (int)gridDim.x);
    { const int tok = tid >> 4, cg = tid & 15, t = t0 + tok; const bool zp = (t == 0 || t == NCTX), zn = (t == L - 1 || t == NCTX - 1);
      const f16* rp = RAW + tok * RAWP + 192 + 16 * cg;
      const int c0 = 16 * cg, mt = c0 < 128 ? 2 * (c0 >> 6) : 2 * ((c0 - 128) >> 6) + 1, j0 = c0 & 63;
#pragma unroll
      for (int hf = 0; hf < 2; ++hf) { const f16x8 pv = *(const f16x8*)(rp + hf * 8), cv = *(const f16x8*)(rp + RAWP + hf * 8), nv = *(const f16x8*)(rp + 2 * RAWP + hf * 8);
        const float* m0p = CST + c0 + hf * 8; f16x8 o;
#pragma unroll
        for (int e = 0; e < 8; ++e) { const float sv = (float)cv[e], p = zp ? 0.f : (float)pv[e], n = zn ? 0.f : (float)nv[e];
          float x = sv + m0p[e] * (p - sv) + m0p[256 + e] * (n - sv); if (!(mt & 1)) x = tanh_f(x); o[e] = (f16)x; }
        *(f16x8*)(XA + (mt * 32 + tok) * XAP + j0 + hf * 8) = o; } }
#pragma unroll
    for (int it = 0; it < 2; ++it) { const int q = tid + NT * it; if (q < 32 * 24) { const int tok = q / 24, g8 = q % 24, seg = g8 >> 3, ch = (g8 & 7) * 8, t = t0 + tok;
        const bool zp = (t == 0 || t == NCTX), zn = (t == L - 1 || t == NCTX - 1);
        const f16* rp = RAW + tok * RAWP + g8 * 8; const f16x8 pv = *(const f16x8*)rp, cv = *(const f16x8*)(rp + RAWP), nv = *(const f16x8*)(rp + 2 * RAWP);
        const float* m0p = CST + 512 + seg * 64 + ch; float o[8];
#pragma unroll
        for (int e = 0; e < 8; ++e) { const float sv = (float)cv[e], p = zp ? 0.f : (float)pv[e], n = zn ? 0.f : (float)nv[e]; o[e] = sv + m0p[e] * (p - sv) + m0p[192 + e] * (n - sv); }
        float* dst = SH + (seg * 32 + tok) * 64 + ch; *(f32x4*)dst = (f32x4){o[0], o[1], o[2], o[3]}; *(f32x4*)(dst + 4) = (f32x4){o[4], o[5], o[6], o[7]}; } }
    __syncthreads();
    const int ti = wave & 1, d = (wave >> 1) & 1, chalf = wave >> 2;
    f32x4 acc[2][2];
#pragma unroll
    for (int m2 = 0; m2 < 2; ++m2)
#pragma unroll
      for (int c2 = 0; c2 < 2; ++c2) { acc[m2][c2] = (f32x4){0.f, 0.f, 0.f, 0.f};
#pragma unroll
        for (int ks = 0; ks < 2; ++ks) acc[m2][c2] = __builtin_amdgcn_mfma_f32_16x16x32_f16(*(const f16x8*)(XA + ((2 * d + m2) * 32 + 16 * ti + fr) * XAP + ks * 32 + fq * 8),
                                                                                             *(const f16x8*)(WT + ((2 * d + m2) * 64 + 16 * (2 * chalf + c2) + fr) * WTP + ks * 32 + fq * 8), acc[m2][c2], 0, 0, 0); }
    __syncthreads();
    unsigned char* SR = lds + OFF_RAW;
    { const int tok = 4 * wave + (lane >> 4), c4 = (lane & 15) * 4;
      const f32x4 r4 = *(const f32x4*)(SH + (0 * 32 + tok) * 64 + c4), k4 = *(const f32x4*)(SH + (1 * 32 + tok) * 64 + c4), v4 = *(const f32x4*)(SH + (2 * 32 + tok) * 64 + c4);
      const f32x4 kkw = *(const f32x4*)(CST + 896 + c4), rkw = *(const f32x4*)(CST + 1024 + c4);
      const f32x4 kk = k4 * kkw, rkp = r4 * k4 * rkw;
      const float n2 = red16((kk.x * kk.x + kk.y * kk.y) + (kk.z * kk.z + kk.w * kk.w)), rk = red16((rkp.x + rkp.y) + (rkp.z + rkp.w));
      const float inv = 1.f / fmaxf(sqrtf(n2), 1e-12f);
      unsigned char* o = SR + tok * SIR + c4 * 2;
      uint2 w; w.x = pkh(r4.x, r4.y); w.y = pkh(r4.z, r4.w); *(uint2*)o = w;
      w.x = pkh(kk.x * inv, kk.y * inv); w.y = pkh(kk.z * inv, kk.w * inv); *(uint2*)(o + 128) = w;
      w.x = pkh(v4.x, v4.y); w.y = pkh(v4.z, v4.w); *(uint2*)(o + 256) = w;
      if ((lane & 15) == 0) { NRI[tok] = inv; RKD[(size_t)(m0 + tok) * 16 + h] = rk; } }
    __syncthreads();
#pragma unroll
    for (int c2 = 0; c2 < 2; ++c2) { const int ch = 16 * (2 * chalf + c2) + fr, c = h * 64 + ch;
      const float kkw = CST[896 + ch], kaw = CST[960 + ch], w0v = CST[1088 + d * 64 + ch], a0v = CST[1216 + d * 64 + ch];
#pragma unroll
      for (int r = 0; r < 4; ++r) { const int tok = 16 * ti + 4 * fq + r; const float k = SH[(1 * 32 + tok) * 64 + ch]; const float kk = k * kkw * NRI[tok];
        const float wl = w0v + acc[0][c2][r]; const float dec = __expf(-0.6065306597126334f * sigm_f(wl));
        const float ag = sigm_f(a0v + acc[1][c2][r]);
        unsigned char* o = SR + tok * SIR + 384 + d * 512;
        ((float*)o)[ch] = dec; ((f16*)(o + 256))[ch] = (f16)(kk * ag); ((f16*)(o + 384))[ch] = (f16)(k * (1.f + (ag - 1.f) * kaw)); } }
    __syncthreads();
    { unsigned char* dstg = a.ws + WS_SI + ((size_t)(b * 16 + h) * L + t0) * SIR;
#pragma unroll
      for (int i = 0; i < 6; ++i) { const int q = tid + NT * i; if (q < 32 * SIR / 16) *(u32x4*)(dstg + (size_t)q * 16) = *(const u32x4*)(SR + q * 16); } }
  }
#undef PREP_LOAD
  __syncthreads();
  f16* QN = (f16*)(a.ws + WS_QN); f16* KN = (f16*)(a.ws + WS_KN);
  f32x2* cst = (f32x2*)lds;
  for (int i = tid; i < 64 * 32; i += NT) { const int pos = i >> 5, fi = i & 31; const float ang = (float)pos * powf(10000.f, -(float)(2 * fi) / 64.f); cst[i] = (f32x2){cosf(ang), sinf(ang)}; }
  __syncthreads();
  if (nb == 0) nb = gridDim.x;
  const int gw = (lbid() - b0) * 8 + wave, NGW = nb * 8;
  const int ax = lane >> 5, fi = lane & 31;
  if (part & 2)
  for (int m = gw; m < M; m += NGW) {
    const int t = m % L; const f16* pr = P + (size_t)m * NP;
    float x1[10], x2[10], ss[10];
#pragma unroll
    for (int hh = 0; hh < 10; ++hh) { const int src = hh < 8 ? C_ATQ + hh * 128 : C_ATK + (hh - 8) * 128; x1[hh] = (float)pr[src + ax * 64 + fi]; x2[hh] = (float)pr[src + ax * 64 + 32 + fi]; ss[hh] = x1[hh] * x1[hh] + x2[hh] * x2[hh]; }
    const f16x4 vc = *(const f16x4*)(pr + C_ATV + 4 * lane);
#pragma unroll
    for (int hh = 0; hh < 10; ++hh) ss[hh] = wave_sum(ss[hh]);
    f32x2 cs = {1.f, 0.f};
    if (t >= NCTX) { const int n = t - NCTX; cs = cst[(ax == 0 ? n / 64 : n % 64) * 32 + fi]; }
#pragma unroll
    for (int hh = 0; hh < 10; ++hh) { const float* g = (hh < 8 ? a.in[18] : a.in[19]) + l * 128; const float rstd = rsqrtf(ss[hh] * (1.f / 128.f) + 1e-6f);
      const float y1 = x1[hh] * rstd * g[ax * 64 + fi], y2 = x2[hh] * rstd * g[ax * 64 + 32 + fi];
      f16* dst = hh < 8 ? QN + (size_t)m * 1024 + hh * 128 : KN + (size_t)m * 512 + (hh - 8) * 128;
      dst[ax * 64 + fi] = (f16)(y1 * cs.x - y2 * cs.y); dst[ax * 64 + 32 + fi] = (f16)(y1 * cs.y + y2 * cs.x); }
    *(f16x4*)(KN + (size_t)m * 512 + 256 + 4 * lane) = vc;
  }
}

__device__ __forceinline__ int scan_tok(int dir, int i) { return dir == 0 ? i : (i < NCTX ? NCTX - 1 - i : L - 1 - (i - NCTX)); }

namespace rw {
constexpr int T = 32;
constexpr int STEPF = 6 * 64;
constexpr int BUFF = T * STEPF;
template <int CTRL> __device__ __forceinline__ float dpp(float x) { return __int_as_float(__builtin_amdgcn_update_dpp(0, __float_as_int(x), CTRL, 0xF, 0xF, true)); }
__device__ __forceinline__ float red8(float x) { x += dpp<0xB1>(x); x += dpp<0x4E>(x); x += dpp<0x141>(x); return x; }
struct Ops { f32x4 r0, r1, k0, k1, w0, w1, b0, b1, d0, d1; f32x2 v; };
typedef __attribute__((address_space(3))) const float lcf;
__device__ __forceinline__ void ld_ops(Ops& o, lcf* st, lcf* vp) {
  o.r0 = *(const __attribute__((address_space(3))) f32x4*)(st); o.r1 = *(const __attribute__((address_space(3))) f32x4*)(st + 4);
  o.k0 = *(const __attribute__((address_space(3))) f32x4*)(st + 64); o.k1 = *(const __attribute__((address_space(3))) f32x4*)(st + 68);
  o.w0 = *(const __attribute__((address_space(3))) f32x4*)(st + 192); o.w1 = *(const __attribute__((address_space(3))) f32x4*)(st + 196);
  o.b0 = *(const __attribute__((address_space(3))) f32x4*)(st + 256); o.b1 = *(const __attribute__((address_space(3))) f32x4*)(st + 260);
  o.d0 = *(const __attribute__((address_space(3))) f32x4*)(st + 320); o.d1 = *(const __attribute__((address_space(3))) f32x4*)(st + 324);
  o.v = *(const __attribute__((address_space(3))) f32x2*)(vp);
}
__device__ __forceinline__ f32x2 step(float (&S0)[8], float (&S1)[8], const Ops& o, f32x2& yp) {
  float kk[8] = {o.k0[0], o.k0[1], o.k0[2], o.k0[3], o.k1[0], o.k1[1], o.k1[2], o.k1[3]};
  float r[8] = {o.r0[0], o.r0[1], o.r0[2], o.r0[3], o.r1[0], o.r1[1], o.r1[2], o.r1[3]};
  float w[8] = {o.w0[0], o.w0[1], o.w0[2], o.w0[3], o.w1[0], o.w1[1], o.w1[2], o.w1[3]};
  float bb[8] = {o.b0[0], o.b0[1], o.b0[2], o.b0[3], o.b1[0], o.b1[1], o.b1[2], o.b1[3]};
  float kd[8] = {o.d0[0], o.d0[1], o.d0[2], o.d0[3], o.d1[0], o.d1[1], o.d1[2], o.d1[3]};
  float a0 = 0.f, a1 = 0.f, c0 = 0.f, c1 = 0.f;
#pragma unroll
  for (int k = 0; k < 4; ++k) { a0 += S0[k] * kk[k]; a1 += S1[k] * kk[k]; c0 += S0[k + 4] * kk[k + 4]; c1 += S1[k + 4] * kk[k + 4]; }
  float t0[8], t1[8];
#pragma unroll
  for (int k = 0; k < 8; ++k) { t0[k] = S0[k] * w[k] + o.v.x * kd[k]; t1[k] = S1[k] * w[k] + o.v.y * kd[k]; }
  float x0 = a0 + c0, x1 = a1 + c1, q0 = yp.x, q1 = yp.y;
  x0 += dpp<0xB1>(x0); x1 += dpp<0xB1>(x1); q0 += dpp<0xB1>(q0); q1 += dpp<0xB1>(q1);
  x0 += dpp<0x4E>(x0); x1 += dpp<0x4E>(x1); q0 += dpp<0x4E>(q0); q1 += dpp<0x4E>(q1);
  x0 += dpp<0x141>(x0); x1 += dpp<0x141>(x1); q0 += dpp<0x141>(q0); q1 += dpp<0x141>(q1);
  const float sa0 = -x0, sa1 = -x1;
  float y0 = 0.f, y1 = 0.f, z0 = 0.f, z1 = 0.f;
#pragma unroll
  for (int k = 0; k < 4; ++k) {
    S0[k] = t0[k] + sa0 * bb[k]; S1[k] = t1[k] + sa1 * bb[k];
    S0[k + 4] = t0[k + 4] + sa0 * bb[k + 4]; S1[k + 4] = t1[k + 4] + sa1 * bb[k + 4];
    y0 += S0[k] * r[k]; y1 += S1[k] * r[k]; z0 += S0[k + 4] * r[k + 4]; z1 += S1[k + 4] * r[k + 4]; }
  yp = (f32x2){y0 + z0, y1 + z1};
  return (f32x2){q0, q1};
}
__device__ __forceinline__ void scan_unit(const Args& a, int u, unsigned char* ldsb) {
  const int tid = ltid(), wave = tid >> 6;
  const int dir = u & 1, bh = u >> 1, b = bh >> 4, h = bh & 15;
  const unsigned char* SIb = a.ws + WS_SI + (size_t)bh * L * SIR;
  float* Y = (float*)(a.ws + WS_YRW) + (size_t)dir * M * 1024 + (size_t)b * L * 1024 + h * 64;
  float* sbuf = (float*)ldsb;
  constexpr int NC = L / T;
  if (wave >= 4) {
    const int lt = tid - 256;
    u32x4 regs[7];
    auto issue = [&](int c) {
#pragma unroll
      for (int j = 0; j < 7; ++j) { const int un = lt + 256 * j, s = un / 56, q = un % 56; const int t = scan_tok(dir, c * T + s);
        regs[j] = *(const u32x4*)(SIb + (size_t)t * SIR + (q < 24 ? q * 16 : 384 + dir * 512 + (q - 24) * 16)); }
    };
    auto commit = [&](int c) {
      float* dst = sbuf + (c & 1) * BUFF;
#pragma unroll
      for (int j = 0; j < 7; ++j) { const int un = lt + 256 * j, s = un / 56, q = un % 56; float* d0 = dst + s * STEPF;
        if (q >= 24 && q < 40) { *(u32x4*)(d0 + 192 + (q - 24) * 4) = regs[j]; }
        else { const f16x8 hv = __builtin_bit_cast(f16x8, regs[j]); float* dd = d0 + (q < 24 ? q * 8 : (q < 48 ? 256 + (q - 40) * 8 : 320 + (q - 48) * 8));
          *(f32x4*)dd = (f32x4){(float)hv[0], (float)hv[1], (float)hv[2], (float)hv[3]}; *(f32x4*)(dd + 4) = (f32x4){(float)hv[4], (float)hv[5], (float)hv[6], (float)hv[7]}; } }
    };
    issue(0); commit(0);
    __syncthreads();
    for (int c = 0; c < NC; ++c) {
      if (c + 1 < NC) { issue(c + 1); commit(c + 1); }
      __syncthreads();
    }
  } else {
    const int p = tid >> 3, ks = tid & 7;
    __builtin_amdgcn_s_setprio(2);
    float S0[8], S1[8];
#pragma unroll
    for (int k = 0; k < 8; ++k) { S0[k] = 0.f; S1[k] = 0.f; }
    __syncthreads();
    for (int c = 0; c < NC; ++c) {
      lcf* buf = (lcf*)(sbuf + (c & 1) * BUFF) + ks * 8; lcf* vb = (lcf*)(sbuf + (c & 1) * BUFF) + 128 + 2 * p;
      const int t0 = scan_tok(dir, c * T), sg = dir ? -1 : 1;
      float* yp_ = Y + (size_t)t0 * 1024 + 2 * p;
      Ops A, B;
      ld_ops(A, buf, vb);
      f32x2 yp = {0.f, 0.f};
#pragma unroll 2
      for (int s = 0; s < T; s += 2) {
        ld_ops(B, buf + (s + 1) * STEPF, vb + (s + 1) * STEPF);
        const f32x2 ya = step(S0, S1, A, yp);
        if (s > 0) *(f32x2*)(yp_ + (ptrdiff_t)sg * (s - 1) * 1024) = ya;
        if (s + 2 < T) ld_ops(A, buf + (s + 2) * STEPF, vb + (s + 2) * STEPF);
        const f32x2 yb = step(S0, S1, B, yp);
        *(f32x2*)(yp_ + (ptrdiff_t)sg * s * 1024) = yb;
      }
      { const f32x2 yl = {red8(yp.x), red8(yp.y)}; if (ks == 0) *(f32x2*)(yp_ + (ptrdiff_t)sg * (T - 1) * 1024) = yl; }
      __syncthreads();
    }
    __builtin_amdgcn_s_setprio(0);
  }
}
}


namespace ml {
constexpr int PT = 136;
constexpr int OFF_Q = 0, OFF_K = 128 * PT * 2, OFF_KT = 2 * 128 * PT * 2, OFF_VT = 3 * 128 * PT * 2, OFF_CT = OFF_VT + 80 * PT * 2, OFF_SC = OFF_CT + 80 * PT * 2;
constexpr int LDS_NEED = OFF_SC + 6 * 512 + 256 + 64;
static_assert(LDS_NEED <= LDS_BYTES, "mLSTM LDS");
constexpr int NCH = L / 128;
#define MFMA16(a_, b_, c_) __builtin_amdgcn_mfma_f32_16x16x32_f16(a_, b_, c_, 0, 0, 0)
__device__ __forceinline__ void mlstm_unit(const Args& a, int l, int u, unsigned char* lds) {
  const int tid = ltid(), lane = tid & 63, w = __builtin_amdgcn_readfirstlane(tid >> 6), fr = lane & 15, fq = lane >> 4;
  const int dir = u & 1, vs = (u >> 1) & 3, bh = u >> 3, b = bh >> 2, h = bh & 3;
  const f16* P = (const f16*)(a.ws + WS_P) + (size_t)b * L * NP; const float* GP = (const float*)(a.ws + WS_GPRE) + (size_t)b * L * 16; const float* gb = a.in[20] + l * 16;
  float* HM = (float*)(a.ws + WS_HM) + (size_t)dir * M * 1024 + (size_t)b * L * 1024 + h * 256 + vs * 64;
  f16* Qs = (f16*)(lds + OFF_Q); f16* Ks = (f16*)(lds + OFF_K); f16* KTs = (f16*)(lds + OFF_KT); f16* VTs = (f16*)(lds + OFF_VT); f16* CTs = (f16*)(lds + OFF_CT);
  float* sc = (float*)(lds + OFF_SC); float* li = sc; float* bcs = sc + 128; float* uu = sc + 256; float* Mx = sc + 384; float* wint = sc + 512; float* emt = sc + 640; f16* wah = (f16*)(sc + 768);
  const float bi = gb[dir * 4 + h], bfg = gb[(2 + dir) * 4 + h];
  __syncthreads();
  for (int i = tid; i < 16 * PT; i += NT) VTs[64 * PT + i] = (f16)(i < PT ? 1.f : 0.f);
  for (int i = tid; i < 80 * PT; i += NT) CTs[i] = (f16)0.f;
  f32x4 CT[5];
#pragma unroll
  for (int n = 0; n < 5; ++n) CT[n] = (f32x4){0.f, 0.f, 0.f, 0.f};
  float mcar = 0.f;
  const int sgn = dir ? -1 : 1;
  f16x8 pq[4], pk[4], pv[2];
#define ML_LOAD(c) do { const int tb_ = scan_tok(dir, 128 * (c)); \
    _Pragma("unroll") for (int i = 0; i < 4; ++i) { const int un = tid + NT * i, j = un >> 4, d8 = un & 15; const f16* rp = P + (size_t)(tb_ + sgn * j) * NP; \
      pq[i] = *(const f16x8*)(rp + C_MLQ + h * 128 + d8 * 8); pk[i] = *(const f16x8*)(rp + C_MLK + h * 128 + d8 * 8); } \
    _Pragma("unroll") for (int i = 0; i < 2; ++i) { const int un = tid + NT * i, j = un >> 3, v8 = un & 7; \
      pv[i] = *(const f16x8*)(P + (size_t)(tb_ + sgn * j) * NP + C_MLV + h * 256 + vs * 64 + v8 * 8); } } while (0)
  ML_LOAD(0);
  for (int c = 0; c < NCH; ++c) {
    const int tb = scan_tok(dir, 128 * c);
    __syncthreads();
#pragma unroll
    for (int i = 0; i < 4; ++i) { const int un = tid + NT * i, j = un >> 4, d8 = un & 15;
      f16x8 qv;
#pragma unroll
      for (int e = 0; e < 8; ++e) qv[e] = (f16)((float)pq[i][e] * 0.08838834764831845f);
      *(f16x8*)(Qs + j * PT + d8 * 8) = qv; *(f16x8*)(Ks + j * PT + d8 * 8) = pk[i];
#pragma unroll
      for (int e = 0; e < 8; ++e) KTs[(d8 * 8 + e) * PT + (j ^ (d8 * 8))] = pk[i][e]; }
#pragma unroll
    for (int i = 0; i < 2; ++i) { const int un = tid + NT * i, j = un >> 3, v8 = un & 7;
#pragma unroll
      for (int e = 0; e < 8; ++e) VTs[(v8 * 8 + e) * PT + (j ^ (v8 * 8))] = pv[i][e]; }
    if (tid < 128) { const float* gp = GP + (size_t)(tb + sgn * tid) * 16;
      const float pi = gp[dir * 4 + h] + bi, pf = gp[(2 + dir) * 4 + h] + bfg;
      li[tid] = 15.f * tanhf(pi * (1.f / 15.f)); bcs[tid] = -softplus_f(-15.f * tanhf(pf * (1.f / 15.f))); }
    if (c + 1 < NCH) ML_LOAD(c + 1);
    __syncthreads();
    if (w == 0) {
      const float x0 = bcs[2 * lane], x1 = bcs[2 * lane + 1]; const float ps = x0 + x1; float inc = ps;
#pragma unroll
      for (int o = 1; o < 64; o <<= 1) { const float t = __shfl_up(inc, o); if (lane >= o) inc += t; }
      const float b0 = inc - ps + x0, b1 = b0 + x1;
      const float u0 = li[2 * lane] - b0, u1 = li[2 * lane + 1] - b1;
      float incm = fmaxf(u0, u1);
#pragma unroll
      for (int o = 1; o < 64; o <<= 1) { const float t = __shfl_up(incm, o); if (lane >= o) incm = fmaxf(incm, t); }
      float exm = __shfl_up(incm, 1); if (lane == 0) exm = -INFINITY;
      const float pm0 = fmaxf(exm, u0), pm1 = incm;
      const float M0 = fmaxf(mcar, pm0), M1 = fmaxf(mcar, pm1); const float Ml = __shfl(M1, 63);
      bcs[2 * lane] = b0; bcs[2 * lane + 1] = b1; uu[2 * lane] = u0; uu[2 * lane + 1] = u1; Mx[2 * lane] = M0; Mx[2 * lane + 1] = M1;
      wint[2 * lane] = expf(mcar - M0); wint[2 * lane + 1] = expf(mcar - M1); emt[2 * lane] = expf(-(b0 + M0)); emt[2 * lane + 1] = expf(-(b1 + M1));
      wah[2 * lane] = (f16)expf(u0 - Ml); wah[2 * lane + 1] = (f16)expf(u1 - Ml);
    }
    f16x8 af[4];
#pragma unroll
    for (int ks = 0; ks < 4; ++ks) af[ks] = *(const f16x8*)(Qs + (16 * w + fr) * PT + ks * 32 + fq * 8);
    f32x4 acc[8];
#pragma unroll
    for (int n = 0; n < 8; ++n) { acc[n] = (f32x4){0.f, 0.f, 0.f, 0.f};
#pragma unroll
      for (int ks = 0; ks < 4; ++ks) acc[n] = MFMA16(af[ks], *(const f16x8*)(Ks + (16 * n + fr) * PT + ks * 32 + fq * 8), acc[n]); }
    __syncthreads();
    const float Mlast = Mx[127], gsum = bcs[127]; const float cs = expf(mcar - Mlast);
    f16* Ss = Ks;
    { float Mt[4];
#pragma unroll
      for (int r = 0; r < 4; ++r) Mt[r] = Mx[16 * w + 4 * fq + r];
#pragma unroll
      for (int n = 0; n < 8; ++n) { const int s = 16 * n + fr; const float us = uu[s];
#pragma unroll
        for (int r = 0; r < 4; ++r) { const int t = 16 * w + 4 * fq + r; const float v = (s <= t) ? acc[n][r] * __expf(us - Mt[r]) : 0.f; Ss[t * PT + s] = (f16)v; } } }
    f32x4 QC[5], SV[5];
#pragma unroll
    for (int n = 0; n < 5; ++n) { QC[n] = (f32x4){0.f, 0.f, 0.f, 0.f}; SV[n] = (f32x4){0.f, 0.f, 0.f, 0.f};
#pragma unroll
      for (int ks = 0; ks < 4; ++ks) QC[n] = MFMA16(af[ks], *(const f16x8*)(CTs + (16 * n + fr) * PT + ks * 32 + fq * 8), QC[n]); }
#pragma unroll
    for (int ks = 0; ks < 4; ++ks) if (32 * ks <= 16 * w + 15) { const f16x8 sf = *(const f16x8*)(Ss + (16 * w + fr) * PT + ks * 32 + fq * 8);
#pragma unroll
      for (int n = 0; n < 5; ++n) SV[n] = MFMA16(sf, *(const f16x8*)(VTs + (16 * n + fr) * PT + ((ks * 32 + fq * 8) ^ ((((16 * n + fr) >> 3) & 7) * 8))), SV[n]); }
#pragma unroll
    for (int r = 0; r < 4; ++r) { const int t = 16 * w + 4 * fq + r; const float wi = wint[t];
      const float den = __shfl(wi * QC[4][r] + SV[4][r], lane & 48); const float inv = 1.f / fmaxf(fabsf(den), emt[t]);
      float* hp = HM + (size_t)(tb + sgn * t) * 1024 + fr;
#pragma unroll
      for (int n = 0; n < 4; ++n) hp[16 * n] = (wi * QC[n][r] + SV[n][r]) * inv; }
#pragma unroll
    for (int n = 0; n < 5; ++n) CT[n] = CT[n] * cs;
#pragma unroll
    for (int ks = 0; ks < 4; ++ks) { const f16x8 bfr = *(const f16x8*)(KTs + (16 * w + fr) * PT + ((ks * 32 + fq * 8) ^ ((((16 * w + fr) >> 3) & 15) * 8))) * *(const f16x8*)(wah + ks * 32 + fq * 8);
#pragma unroll
      for (int n = 0; n < 5; ++n) CT[n] = MFMA16(*(const f16x8*)(VTs + (16 * n + fr) * PT + ((ks * 32 + fq * 8) ^ ((((16 * n + fr) >> 3) & 7) * 8))), bfr, CT[n]); }
    __syncthreads();
#pragma unroll
    for (int n = 0; n < 5; ++n)
#pragma unroll
      for (int r = 0; r < 4; ++r) CTs[(16 * n + 4 * fq + r) * PT + 16 * w + fr] = (f16)CT[n][r];
    mcar = gsum + Mlast;
  }
#undef ML_LOAD
}
#undef MFMA16
}

namespace att {
constexpr int AD = 128, NW = 8, QBLK = 32, KVBLK = 64;
constexpr float SCALE = 0.088388347648318440f;
constexpr float THR = 8.f;
constexpr int LDQ = 1024, LDK = 512, LDV = 512, LDO = 1024;
constexpr size_t SHM_V = KVBLK * AD * 2, SHM_K = KVBLK * AD * 2, SHM_ATTN = 2 * SHM_V + 2 * SHM_K + NW * 64 * 4;
using s16x4 = __attribute__((ext_vector_type(4))) short;
using f32x16 = __attribute__((ext_vector_type(16))) float;
#define KSWZ(row, colB) ((row) * 256 + ((colB) ^ (((row) & 7) << 4)))
#define SBAR() __builtin_amdgcn_sched_barrier(0)
__device__ __forceinline__ int crow(int r, int hi) { return (r & 3) + 8 * (r >> 2) + 4 * hi; }
__device__ __forceinline__ unsigned cvtpk(float lo, float hi) { unsigned r; asm volatile("v_cvt_pk_f16_f32 %0, %1, %2" : "=v"(r) : "v"(lo), "v"(hi)); return r; }
__device__ __forceinline__ void partialSM(f32x16& p0, f32x16& p1, float& m_reg, float& mn, float& alpha) {
  constexpr float C = SCALE * 1.4426950408889634f;
  float pmax = p0[0];
#pragma unroll
  for (int r = 1; r < 16; ++r) pmax = fmaxf(pmax, p0[r]);
#pragma unroll
  for (int r = 0; r < 16; ++r) pmax = fmaxf(pmax, p1[r]);
  { auto rr = __builtin_amdgcn_permlane32_swap(__float_as_uint(pmax), __float_as_uint(pmax), false, false);
    pmax = fmaxf(__uint_as_float(rr[0]), __uint_as_float(rr[1])); }
  if (__builtin_expect(__all(pmax - m_reg <= THR / SCALE), 1)) { mn = m_reg; alpha = 1.f; }
  else { mn = fmaxf(m_reg, pmax); alpha = __builtin_amdgcn_exp2f((m_reg - mn) * C); m_reg = mn; }
  float mnC = -mn * C;
#pragma unroll
  for (int r = 0; r < 16; ++r) p0[r] = fmaf(p0[r], C, mnC);
#pragma unroll
  for (int r = 0; r < 16; ++r) p1[r] = fmaf(p1[r], C, mnC);
#pragma unroll
  for (int r = 0; r < 16; ++r) p0[r] = __builtin_amdgcn_exp2f(p0[r]);
}
__device__ __forceinline__ void finishSM(f32x16& p0, f32x16& p1, float alpha, float& l_reg, f16x8& pa0, f16x8& pa1, f16x8& pa2, f16x8& pa3) {
#pragma unroll
  for (int r = 0; r < 16; ++r) p1[r] = __builtin_amdgcn_exp2f(p1[r]);
  float ps = 0;
#pragma unroll
  for (int r = 0; r < 16; ++r) ps += p0[r];
#pragma unroll
  for (int r = 0; r < 16; ++r) ps += p1[r];
  { auto rr = __builtin_amdgcn_permlane32_swap(__float_as_uint(ps), __float_as_uint(ps), false, false);
    ps = __uint_as_float(rr[0]) + __uint_as_float(rr[1]); }
  l_reg = l_reg * alpha + ps;
#define PK4(P, BASE, OUT) do { unsigned a0 = cvtpk(P[BASE + 0], P[BASE + 1]), a1 = cvtpk(P[BASE + 2], P[BASE + 3]);   \
    unsigned b0 = cvtpk(P[BASE + 4], P[BASE + 5]), b1 = cvtpk(P[BASE + 6], P[BASE + 7]);                              \
    auto r0 = __builtin_amdgcn_permlane32_swap(a0, b0, false, false); auto r1 = __builtin_amdgcn_permlane32_swap(a1, b1, false, false); \
    u32x4 w = {r0[0], r1[0], r0[1], r1[1]}; OUT = __builtin_bit_cast(f16x8, w); } while (0)
  PK4(p0, 0, pa0); PK4(p0, 8, pa1); PK4(p1, 0, pa2); PK4(p1, 8, pa3);
#undef PK4
}
__device__ __forceinline__ void qkt(f32x16& p0, f32x16& p1, const char* Ks, const f16x8* qr, int r32, int hi) {
  p0 = f32x16{}; p1 = f32x16{};
#pragma unroll
  for (int d0 = 0; d0 < 8; ++d0) { int cb = (d0 * 16 + hi * 8) * 2;
    f16x8 b0 = *reinterpret_cast<const f16x8*>(Ks + KSWZ(r32, cb));
    f16x8 b1 = *reinterpret_cast<const f16x8*>(Ks + KSWZ(32 + r32, cb));
    p0 = __builtin_amdgcn_mfma_f32_32x32x16_f16(b0, qr[d0], p0, 0, 0, 0);
    p1 = __builtin_amdgcn_mfma_f32_32x32x16_f16(b1, qr[d0], p1, 0, 0, 0); }
}
__device__ __forceinline__ int v_st(int k, int c) { const int kk = (k & ~0xC) | ((k & 4) << 1) | ((k & 8) >> 1); return ((kk >> 3) * 4 + (c >> 5)) * 512 + ((kk & 7) * 32 + (c & 31)) * 2; }
__device__ __forceinline__ int v_rd_base(int lane) { return ((lane & 3) << 3) | (((lane >> 2) & 3) << 6) | (((lane >> 4) & 1) << 5) | (((lane >> 5) & 1) << 8); }
constexpr int v_rd_off(int d0, int ks, int half) { return d0 * 512 + ks * 4096 + half * 2048; }
template <int OFF> __device__ __forceinline__ s16x4 tr_read(int vb) {
  s16x4 r; asm volatile("ds_read_b64_tr_b16 %0, %1 offset:%2" : "=&v"(r) : "v"(vb), "i"(OFF) : "memory"); return r;
}
template <int D0> __device__ __forceinline__ void pv_one(f32x16& od, int vb, f16x8 pa0, f16x8 pa1, f16x8 pa2, f16x8 pa3) {
  const s16x4 l0 = tr_read<v_rd_off(D0, 0, 0)>(vb), h0 = tr_read<v_rd_off(D0, 0, 1)>(vb), l1 = tr_read<v_rd_off(D0, 1, 0)>(vb), h1 = tr_read<v_rd_off(D0, 1, 1)>(vb);
  const s16x4 l2 = tr_read<v_rd_off(D0, 2, 0)>(vb), h2 = tr_read<v_rd_off(D0, 2, 1)>(vb), l3 = tr_read<v_rd_off(D0, 3, 0)>(vb), h3 = tr_read<v_rd_off(D0, 3, 1)>(vb);
  asm volatile("s_waitcnt lgkmcnt(0)" ::: "memory"); SBAR();
  typedef short s16x8 __attribute__((ext_vector_type(8)));
#define PK(Lo, Hi) __builtin_bit_cast(f16x8, (s16x8){Lo[0], Lo[1], Lo[2], Lo[3], Hi[0], Hi[1], Hi[2], Hi[3]})
  od = __builtin_amdgcn_mfma_f32_32x32x16_f16(pa0, PK(l0, h0), od, 0, 0, 0);
  od = __builtin_amdgcn_mfma_f32_32x32x16_f16(pa1, PK(l1, h1), od, 0, 0, 0);
  od = __builtin_amdgcn_mfma_f32_32x32x16_f16(pa2, PK(l2, h2), od, 0, 0, 0);
  od = __builtin_amdgcn_mfma_f32_32x32x16_f16(pa3, PK(l3, h3), od, 0, 0, 0);
#undef PK
}
__device__ __forceinline__ void pv_d0(f32x16* o, int vb, f16x8 pa0, f16x8 pa1, f16x8 pa2, f16x8 pa3) {
  pv_one<0>(o[0], vb, pa0, pa1, pa2, pa3); pv_one<1>(o[1], vb, pa0, pa1, pa2, pa3); pv_one<2>(o[2], vb, pa0, pa1, pa2, pa3); pv_one<3>(o[3], vb, pa0, pa1, pa2, pa3);
}
__device__ __forceinline__ void attn_dense_body(const f16* __restrict__ Qb, const f16* __restrict__ Kh, const f16* __restrict__ Vh, float* __restrict__ Ob, int seq, char* lds) {
  const int tid = ltid(), wid = tid >> 6, lane = tid & 63, r32 = lane & 31, hi = lane >> 5;
  char* V_lds = lds; char* K_lds = lds + 2 * SHM_V;
  float* ws = (float*)(lds + 2 * SHM_V + 2 * SHM_K) + wid * 64; float* li_l = ws; float* al_l = ws + 32;
  float m_reg = -1e30f, l_reg = 0; f32x16 o[4] = {}; f16x8 qr[8];
  const f16* Qw = Qb + (long)(wid * QBLK + r32) * LDQ + hi * 8;
#pragma unroll
  for (int d0 = 0; d0 < 8; ++d0) qr[d0] = *reinterpret_cast<const f16x8*>(Qw + d0 * 16);
  const int sr = tid >> 4, sc = (tid & 15) * 8, vst0 = v_st(sr, sc), vst1 = v_st(32 + sr, sc);
  const int vb0 = (int)(uintptr_t)V_lds + v_rd_base(lane);
  struct { f16x8 vs0, vs1, ks0, ks1; } sr_[2];
#define SLOAD(i, k0) do { sr_[i].vs0 = *(const f16x8*)(&Vh[(long)((k0) + sr) * LDV + sc]); sr_[i].vs1 = *(const f16x8*)(&Vh[(long)((k0) + 32 + sr) * LDV + sc]); \
    sr_[i].ks0 = *(const f16x8*)(&Kh[(long)((k0) + sr) * LDK + sc]); sr_[i].ks1 = *(const f16x8*)(&Kh[(long)((k0) + 32 + sr) * LDK + sc]); } while (0)
#define SWRITE(b, i) do { *(f16x8*)(V_lds + (b) * SHM_V + vst0) = sr_[i].vs0;          \
    *(f16x8*)(V_lds + (b) * SHM_V + vst1) = sr_[i].vs1; int kc = sc * 2;               \
    *(f16x8*)(K_lds + (b) * SHM_K + KSWZ(sr, kc)) = sr_[i].ks0;                       \
    *(f16x8*)(K_lds + (b) * SHM_K + KSWZ(32 + sr, kc)) = sr_[i].ks1; } while (0)
#define SWAIT() asm volatile("s_waitcnt vmcnt(4)" ::: "memory")
#define RESC(a) do { if (__any((a) < 1.f)) { if (hi == 0) al_l[r32] = (a); asm volatile("s_waitcnt lgkmcnt(0)" ::: "memory"); \
    _Pragma("unroll") for (int d = 0; d < 4; ++d) _Pragma("unroll") for (int r = 0; r < 16; ++r) o[d][r] *= al_l[crow(r, hi)]; } } while (0)
  f32x16 pA0, pA1, pB0, pB1; float mnA, mnB, alA, alB; f16x8 pa0, pa1, pa2, pa3; const int NTl = seq / KVBLK;
  constexpr int SE = 0, SO = 1;
  SLOAD(SE, 0); asm volatile("s_waitcnt vmcnt(0)" ::: "memory"); SWRITE(0, SE); __syncthreads();
  qkt(pA0, pA1, K_lds, qr, r32, hi); partialSM(pA0, pA1, m_reg, mnA, alA);
  SLOAD(SO, KVBLK); if (2 < NTl) SLOAD(SE, 2 * KVBLK);
  SWAIT(); SWRITE(1, SO); __syncthreads();
  for (int j = 1; j + 1 < NTl; j += 2) {
    SBAR(); qkt(pB0, pB1, K_lds + SHM_K, qr, r32, hi);
    finishSM(pA0, pA1, alA, l_reg, pa0, pa1, pa2, pa3); SBAR();
    SLOAD(SO, (j + 2) * KVBLK); SBAR();
    pv_d0(o, vb0, pa0, pa1, pa2, pa3); partialSM(pB0, pB1, m_reg, mnB, alB);
    __syncthreads(); SWAIT(); SWRITE(0, SE);
    RESC(alB); __syncthreads();
    SBAR(); qkt(pA0, pA1, K_lds, qr, r32, hi);
    finishSM(pB0, pB1, alB, l_reg, pa0, pa1, pa2, pa3); SBAR();
    if (j + 3 < NTl) SLOAD(SE, (j + 3) * KVBLK); SBAR();
    pv_d0(o, vb0 + (int)SHM_V, pa0, pa1, pa2, pa3); partialSM(pA0, pA1, m_reg, mnA, alA);
    __syncthreads(); SWAIT(); SWRITE(1, SO);
    RESC(alA); __syncthreads();
  }
  SBAR(); qkt(pB0, pB1, K_lds + SHM_K, qr, r32, hi);
  finishSM(pA0, pA1, alA, l_reg, pa0, pa1, pa2, pa3); SBAR();
  pv_d0(o, vb0, pa0, pa1, pa2, pa3); partialSM(pB0, pB1, m_reg, mnB, alB);
  __syncthreads(); RESC(alB);
  finishSM(pB0, pB1, alB, l_reg, pa0, pa1, pa2, pa3); SBAR();
  pv_d0(o, vb0 + (int)SHM_V, pa0, pa1, pa2, pa3);
  if (hi == 0) li_l[r32] = l_reg; asm volatile("s_waitcnt lgkmcnt(0)" ::: "memory");
  float rli[16];
#pragma unroll
  for (int r = 0; r < 16; ++r) rli[r] = __builtin_amdgcn_rcpf(li_l[crow(r, hi)]);
  float* Ow = Ob + (long)(wid * QBLK) * LDO;
#pragma unroll
  for (int r = 0; r < 16; ++r) { int orow = crow(r, hi);
#pragma unroll
    for (int d0 = 0; d0 < 4; ++d0) Ow[(long)orow * LDO + d0 * 32 + r32] = o[d0][r] * rli[r]; }
#undef SLOAD
#undef SWRITE
#undef SWAIT
#undef RESC
}
#undef KSWZ
#undef SBAR
__device__ __forceinline__ void attn_unit(const Args& a, int u, char* lds) {
  int b, hq, t0, seq;
  if (u < 256) { const int qb = u & 15, r = (u >> 4) & 3, g = (u >> 6) & 1; b = u >> 7; hq = g * 4 + r; t0 = NCTX + 256 * qb; seq = L; }
  else { const int v = u - 256; b = v >> 3; hq = v & 7; t0 = 0; seq = NCTX; }
  const size_t m0 = (size_t)b * L + t0, k0 = (size_t)b * L; const int g = hq >> 2;
  const f16* Kh = (const f16*)(a.ws + WS_KN) + k0 * 512 + g * 128;
  attn_dense_body((const f16*)(a.ws + WS_QN) + m0 * 1024 + hq * 128, Kh, Kh + 256, (float*)(a.ws + WS_AO) + m0 * 1024 + hq * 128, seq, lds);
}
}

__device__ __forceinline__ void ph_post(const Args& a, int l, int part = 3, int b0 = 0, int nb = 0) {
  const int tid = ltid(), lane = tid & 63, wave = tid >> 6;
  if (nb == 0) nb = gridDim.x;
  const int gw = (lbid() - b0) * 8 + wave, NGW = nb * 8;
  const f16* P = (const f16*)(a.ws + WS_P); f16* Y = (f16*)(a.ws + WS_Y);
  const float* YRW = (const float*)(a.ws + WS_YRW); const float* AO = (const float*)(a.ws + WS_AO); const float* HM = (const float*)(a.ws + WS_HM);
  const unsigned char* SIp = a.ws + WS_SI; const float* RKD = (const float*)(a.ws + WS_RKD);
  for (int m = gw; m < M; m += NGW) {
    const int lane = ltid() & 63, hq = lane >> 4, c4 = (lane & 15) * 4;
    const int b = m / L, t = m % L; const f16* pr = P + (size_t)m * NP; f16* yr = Y + (size_t)m * 3072;
    if (part & 1) {
    f32x4 ya[4], yb[4], vv[4], lw[4], lb[4]; f16x4 ga[4]; float rk[4];
#pragma unroll
    for (int g = 0; g < 4; ++g) { const int h = 4 * g + hq, c = h * 64 + c4;
      ya[g] = *(const f32x4*)(YRW + (size_t)m * 1024 + c); yb[g] = *(const f32x4*)(YRW + (size_t)(M + m) * 1024 + c);
      { const f16x4 vh = *(const f16x4*)(SIp + ((size_t)(b * 16 + h) * L + t) * SIR + 256 + c4 * 2); vv[g] = (f32x4){(float)vh[0], (float)vh[1], (float)vh[2], (float)vh[3]}; } ga[g] = *(const f16x4*)(pr + C_RWG + c);
      lw[g] = *(const f32x4*)(a.in[16] + l * 1024 + c); lb[g] = *(const f32x4*)(a.in[17] + l * 1024 + c); rk[g] = RKD[(size_t)m * 16 + h]; }
#pragma unroll
    for (int g = 0; g < 4; ++g) { const int c = (4 * g + hq) * 64 + c4; const f32x4 y = ya[g] + yb[g];
      const float mu = red16(y.x + y.y + y.z + y.w) * (1.f / 64.f); const f32x4 dv = y - mu;
      const float var = red16(dv.x * dv.x + dv.y * dv.y + dv.z * dv.z + dv.w * dv.w) * (1.f / 64.f); const float rs = rsqrtf(var + 64e-5f);
      float o[4];
#pragma unroll
      for (int e = 0; e < 4; ++e) o[e] = (dv[e] * rs * lw[g][e] + lb[g][e] + rk[g] * vv[g][e]) * silu_f((float)ga[g][e]);
      uint2 w; w.x = pkh(o[0], o[1]); w.y = pkh(o[2], o[3]); *(uint2*)(yr + c) = w; }
    }
    if (part & 2) {
    f32x4 ao[4]; f16x4 gb[4];
#pragma unroll
    for (int j = 0; j < 4; ++j) { const int c = j * 256 + lane * 4; ao[j] = *(const f32x4*)(AO + (size_t)m * 1024 + c); gb[j] = *(const f16x4*)(pr + C_ATG + c); }
    f32x4 ha[4], hb[4], ng[4]; f16x4 go[4], gg[4];
#pragma unroll
    for (int h = 0; h < 4; ++h) { const int c = h * 256 + lane * 4; ha[h] = *(const f32x4*)(HM + (size_t)m * 1024 + c); hb[h] = *(const f32x4*)(HM + (size_t)(M + m) * 1024 + c);
      ng[h] = *(const f32x4*)(a.in[21] + l * 1024 + c); go[h] = *(const f16x4*)(pr + C_MLO + c); gg[h] = *(const f16x4*)(pr + C_MLG + c); }
#pragma unroll
    for (int j = 0; j < 4; ++j) { const int c = j * 256 + lane * 4; float o[4];
#pragma unroll
      for (int e = 0; e < 4; ++e) o[e] = ao[j][e] * silu_f((float)gb[j][e]);
      uint2 w; w.x = pkh(o[0], o[1]); w.y = pkh(o[2], o[3]); *(uint2*)(yr + 1024 + c) = w; }
    float ss[4];
#pragma unroll
    for (int h = 0; h < 4; ++h) { ha[h] = ha[h] + hb[h]; ss[h] = ha[h].x * ha[h].x + ha[h].y * ha[h].y + ha[h].z * ha[h].z + ha[h].w * ha[h].w; }
#pragma unroll
    for (int o = 32; o >= 1; o >>= 1) {
#pragma unroll
      for (int h = 0; h < 4; ++h) ss[h] += __shfl_xor(ss[h], o); }
#pragma unroll
    for (int h = 0; h < 4; ++h) { const int c = h * 256 + lane * 4; const float rstd = rsqrtf(ss[h] * (1.f / 256.f) + 1e-6f); float o[4];
#pragma unroll
      for (int e = 0; e < 4; ++e) o[e] = sigm_f((float)go[h][e]) * (ha[h][e] * rstd * ng[h][e]) * silu_f((float)gg[h][e]);
      uint2 w; w.x = pkh(o[0], o[1]); w.y = pkh(o[2], o[3]); *(uint2*)(yr + 2048 + c) = w; }
    }
  }
}

__device__ __forceinline__ void ph_sum3(const Args& a) {
  const f16* G3 = (const f16*)(a.ws + WS_G3); const f16* G3b = (const f16*)(a.ws + WS_G3B); f16* MG = (f16*)(a.ws + WS_MRG);
  const size_t n8 = (size_t)M * D / 8;
  for (size_t i = (size_t)lbid() * NT + ltid(); i < n8; i += (size_t)gridDim.x * NT) {
    const f16x8 x = *(const f16x8*)(G3 + i * 8), y = *(const f16x8*)(G3b + i * 8), z = *(const f16x8*)(G3b + (size_t)M * D + i * 8);
    f16x8 o;
#pragma unroll
    for (int e = 0; e < 8; ++e) o[e] = (f16)((float)x[e] + (float)y[e] + (float)z[e]);
    *(f16x8*)(MG + i * 8) = o; }
}

__device__ __forceinline__ void ph_final(const Args& a) {
  const int tid = ltid(), lane = tid & 63, wave = tid >> 6;
  const int gw = lbid() * 8 + wave, NGW = gridDim.x * 8;
  const float* Z = (const float*)(a.ws + WS_Z); const float* fg = a.in[24];
  for (int r = gw; r < BATCH * SEQ; r += NGW) {
    const int b = r / SEQ, t = r % SEQ; const float* zr = Z + ((size_t)b * L + NCTX + t) * D; float* o = a.out + (size_t)r * D;
    f32x4 v[8]; float ss = 0.f;
#pragma unroll
    for (int j = 0; j < 8; ++j) { v[j] = *(const f32x4*)(zr + 4 * (lane + 64 * j)); ss += v[j].x * v[j].x + v[j].y * v[j].y + v[j].z * v[j].z + v[j].w * v[j].w; }
    const float rstd = rsqrtf(wave_sum(ss) * (1.f / D) + 1e-6f);
#pragma unroll
    for (int j = 0; j < 8; ++j) { const int k = 4 * (lane + 64 * j); *(f32x4*)(o + k) = v[j] * rstd * *(const f32x4*)(fg + k); }
  }
}


#define XLAS __attribute__((address_space(3)))
#define XB_TMO      128
#define XB_XCNT(j)  (256  + 64 * (j))
#define XB_XSUB(j)  (1280 + 64 * (j))
#define XB_XGEN(j)  (2304 + 64 * (j))
#define XB_TOP      3328
#define XB_TOPGEN   3392
#define XCD_BAR_WORDS 3456
#define XB_SPIN_CAP (1u << 18)
__device__ __forceinline__ unsigned xb_ld(unsigned* p)              { return __hip_atomic_load(p, __ATOMIC_RELAXED, __HIP_MEMORY_SCOPE_AGENT); }
__device__ __forceinline__ unsigned xb_add(unsigned* p, unsigned v) { return __hip_atomic_fetch_add(p, v, __ATOMIC_RELAXED, __HIP_MEMORY_SCOPE_AGENT); }
__device__ __forceinline__ unsigned xb_xcc_id() { return (unsigned)__builtin_amdgcn_s_getreg((3 << 11) | 20) & 0xFu; }
#define XB_SPIN(cond, bar) do { unsigned _sp = 0; while (cond) { __builtin_amdgcn_s_sleep(1); \
    if ((++_sp & 255u) == 0u) { if (xb_ld(&(bar)[XB_TMO])) break; if (_sp > XB_SPIN_CAP) { atomicAdd(&(bar)[XB_TMO], 1u); break; } } } } while (0)
struct XcdBarrier { unsigned* bar; unsigned x; volatile XLAS unsigned* st; };
__device__ __forceinline__ XcdBarrier xcd_barrier_post(unsigned* bar, volatile XLAS unsigned* st) {
    XcdBarrier b; b.bar = bar; b.x = xb_xcc_id(); b.st = st;
    if (threadIdx.x == 0) (void)xb_add(&bar[XB_XCNT(b.x)], 1u);
    return b;
}
__device__ __forceinline__ void xcd_barrier_complete(unsigned* bar, unsigned x, unsigned& nloc, unsigned& nx) {
    const unsigned G = gridDim.x * gridDim.y * gridDim.z;
    unsigned sum, cnt, mine, sp = 0u;
    for (;;) {
        sum = 0u; cnt = 0u; mine = 0u;
#pragma unroll
        for (unsigned j = 0; j < 16; ++j) { const unsigned c = xb_ld(&bar[XB_XCNT(j)]); sum += c; cnt += (c > 0u) ? 1u : 0u; mine = (j == x) ? c : mine; }
        if (sum == G) break;
        __builtin_amdgcn_s_sleep(1);
        if ((++sp & 255u) == 0u) { if (xb_ld(&bar[XB_TMO])) break; if (sp > XB_SPIN_CAP) { atomicAdd(&bar[XB_TMO], 1u); break; } }
    }
    nloc = mine > 0u ? mine : 1u; nx = cnt > 0u ? cnt : 1u;
}
__device__ __forceinline__ void xcd_barrier(const XcdBarrier& b) {
    asm volatile("s_waitcnt vmcnt(0)" ::: "memory");
    __syncthreads();
    if (threadIdx.x == 0) {
        unsigned* bar = b.bar;
        __builtin_amdgcn_s_waitcnt(0);
        unsigned nloc = b.st[0], nx = b.st[1];
        if (nloc == 0u) { xcd_barrier_complete(bar, b.x, nloc, nx); b.st[0] = nloc; b.st[1] = nx; }
        const unsigned old = xb_add(&bar[XB_XSUB(b.x)], 1u);
        const unsigned gen = old / nloc;
        if (old + 1u == (gen + 1u) * nloc) {
            __builtin_amdgcn_fence(__ATOMIC_RELEASE, "agent");
            asm volatile("s_waitcnt vmcnt(0)" ::: "memory");
            const unsigned og = xb_add(&bar[XB_TOP], 1u);
            const unsigned tg = og / nx;
            if (og + 1u == (tg + 1u) * nx) xb_add(&bar[XB_TOPGEN], 1u);
            else XB_SPIN(xb_ld(&bar[XB_TOPGEN]) == tg, bar);
            __builtin_amdgcn_fence(__ATOMIC_ACQUIRE, "agent");
            xb_add(&bar[XB_XGEN(b.x)], 1u);
            asm volatile("s_waitcnt vmcnt(0)" ::: "memory");
        } else {
            XB_SPIN(xb_ld(&bar[XB_XGEN(b.x)]) == gen, bar);
            __builtin_amdgcn_fence(__ATOMIC_ACQUIRE, "agent");
            asm volatile("s_waitcnt vmcnt(0)" ::: "memory");
        }
    }
    __syncthreads();
}


__device__ __forceinline__ void sub_barrier(unsigned* bar, volatile XLAS unsigned* st, unsigned G) {
    asm volatile("s_waitcnt vmcnt(0)" ::: "memory");
    __syncthreads();
    if (threadIdx.x == 0) {
        const unsigned x = xb_xcc_id();
        __builtin_amdgcn_s_waitcnt(0);
        unsigned nloc = st[0], nx = st[1];
        if (nloc == 0u) {
            unsigned sum, cnt, mine, sp = 0u;
            for (;;) { sum = 0u; cnt = 0u; mine = 0u;
#pragma unroll
                for (unsigned j = 0; j < 16; ++j) { const unsigned c = xb_ld(&bar[XB_XCNT(j)]); sum += c; cnt += (c > 0u) ? 1u : 0u; mine = (j == x) ? c : mine; }
                if (sum == G) break;
                __builtin_amdgcn_s_sleep(1);
                if ((++sp & 255u) == 0u) { if (xb_ld(&bar[XB_TMO])) break; if (sp > XB_SPIN_CAP) { atomicAdd(&bar[XB_TMO], 1u); break; } } }
            nloc = mine > 0u ? mine : 1u; nx = cnt > 0u ? cnt : 1u; st[0] = nloc; st[1] = nx; }
        const unsigned old = xb_add(&bar[XB_XSUB(x)], 1u);
        const unsigned gen = old / nloc;
        if (old + 1u == (gen + 1u) * nloc) {
            __builtin_amdgcn_fence(__ATOMIC_RELEASE, "agent");
            asm volatile("s_waitcnt vmcnt(0)" ::: "memory");
            const unsigned og = xb_add(&bar[XB_TOP], 1u);
            const unsigned tg = og / nx;
            if (og + 1u == (tg + 1u) * nx) xb_add(&bar[XB_TOPGEN], 1u);
            else XB_SPIN(xb_ld(&bar[XB_TOPGEN]) == tg, bar);
            __builtin_amdgcn_fence(__ATOMIC_ACQUIRE, "agent");
            xb_add(&bar[XB_XGEN(x)], 1u);
            asm volatile("s_waitcnt vmcnt(0)" ::: "memory");
        } else {
            XB_SPIN(xb_ld(&bar[XB_XGEN(x)]) == gen, bar);
            __builtin_amdgcn_fence(__ATOMIC_ACQUIRE, "agent");
            asm volatile("s_waitcnt vmcnt(0)" ::: "memory");
        }
    }
    __syncthreads();
}

__device__ __forceinline__ int mix_grab(unsigned* ctr, volatile unsigned* slot) {
  __syncthreads();
  if (ltid() == 0) *slot = __hip_atomic_fetch_add(ctr, 1u, __ATOMIC_RELAXED, __HIP_MEMORY_SCOPE_AGENT);
  __syncthreads();
  return (int)*slot;
}
constexpr int MFULL = 8192;
constexpr int NSCAN = 64;
constexpr int NT_RW = 13;
__device__ __forceinline__ void ph_mix(const Args& a, int l, unsigned char* lds) {
  const int bx0 = lbid();
  const bool xsplit = (gridDim.x == 256);
  const bool is_scan = xsplit ? ((bx0 & 7) < 2) : (bx0 < NSCAN);
  if (is_scan) { rw::scan_unit(a, xsplit ? ((bx0 >> 3) * 2 + (bx0 & 7)) : bx0, lds); return; }
  const int NB = gridDim.x - NSCAN;
  const int bx = NSCAN + (xsplit ? ((bx0 >> 3) * 6 + (bx0 & 7) - 2) : (bx0 - NSCAN));
  const int b0v = bx0 - (bx - NSCAN);
  unsigned* bar2 = (unsigned*)(a.ws + WS_CTL) + 8192 + l * XCD_BAR_WORDS;
  volatile XLAS unsigned* st2 = (volatile XLAS unsigned*)((XLAS unsigned char*)lds + (LDS_BYTES - 48));
  if (ltid() < 2) st2[ltid()] = 0u;
  __syncthreads();
  if (ltid() == 0) (void)xb_add(&bar2[XB_XCNT(xb_xcc_id())], 1u);
  { pg8::Gemm g{(const f16*)(a.ws + WS_H), (const f16*)(a.ws + WS_WIN) + (size_t)NT_RW * 256 * D, D, D, D, 1 << 20, 0}; pg8::StaticOrder So; So.init(M, NP - NT_RW * 256, NB, bx - NSCAN, 0, xsplit ? 6 : pg8::NXCD);
    pg8::gemm_phase((PG8_LAS unsigned char*)lds, g, So, pg8::EpiP{(f16*)(a.ws + WS_P), NT_RW * 256}); }
  sub_barrier(bar2, st2, (unsigned)NB);
  ph_prep(a, l, lds, 2, b0v, NB);
  sub_barrier(bar2, st2, (unsigned)NB);
  unsigned* ctr = (unsigned*)(a.ws + WS_CTL) + 64 * (1 + l);
  volatile unsigned* slot = (volatile unsigned*)(lds + LDS_BYTES - 64);
  int u = mix_grab(ctr, slot);
  while (u < 64) { ml::mlstm_unit(a, l, u, lds); u = mix_grab(ctr, slot); }
  while (u < 336) { att::attn_unit(a, u - 64, (char*)lds); u = mix_grab(ctr, slot); }
  sub_barrier(bar2, st2, (unsigned)NB);
  ph_post(a, l, 2, b0v, NB);
  sub_barrier(bar2, st2, (unsigned)NB);
  { pg8::Gemm g{(const f16*)(a.ws + WS_Y), (const f16*)(a.ws + WS_WBR), 3072, BR, BR, 8, 1024}; pg8::StaticOrder So; So.init(M, 2 * D, NB, bx - NSCAN, 8, xsplit ? 6 : pg8::NXCD);
    pg8::gemm_phase((PG8_LAS unsigned char*)lds, g, So, pg8::EpiBr{(f16*)(a.ws + WS_G3), (f16*)(a.ws + WS_G3B), (const f16*)(a.ws + WS_P), nullptr}); }
  if (l + 1 < DEPTH) ph_convert(a, l + 1, lds, 1, b0v, NB);
}

__global__ void __launch_bounds__(NT) mega(Args a) {
  extern __shared__ __attribute__((aligned(16))) unsigned char lds[];
  { volatile XLAS unsigned* st0 = (volatile XLAS unsigned*)((XLAS unsigned char*)lds + (LDS_BYTES - 48)); if (threadIdx.x < 6) st0[threadIdx.x] = 0u; }
  __syncthreads();
  (void)xcd_barrier_post((unsigned*)(a.ws + WS_CTL) + 4096, (volatile XLAS unsigned*)((XLAS unsigned char*)lds + (LDS_BYTES - 32)));
#define GRID_SYNC() do { XcdBarrier xb_; xb_.bar = (unsigned*)(a.ws + WS_CTL) + 4096; xb_.x = xb_xcc_id(); xb_.st = (volatile XLAS unsigned*)((XLAS unsigned char*)lds + (LDS_BYTES - 32)); xcd_barrier(xb_); } while (0)
  const f16* P = (const f16*)(a.ws + WS_P);
  ph_modv(a, lds); __syncthreads(); ph_convert(a, 0, lds, 3);
  GRID_SYNC();
#pragma unroll 1
  for (int l = 0; l < DEPTH; ++l) {
    if (l > 0) { ph_convert(a, l, lds, 2); __syncthreads(); }
    ph_norm(a, l, lds);
    GRID_SYNC();
    { pg8::Gemm g{(const f16*)(a.ws + WS_H), (const f16*)(a.ws + WS_WIN), D, D, D, 1 << 20, 0}; pg8::StaticOrder So; So.init(M, NT_RW * 256, gridDim.x, lbid());
      pg8::gemm_phase((PG8_LAS unsigned char*)lds, g, So, pg8::EpiP{(f16*)(a.ws + WS_P), 0}); }
    GRID_SYNC();
    ph_prep(a, l, lds, 1);
    GRID_SYNC();
    ph_mix(a, l, lds);
    GRID_SYNC();
    ph_post(a, l, 1);
    GRID_SYNC();
    { pg8::Gemm g{(const f16*)(a.ws + WS_Y), (const f16*)(a.ws + WS_WBR), 3072, BR, BR, 8, 1024}; pg8::StaticOrder So; So.init(MFULL, D, gridDim.x, lbid());
      pg8::gemm_phase((PG8_LAS unsigned char*)lds, g, So, pg8::EpiBr{(f16*)(a.ws + WS_G3), (f16*)(a.ws + WS_G3B), P, (f16*)(a.ws + WS_MRG)});
      tail_gemm((const f16*)(a.ws + WS_Y), 3072, (const f16*)(a.ws + WS_WBR), BR, MFULL, M - MFULL, D, BR, lds, EpiBranchMerge{(f16*)(a.ws + WS_MRG), (const f16*)(a.ws + WS_G3B), P}); }
    GRID_SYNC();
    { pg8::Gemm g{(const f16*)(a.ws + WS_MRG), (const f16*)(a.ws + WS_WOUT), D, D, D, 1 << 20, 0}; pg8::StaticOrder So; So.init(MFULL, D, gridDim.x, lbid());
      pg8::gemm_phase((PG8_LAS unsigned char*)lds, g, So, pg8::EpiZ{a, l});
      tail_gemm((const f16*)(a.ws + WS_MRG), D, (const f16*)(a.ws + WS_WOUT), D, MFULL, M - MFULL, D, D, lds, EpiOut{a, l}); }
    GRID_SYNC();
  }
  ph_final(a);
}

extern "C" void kernel_launch(void* const* d_in, const int* in_sizes, int n_in, void* d_out, int out_size, void* d_ws, size_t ws_size, hipStream_t stream) {
  static int grid_blocks = 0;
  if (grid_blocks == 0) {
    if (n_in != 25 || out_size != BATCH * SEQ * D || ws_size < WS_END) { fprintf(stderr, "kernel_launch: bad shapes n_in %d out %d ws %zu (need %zu)\n", n_in, out_size, ws_size, (size_t)WS_END); grid_blocks = -1; return; }
    if (hipFuncSetAttribute((const void*)mega, hipFuncAttributeMaxDynamicSharedMemorySize, LDS_BYTES) != hipSuccess) { fprintf(stderr, "kernel_launch: LDS attribute failed\n"); grid_blocks = -1; return; }
    int dev = 0, cus = 0, per_cu = 0;
    hipGetDevice(&dev); hipDeviceGetAttribute(&cus, hipDeviceAttributeMultiprocessorCount, dev);
    if (hipOccupancyMaxActiveBlocksPerMultiprocessor(&per_cu, (const void*)mega, NT, LDS_BYTES) != hipSuccess || per_cu < 1) { fprintf(stderr, "kernel_launch: occupancy query says %d\n", per_cu); (void)hipGetLastError(); per_cu = 1; }
    grid_blocks = cus * 1;
    fprintf(stderr, "kernel_launch: cus %d per_cu %d grid %d\n", cus, per_cu, grid_blocks);
  }
  if (grid_blocks < 0) return;
  (void)hipMemsetAsync((char*)d_ws + WS_CTL, 0, 65536, stream);
  Args a{};
  for (int i = 0; i < 25; ++i) a.in[i] = (const float*)d_in[i];
  a.out = (float*)d_out; a.ws = (unsigned char*)d_ws;
  hipLaunchKernelGGL(mega, dim3(grid_blocks), dim3(NT), LDS_BYTES, stream, a);
  const hipError_t e = hipPeekAtLastError();
  if (e != hipSuccess) fprintf(stderr, "launch failed: %s (grid %d)\n", hipGetErrorString(e), grid_blocks);
}
```

```cpp
#include <hip/hip_runtime.h>
#include <hip/hip_cooperative_groups.h>
#include <cstdio>
#include <cstdint>

constexpr int D = 2048, BATCH = 2, SEQ = 4096, NCTX = 256, L = NCTX + SEQ, M = BATCH * L, DEPTH = 2;
constexpr int NIN = 17168, NP = 17152;
constexpr int BR = 1024;
constexpr int C_R = 0, C_K = 1024, C_V = 2048, C_WD = 3072, C_AD = 3200, C_RWG = 3328, C_ATQ = 4352, C_ATK = 5376, C_ATV = 5632,
              C_ATG = 5888, C_MLQ = 6912, C_MLK = 7424, C_MLV = 7936, C_MLO = 8960, C_MLG = 9984, C_MRG = 11008;
constexpr int GATE_COL = 9984;
constexpr int SIV = 9 * 64;
constexpr int SIR = 912;

namespace cg = cooperative_groups;
typedef _Float16 f16;
typedef _Float16 f16x8 __attribute__((ext_vector_type(8)));
typedef _Float16 f16x4 __attribute__((ext_vector_type(4)));
typedef _Float16 f16x2 __attribute__((ext_vector_type(2)));
typedef float f32x4 __attribute__((ext_vector_type(4)));
typedef float f32x2 __attribute__((ext_vector_type(2)));
typedef unsigned u32x4 __attribute__((ext_vector_type(4)));

constexpr size_t MiB = 1u << 20;
constexpr size_t al(size_t x) { return (x + 255) / 256 * 256; }
constexpr size_t WS_CTL = 0;
constexpr size_t WS_MODV = 1 * MiB;
constexpr size_t WS_WIN = WS_MODV + al((size_t)2 * 3 * 6144 * 4);
constexpr size_t WS_WBR = WS_WIN + al((size_t)NP * D * 2);
constexpr size_t WS_WOUT = WS_WBR + al((size_t)3 * D * BR * 2);
constexpr size_t WS_H = WS_WOUT + al((size_t)D * D * 2);
constexpr size_t WS_QN = WS_H;
constexpr size_t WS_KN = WS_QN + al((size_t)M * 1024 * 2);
constexpr size_t WS_GPRE = WS_H + al((size_t)M * D * 2);
constexpr size_t WS_RKD = WS_GPRE + al((size_t)M * 16 * 4);
constexpr size_t WS_P = WS_RKD + al((size_t)M * 16 * 4);
constexpr size_t WS_SI = WS_P + al((size_t)M * NP * 2);
constexpr size_t WS_G3 = WS_SI;
constexpr size_t WS_MRG = WS_G3 + al((size_t)3 * M * D * 2);
constexpr size_t WS_YRW = WS_SI + al((size_t)BATCH * 16 * L * SIV * 4);
constexpr size_t WS_AO = WS_YRW + al((size_t)2 * M * 1024 * 4);
constexpr size_t WS_HM = WS_AO + al((size_t)M * 1024 * 4);
constexpr size_t WS_Y = WS_HM + al((size_t)2 * M * 1024 * 4);
constexpr size_t WS_Z = WS_Y + al((size_t)M * 3072 * 2);
constexpr size_t WS_G3B = WS_Z + al((size_t)M * D * 4);
constexpr size_t WS_END = WS_G3B + al((size_t)2 * M * D * 2);
static_assert(WS_MRG + (size_t)M * D * 2 <= WS_YRW, "G3|MERGED overlay fits in SI");
static_assert(WS_KN + (size_t)M * 512 * 2 <= WS_GPRE, "QN|KN overlay fits in H");

#ifndef PROBE_PHASE
#define PROBE_PHASE 0
#endif
constexpr int NT = 512;
constexpr int LDS_BYTES = 152 * 1024;

struct Args { const float* in[25]; float* out; unsigned char* ws; int ph_lo, ph_hi; };

__device__ __forceinline__ int ltid() { int t = threadIdx.x; asm volatile("" : "+v"(t)); return t; }
__device__ __forceinline__ int lbid() { int t = blockIdx.x; asm volatile("" : "+s"(t)); return t; }
__device__ __forceinline__ float wave_sum(float v) {
#pragma unroll
  for (int o = 32; o >= 1; o >>= 1) v += __shfl_xor(v, o);
  return v;
}
template <int CTRL> __device__ __forceinline__ float dppf(float x) { return __int_as_float(__builtin_amdgcn_update_dpp(0, __float_as_int(x), CTRL, 0xF, 0xF, true)); }
__device__ __forceinline__ float red16(float x) { x += dppf<0xB1>(x); x += dppf<0x4E>(x); x += dppf<0x141>(x); x += dppf<0x140>(x); return x; }
template <int CTRL> __device__ __forceinline__ float dppx(float x) { return __int_as_float(__builtin_amdgcn_update_dpp(0, __float_as_int(x), CTRL, 0xF, 0xF, true)); }
__device__ __forceinline__ float wsum_fast(float x) { x += dppx<0xB1>(x); x += dppx<0x4E>(x); x += dppx<0x141>(x); x += dppx<0x140>(x); x += __shfl_xor(x, 16); x += __shfl_xor(x, 32); return x; }

__device__ __forceinline__ float wave_max(float v) {
#pragma unroll
  for (int o = 32; o >= 1; o >>= 1) v = fmaxf(v, __shfl_xor(v, o));
  return v;
}
__device__ __forceinline__ float sigm_f(float x) { return __builtin_amdgcn_rcpf(1.f + __expf(-x)); }
__device__ __forceinline__ float silu_f(float x) { return x * sigm_f(x); }
__device__ __forceinline__ float tanh_f(float x) { const float t = __expf(-2.f * fabsf(x)); return copysignf((1.f - t) * __builtin_amdgcn_rcpf(1.f + t), x); }
__device__ __forceinline__ float softplus_f(float x) { return x > 20.f ? x : log1pf(expf(x)); }
__device__ __forceinline__ unsigned pkh(float lo, float hi) { f32x2 v = {lo, hi}; f16x2 h = __builtin_convertvector(v, f16x2); return __builtin_bit_cast(unsigned, h); }

__device__ __forceinline__ const float* zrow(const Args& a, int l, int m) {
  if (l > 0) return (const float*)(a.ws + WS_Z) + (size_t)m * D;
  const int b = m / L, t = m % L;
  return t < NCTX ? a.in[2] + ((size_t)b * NCTX + t) * D : a.in[0] + ((size_t)b * SEQ + (t - NCTX)) * D;
}

__device__ __forceinline__ void ph_modv(const Args& a, unsigned char* lds) {
  const int tid = ltid(), lane = tid & 63, wave = tid >> 6;
  float* sv = (float*)lds;
  float* red = sv + 3 * 2048;
  float* modv = (float*)(a.ws + WS_MODV);
  for (int i = tid; i < 3 * 2048; i += NT) { const int w = i / 2048, k = i % 2048; sv[i] = silu_f(w < 2 ? a.in[1][w * 2048 + k] : a.in[3][k]); }
  __syncthreads();
  for (int u = lbid(); u < 192; u += gridDim.x) {
    const int l = u / 96, j0 = (u % 96) * 64;
    const float* w = a.in[5] + (size_t)l * 2048 * 6144 + j0 + lane;
    float a0 = 0.f, a1 = 0.f, a2 = 0.f;
    for (int k = wave * 256; k < wave * 256 + 256; ++k) { const float wv = w[(size_t)k * 6144]; a0 += sv[k] * wv; a1 += sv[2048 + k] * wv; a2 += sv[4096 + k] * wv; }
    red[(wave * 3 + 0) * 64 + lane] = a0; red[(wave * 3 + 1) * 64 + lane] = a1; red[(wave * 3 + 2) * 64 + lane] = a2;
    __syncthreads();
    if (tid < 192) { const int i = tid >> 6; float s = a.in[6][l * 6144 + j0 + lane];
      for (int w8 = 0; w8 < 8; ++w8) s += red[(w8 * 3 + i) * 64 + lane];
      modv[(size_t)(l * 3 + i) * 6144 + j0 + lane] = s; }
    __syncthreads();
  }
}

__device__ __forceinline__ void transpose_item(const float* W, int ldw, int ncol0, int k0, f16* WT, int K, int row0, float* scr, int lane) {
#pragma unroll 8
  for (int i = 0; i < 32; ++i) { const int kk = 2 * i + (lane >> 5); scr[kk * 33 + (lane & 31)] = W[(size_t)(k0 + kk) * ldw + ncol0 + (lane & 31)]; }
  asm volatile("s_waitcnt lgkmcnt(0)" ::: "memory");
  const int c = lane & 7;
#pragma unroll
  for (int j = 0; j < 4; ++j) { const int n = (lane >> 3) + 8 * j; const float* s = scr + (8 * c) * 33 + n;
    u32x4 o; o.x = pkh(s[0 * 33], s[1 * 33]); o.y = pkh(s[2 * 33], s[3 * 33]); o.z = pkh(s[4 * 33], s[5 * 33]); o.w = pkh(s[6 * 33], s[7 * 33]);
    *(u32x4*)(WT + (size_t)(row0 + n) * K + k0 + 8 * c) = o; }
  asm volatile("s_waitcnt lgkmcnt(0)" ::: "memory");
}
__device__ __forceinline__ void ph_convert(const Args& a, int l, unsigned char* lds, int part = 3, int b0 = 0, int nb = 0) {
  const int tid = ltid(), lane = tid & 63, wave = tid >> 6;
  float* scr = (float*)lds + wave * (64 * 33);
  if (nb == 0) nb = gridDim.x;
  const int gw = (lbid() - b0) * 8 + wave, NGW = nb * 8;
  constexpr int I_IN = (D / 64) * (NP / 32), I_BR = (BR / 64) * (D / 32), I_OUT = (D / 64) * (D / 32);
  f16* WIN = (f16*)(a.ws + WS_WIN); f16* WBR = (f16*)(a.ws + WS_WBR); f16* WOUT = (f16*)(a.ws + WS_WOUT);
  for (int it = gw + ((part & 1) ? 0 : I_IN); it < ((part & 2) ? I_IN + 3 * I_BR + I_OUT : I_IN); it += NGW) {
    int r = it;
    if (r < I_IN) { const int nblk = NP / 32, kb = r / nblk, nb = r % nblk, n0 = nb * 32;
      transpose_item(a.in[7] + (size_t)l * D * NIN, NIN, n0 + (n0 >= GATE_COL ? 16 : 0), kb * 64, WIN, D, n0, scr, lane); continue; }
    r -= I_IN;
    if (r < 3 * I_BR) { const int br = r / I_BR, q = r % I_BR, nblk = D / 32, kb = q / nblk, nb = q % nblk;
      transpose_item(a.in[22] + ((size_t)l * 3 + br) * BR * D, D, nb * 32, kb * 64, WBR, BR, br * D + nb * 32, scr, lane); continue; }
    r -= 3 * I_BR;
    { const int nblk = D / 32, kb = r / nblk, nb = r % nblk;
      transpose_item(a.in[23] + (size_t)l * D * D, D, nb * 32, kb * 64, WOUT, D, nb * 32, scr, lane); }
  }
}

__device__ __forceinline__ void ph_norm(const Args& a, int l, unsigned char* lds) {
  const int tid = ltid(), lane = tid & 63, wave = tid >> 6;
  const int gw = lbid() * 8 + wave, NGW = gridDim.x * 8;
  float* wg = (float*)lds;
  { const float* w = a.in[7] + (size_t)l * D * NIN + GATE_COL;
    for (int i = tid; i < 2048 * 4; i += NT) { const int k = i >> 2, q = i & 3; const f32x4 v = *(const f32x4*)(w + (size_t)k * NIN + q * 4);
      wg[(q * 4 + 0) * 2048 + k] = v.x; wg[(q * 4 + 1) * 2048 + k] = v.y; wg[(q * 4 + 2) * 2048 + k] = v.z; wg[(q * 4 + 3) * 2048 + k] = v.w; } }
  __syncthreads();
  const float* modv = (const float*)(a.ws + WS_MODV) + (size_t)l * 3 * 6144;
  const float* ng = a.in[4] + l * D;
  f16* H = (f16*)(a.ws + WS_H); float* GP = (float*)(a.ws + WS_GPRE);
  for (int m = gw; m < M; m += NGW) {
    const int b = m / L, t = m % L; const float* zr = zrow(a, l, m);
    const float* mv = modv + (size_t)(t < NCTX ? 2 : b) * 6144;
    f32x4 v[8]; float ss = 0.f;
#pragma unroll
    for (int j = 0; j < 8; ++j) { v[j] = *(const f32x4*)(zr + 4 * (lane + 64 * j)); ss += v[j].x * v[j].x + v[j].y * v[j].y + v[j].z * v[j].z + v[j].w * v[j].w; }
    const float rstd = rsqrtf(wave_sum(ss) * (1.f / D) + 1e-6f);
#pragma unroll
    for (int j = 0; j < 8; ++j) { const int k = 4 * (lane + 64 * j);
      const f32x4 g = *(const f32x4*)(ng + k), sh = *(const f32x4*)(mv + k), sc = *(const f32x4*)(mv + 2048 + k);
      v[j] = (v[j] * rstd * g) * (1.f + sc) + sh;
      uint2 o; o.x = pkh(v[j].x, v[j].y); o.y = pkh(v[j].z, v[j].w); *(uint2*)(H + (size_t)m * D + k) = o; }
    float gsum = 0.f;
#pragma unroll 4
    for (int g = 0; g < 16; ++g) { float p = 0.f;
#pragma unroll
      for (int j = 0; j < 8; ++j) { const f32x4 w = *(const f32x4*)(wg + g * 2048 + 4 * (lane + 64 * j)); p += v[j].x * w.x + v[j].y * w.y + v[j].z * w.z + v[j].w * w.w; }
      p = wave_sum(p); if (lane == g) gsum = p; }
    if (lane < 16) GP[(size_t)m * 16 + lane] = gsum;
  }
}

template <class Epi>
__device__ __forceinline__ void tail_gemm(const f16* A, int lda, const f16* Bt, int ldb, int m0, int Mrows, int Ncols, int K, unsigned char* lds, const Epi& epi) {
  const int tid = ltid(), lane = tid & 63, wave = __builtin_amdgcn_readfirstlane(tid >> 6), fr = lane & 15, fq = lane >> 4;
  const int ntn = Ncols / 64, nun = (Mrows / 64) * ntn, KW = K / 8;
  float* part = (float*)lds;
  for (int u = lbid(); u < nun; u += (int)gridDim.x) {
    const int tm = u / ntn, tn = u % ntn;
    f32x4 acc[4][4];
#pragma unroll
    for (int i = 0; i < 4; ++i)
#pragma unroll
      for (int j = 0; j < 4; ++j) acc[i][j] = (f32x4){0.f, 0.f, 0.f, 0.f};
    const f16* ap = A + (size_t)(m0 + tm * 64 + fr) * lda + wave * KW + fq * 8; const f16* bp = Bt + (size_t)(tn * 64 + fr) * ldb + wave * KW + fq * 8;
    for (int k0 = 0; k0 < KW; k0 += 64) {
      f16x8 af[4], bf[4], an[4], bn[4];
#pragma unroll
      for (int i = 0; i < 4; ++i) { af[i] = *(const f16x8*)(ap + (size_t)i * 16 * lda + k0); bf[i] = *(const f16x8*)(bp + (size_t)i * 16 * ldb + k0);
                                    an[i] = *(const f16x8*)(ap + (size_t)i * 16 * lda + k0 + 32); bn[i] = *(const f16x8*)(bp + (size_t)i * 16 * ldb + k0 + 32); }
#pragma unroll
      for (int i = 0; i < 4; ++i)
#pragma unroll
        for (int j = 0; j < 4; ++j) { acc[i][j] = __builtin_amdgcn_mfma_f32_16x16x32_f16(af[i], bf[j], acc[i][j], 0, 0, 0); acc[i][j] = __builtin_amdgcn_mfma_f32_16x16x32_f16(an[i], bn[j], acc[i][j], 0, 0, 0); }
    }
    __syncthreads();
#pragma unroll
    for (int i = 0; i < 4; ++i)
#pragma unroll
      for (int j = 0; j < 4; ++j)
#pragma unroll
        for (int r = 0; r < 4; ++r) part[((wave * 16 + i * 4 + j) * 4 + r) * 64 + lane] = acc[i][j][r];
    __syncthreads();
#pragma unroll
    for (int q = 0; q < 2; ++q) { const int f = 2 * wave + q, i = f >> 2, j = f & 3;
#pragma unroll
      for (int r = 0; r < 4; ++r) { float v = 0.f;
#pragma unroll
        for (int w8 = 0; w8 < 8; ++w8) v += part[((w8 * 16 + f) * 4 + r) * 64 + lane];
        epi(m0 + tm * 64 + i * 16 + fq * 4 + r, tn * 64 + j * 16 + fr, v); } }
  }
}
struct EpiBranch { f16* O; const f16* P; int br; __device__ __forceinline__ void operator()(int m, int n, float v) const {
  const float g = sigm_f((float)P[(size_t)m * NP + C_MRG + br * D + n]); O[(size_t)m * D + n] = (f16)(g * v); } };
struct EpiBranchMerge { f16* MRG; const f16* G3b; const f16* P; __device__ __forceinline__ void operator()(int m, int n, float v) const {
  const float g = sigm_f((float)P[(size_t)m * NP + C_MRG + n]); MRG[(size_t)m * D + n] = (f16)(g * v + (float)G3b[(size_t)m * D + n] + (float)G3b[(size_t)M * D + (size_t)m * D + n]); } };
struct EpiOut { Args a; int l; __device__ __forceinline__ void operator()(int m, int n, float v) const {
  const int b = m / L, t = m % L; const float gt = ((const float*)(a.ws + WS_MODV))[(size_t)(l * 3 + (t < NCTX ? 2 : b)) * 6144 + 4096 + n];
  ((float*)(a.ws + WS_Z))[(size_t)m * D + n] = zrow(a, l, m)[n] + gt * v; } };


namespace pg8 {
#define PG8_LAS __attribute__((address_space(3)))
constexpr int BM = 256, BK = 64, HALF = 128, HTB = HALF * BK * 2  , STAGE_BYTES = 8 * HTB, NXCD = 8, WGM = 8;
__host__ __device__ __forceinline__ int lds_byte(int r, int c) { const int st = (r >> 4) * 2 + (c >> 5), rr = r & 15, cc = c & 31, ob = rr * 64 + cc * 2; return st * 1024 + (ob ^ (((ob >> 9) & 1) << 5)); }
__host__ __device__ __forceinline__ void stage_rc(int b, int& R, int& C) { const int st = b / 1024, sb = b % 1024, swz = sb ^ (((sb >> 9) & 1) << 5); R = (st >> 1) * 16 + swz / 64; C = (st & 1) * 32 + (swz % 64) / 2; }
__host__ __device__ __forceinline__ int perm32(int rho) { const int n = rho >> 4, i = rho & 15; return 8 * (i >> 2) + 4 * n + (i & 3); }
struct Unit { int pm, pn; };
struct Gemm { const f16* A; const f16* Bt; int lda, ldb, K, pn_grp, a_grp_cols; };
struct StaticOrder {
    int nM, nN, nwg, G, c, pn_off;
    __device__ void init(int M_, int N_, int G_, int c_, int pn_off_ = 0) { nM = M_ / BM; nN = N_ / BM; nwg = nM * nN; G = G_; c = c_; pn_off = pn_off_; }
    __device__ bool next(int i, Unit& u) const {
        const long Lx = (long)i * G + c; if (Lx >= nwg) return false;
        int wgid = (int)Lx; { const int q = nwg / NXCD, r = nwg % NXCD, xcd = wgid % NXCD, off = wgid / NXCD; wgid = (xcd < r ? xcd * (q + 1) : r * (q + 1) + (xcd - r) * q) + off; }
        const int nig = WGM * nN, gid = wgid / nig, fm = gid * WGM, gsz = (nM - fm) < WGM ? (nM - fm) : WGM;
        u.pm = fm + ((wgid % nig) % gsz); u.pn = pn_off + (wgid % nig) / gsz; return true;
    }
};
template <class Epi>
__device__ __forceinline__ void gemm_phase(PG8_LAS unsigned char* lds, const Gemm g, const StaticOrder& S, const Epi& E) {
    const int tid = ltid(), wid = __builtin_amdgcn_readfirstlane(tid >> 6), lane = tid & 63, wr = wid >> 2, wc = wid & 3, fr = lane & 15, fq = lane >> 4;
    const int K = g.K, nt = K / BK;
    unsigned voffA[2], voffB[2];
#pragma unroll
    for (int i = 0; i < 2; ++i) { int R, C; stage_rc(tid * 16 + i * 8192, R, C); const int Rb = Epi::PERM ? ((R & ~31) + perm32(R & 31)) : R;
        voffA[i] = (unsigned)(R * g.lda + C) * 2u; voffB[i] = (unsigned)(Rb * g.ldb + C) * 2u; }
    const size_t kstep = (size_t)(BK * 2);
    const size_t hstepA = (size_t)HALF * g.lda * 2, hstepB = (size_t)HALF * g.ldb * 2;
    const size_t tstepA = 2 * hstepA, tstepB = 2 * hstepB;
    const unsigned ldsw = (unsigned)wid * 1024u;
    const int aoff = lds_byte(wr * 64 + fr, fq * 8), boff = lds_byte(wc * 32 + fr, fq * 8);
#define PG8_SA(b, h) (((b) * 2 + (h)) * HTB)
#define PG8_SB(b, h) ((4 + (b) * 2 + (h)) * HTB)
#define PG8_STAGE(bufoff, gbase, voff) do { _Pragma("unroll") for (int _i = 0; _i < 2; ++_i) \
        __builtin_amdgcn_global_load_lds((const unsigned*)((const char*)(gbase) + (voff)[_i]), (PG8_LAS unsigned*)(lds + (bufoff) + ldsw + _i * 8192), 16, 0, 0); } while (0)
#define PG8_LDA(dst, b, h) do { _Pragma("unroll") for (int m = 0; m < 4; ++m) _Pragma("unroll") for (int k = 0; k < 2; ++k) dst[m][k] = *(const PG8_LAS f16x8*)(lds + PG8_SA(b, h) + aoff + m * 2048 + k * 1024); } while (0)
#define PG8_LDB(dst, b, h) do { _Pragma("unroll") for (int n = 0; n < 2; ++n) _Pragma("unroll") for (int k = 0; k < 2; ++k) dst[n][k] = *(const PG8_LAS f16x8*)(lds + PG8_SB(b, h) + boff + n * 2048 + k * 1024); } while (0)
#define PG8_MMA(ai, bj, At, Bt) do { __builtin_amdgcn_s_setprio(1); _Pragma("unroll") for (int m = 0; m < 4; ++m) _Pragma("unroll") for (int n = 0; n < 2; ++n) _Pragma("unroll") for (int k = 0; k < 2; ++k) \
        acc[ai][bj][m][n] = __builtin_amdgcn_mfma_f32_16x16x32_f16(Bt[n][k], At[m][k], acc[ai][bj][m][n], 0, 0, 0); __builtin_amdgcn_s_setprio(0); } while (0)
#define PG8_WAIT_V(n) asm volatile("s_waitcnt vmcnt(" #n ")" ::: "memory")
#define PG8_WAIT_L(n) asm volatile("s_waitcnt lgkmcnt(" #n ")" ::: "memory")
#define PG8_BAR __builtin_amdgcn_s_barrier()
#define PG8_SCHED __builtin_amdgcn_sched_barrier(0)
#define PG8_UA(u) ((const char*)g.A + (size_t)(u).pm * tstepA + (size_t)((u).pn / g.pn_grp) * g.a_grp_cols * 2)
#define PG8_UB(u) ((const char*)g.Bt + (size_t)(u).pn * tstepB)
    Unit cur, nxt; int ui = 0;
    if (!S.next(0, cur)) return;
    f32x4 acc[2][2][4][2];
#pragma unroll
    for (int a = 0; a < 2; ++a)
#pragma unroll
        for (int b = 0; b < 2; ++b)
#pragma unroll
            for (int m = 0; m < 4; ++m)
#pragma unroll
                for (int n = 0; n < 2; ++n) acc[a][b][m][n] = (f32x4){0.f, 0.f, 0.f, 0.f};
    f16x8 At[4][2], B0[2][2], B1[2][2];
    const char* cA = PG8_UA(cur); const char* cB = PG8_UB(cur);
    PG8_STAGE(PG8_SB(0, 0), cB, voffB); PG8_STAGE(PG8_SB(0, 1), cB + hstepB, voffB); PG8_STAGE(PG8_SA(0, 0), cA, voffA); PG8_STAGE(PG8_SA(0, 1), cA + hstepA, voffA);
    if (wr == 1) PG8_BAR;
    PG8_WAIT_V(2); PG8_BAR;
    PG8_STAGE(PG8_SB(1, 0), cB + kstep, voffB); PG8_STAGE(PG8_SA(1, 0), cA + kstep, voffA); PG8_STAGE(PG8_SB(1, 1), cB + hstepB + kstep, voffB);
    PG8_WAIT_V(6); PG8_BAR;
    for (;;) {
        const bool has_next = S.next(ui + 1, nxt);
        const char* nA = has_next ? PG8_UA(nxt) : cA; const char* nB = has_next ? PG8_UB(nxt) : cB;
        for (int t = 0; t < nt; t += 2) {
            const bool last = (t == nt - 2);
            const char* a1 = cA + (size_t)(t + 1) * kstep;
            const char* a2 = last ? nA : cA + (size_t)(t + 2) * kstep; const char* b2 = last ? nB : cB + (size_t)(t + 2) * kstep;
            const char* a3 = a2 + kstep; const char* b3 = b2 + kstep;
            PG8_LDB(B0, 0, 0); PG8_LDB(B1, 0, 1); PG8_SCHED; PG8_LDA(At, 0, 0); PG8_STAGE(PG8_SA(1, 1), a1 + hstepA, voffA);
            PG8_WAIT_V(8); PG8_WAIT_L(0); PG8_BAR; PG8_MMA(0, 0, At, B0); PG8_MMA(0, 1, At, B1); PG8_BAR; PG8_SCHED;
            PG8_LDA(At, 0, 1); PG8_STAGE(PG8_SB(0, 0), b2, voffB); PG8_STAGE(PG8_SB(0, 1), b2 + hstepB, voffB); PG8_STAGE(PG8_SA(0, 0), a2, voffA);
            PG8_WAIT_V(8); PG8_WAIT_L(0); PG8_BAR; PG8_MMA(1, 0, At, B0); PG8_MMA(1, 1, At, B1); PG8_BAR; PG8_SCHED;
            PG8_LDB(B0, 1, 0); PG8_LDB(B1, 1, 1); PG8_SCHED; PG8_LDA(At, 1, 0); PG8_STAGE(PG8_SA(0, 1), a2 + hstepA, voffA);
            PG8_WAIT_V(8); PG8_WAIT_L(0); PG8_BAR; PG8_MMA(0, 0, At, B0); PG8_MMA(0, 1, At, B1); PG8_BAR; PG8_SCHED;
            PG8_LDA(At, 1, 1); PG8_STAGE(PG8_SB(1, 0), b3, voffB); PG8_STAGE(PG8_SB(1, 1), b3 + hstepB, voffB); PG8_STAGE(PG8_SA(1, 0), a3, voffA);
            PG8_WAIT_V(8); PG8_WAIT_L(0); PG8_BAR; PG8_MMA(1, 0, At, B0); PG8_MMA(1, 1, At, B1); PG8_BAR; PG8_SCHED;
        }
        if (wr == 0) PG8_BAR;
        E(acc, cur, wr, wc, fr, fq);
        if (!has_next) break;
#pragma unroll
        for (int a = 0; a < 2; ++a)
#pragma unroll
            for (int b = 0; b < 2; ++b)
#pragma unroll
                for (int m = 0; m < 4; ++m)
#pragma unroll
                    for (int n = 0; n < 2; ++n) acc[a][b][m][n] = (f32x4){0.f, 0.f, 0.f, 0.f};
        cur = nxt; cA = nA; cB = nB; ++ui;
        if (wr == 1) PG8_BAR;
    }
    PG8_WAIT_V(0);
    PG8_BAR;
#undef PG8_SA
#undef PG8_SB
#undef PG8_STAGE
#undef PG8_LDA
#undef PG8_LDB
#undef PG8_MMA
#undef PG8_WAIT_V
#undef PG8_WAIT_L
#undef PG8_BAR
#undef PG8_SCHED
#undef PG8_UA
#undef PG8_UB
}
struct EpiP { static constexpr bool PERM = true; f16* O; int coff;
    __device__ __forceinline__ void operator()(const f32x4 (&acc)[2][2][4][2], const Unit& u, int wr, int wc, int fr, int fq) const {
        const int row0 = u.pm * BM + wr * 64 + fr, col0 = coff + u.pn * BM + wc * 32 + 8 * fq;
#pragma unroll
        for (int ai = 0; ai < 2; ++ai)
#pragma unroll
            for (int m = 0; m < 4; ++m) { f16* rowp = O + (size_t)(row0 + ai * HALF + m * 16) * NP + col0;
#pragma unroll
                for (int bj = 0; bj < 2; ++bj) { const f32x4 v0 = acc[ai][bj][m][0], v1 = acc[ai][bj][m][1];
                    u32x4 w; w.x = pkh(v0[0], v0[1]); w.y = pkh(v0[2], v0[3]); w.z = pkh(v1[0], v1[1]); w.w = pkh(v1[2], v1[3]);
                    *(u32x4*)(rowp + bj * HALF) = w; } }
    }
};
struct EpiBr { static constexpr bool PERM = true; f16* G3; f16* G3b; const f16* P; f16* MRG;
    __device__ __forceinline__ void operator()(const f32x4 (&acc)[2][2][4][2], const Unit& u, int wr, int wc, int fr, int fq) const {
        const int row0 = u.pm * BM + wr * 64 + fr, colg = u.pn * BM + wc * 32 + 8 * fq, br = u.pn >> 3, col0 = colg - br * D;
        f16* Ob = MRG ? MRG : G3b + (size_t)(br - 1) * M * D;
#pragma unroll
        for (int ai = 0; ai < 2; ++ai)
#pragma unroll
            for (int m = 0; m < 4; ++m) { const int row = row0 + ai * HALF + m * 16;
#pragma unroll
                for (int bj = 0; bj < 2; ++bj) { const f32x4 v0 = acc[ai][bj][m][0], v1 = acc[ai][bj][m][1];
                    const f16x8 gp = *(const f16x8*)(P + (size_t)row * NP + C_MRG + colg + bj * HALF);
                    float o[8];
#pragma unroll
                    for (int e = 0; e < 8; ++e) o[e] = (e < 4 ? v0[e] : v1[e - 4]) * __builtin_amdgcn_rcpf(1.f + __expf(-(float)gp[e]));
                    if (MRG) { const f16x8 x1 = *(const f16x8*)(G3b + (size_t)row * D + col0 + bj * HALF), x2 = *(const f16x8*)(G3b + (size_t)M * D + (size_t)row * D + col0 + bj * HALF);
#pragma unroll
                        for (int e = 0; e < 8; ++e) o[e] += (float)x1[e] + (float)x2[e]; }
                    u32x4 w; w.x = pkh(o[0], o[1]); w.y = pkh(o[2], o[3]); w.z = pkh(o[4], o[5]); w.w = pkh(o[6], o[7]);
                    *(u32x4*)(Ob + (size_t)row * D + col0 + bj * HALF) = w; } }
    }
};
struct EpiZ { static constexpr bool PERM = false; Args a; int l;
    __device__ __forceinline__ void operator()(const f32x4 (&acc)[2][2][4][2], const Unit& u, int wr, int wc, int fr, int fq) const {
        const int row0 = u.pm * BM + wr * 64 + fr, col0 = u.pn * BM + wc * 32 + 4 * fq;
        float* Z = (float*)(a.ws + WS_Z); const float* modv = (const float*)(a.ws + WS_MODV) + (size_t)l * 3 * 6144 + 4096;
#pragma unroll
        for (int ai = 0; ai < 2; ++ai)
#pragma unroll
            for (int m = 0; m < 4; ++m) { const int row = row0 + ai * HALF + m * 16; const int b = row / L, t = row % L;
                const float* zr = zrow(a, l, row); const float* gt = modv + (size_t)(t < NCTX ? 2 : b) * 6144;
#pragma unroll
                for (int bj = 0; bj < 2; ++bj)
#pragma unroll
                    for (int n = 0; n < 2; ++n) { const int c = col0 + bj * HALF + n * 16;
                        const f32x4 zo = *(const f32x4*)(zr + c), gv = *(const f32x4*)(gt + c);
                        *(f32x4*)(Z + (size_t)row * D + c) = zo + gv * acc[ai][bj][m][n]; } }
    }
};
}

__device__ __forceinline__ float shifted(const f16* P, const float* mu, int m, int col) {
  const int t = m % L; const float s = (float)P[(size_t)m * NP + col];
  const float pv = (t == 0 || t == NCTX) ? 0.f : (float)P[(size_t)(m - 1) * NP + col];
  const float nx = (t == L - 1 || t == NCTX - 1) ? 0.f : (float)P[(size_t)(m + 1) * NP + col];
  return s + mu[col] * (pv - s) + mu[3328 + col] * (nx - s);
}
namespace pp {
constexpr int WTP = 72, RAWP = 456, XAP = 72;
constexpr int OFF_WT = 0, OFF_RAW = OFF_WT + 4 * 64 * WTP * 2, OFF_XA = OFF_RAW + 34 * RAWP * 2, OFF_SH = OFF_XA + 4 * 32 * XAP * 2, OFF_NR = OFF_SH + 3 * 32 * 64 * 4, OFF_CST = OFF_NR + 256, OFF_END = OFF_CST + 1344 * 4;
static_assert(OFF_END <= LDS_BYTES, "prep LDS");
}
__device__ __forceinline__ void ph_prep(const Args& a, int l, unsigned char* lds, int part = 3, int b0 = 0, int nb = 0) {
  using namespace pp;
  const int tid = ltid(), lane = tid & 63, wave = __builtin_amdgcn_readfirstlane(tid >> 6), fr = lane & 15, fq = lane >> 4;
  const f16* P = (const f16*)(a.ws + WS_P);
  const float* mu = a.in[8] + (size_t)l * 2 * 3328;
  f16* WT = (f16*)(lds + OFF_WT); f16* RAW = (f16*)(lds + OFF_RAW); f16* XA = (f16*)(lds + OFF_XA); float* SH = (float*)(lds + OFF_SH); float* NRI = (float*)(lds + OFF_NR); float* CST = (float*)(lds + OFF_CST);
  float* RKD = (float*)(a.ws + WS_RKD);
  int cur_h = -1;
  const int NU = 272 * 16;
  f16x8 pre[4];
#define PREP_LOAD(u_) do { const int h_ = (u_) & 15, m0_ = ((u_) >> 4) * 32; \
    _Pragma("unroll") for (int i = 0; i < 4; ++i) { const int q = tid + NT * i; if (q < 34 * 56) { const int row = q / 56, cu = q % 56; int mm = m0_ - 1 + row; mm = mm < 0 ? 0 : (mm > M - 1 ? M - 1 : mm); \
      const int col = cu < 24 ? (cu >> 3) * 1024 + h_ * 64 + (cu & 7) * 8 : C_WD + (cu - 24) * 8; pre[i] = *(const f16x8*)(P + (size_t)mm * NP + col); } } } while (0)
  const int pg_ = lbid() >> 4, ph_ = lbid() & 15;
  const bool pbal = (gridDim.x == 256);
  const int pt0 = pbal ? (pg_ < 4 ? pg_ * 14 : 56 + (pg_ - 4) * 18) : pg_, pcnt = pbal ? (pg_ < 4 ? 14 : 18) : (272 - pg_ + (int)(gridDim.x >> 4) - 1) / (int)(gridDim.x >> 4), pstep = pbal ? 1 : (int)(gridDim.x >> 4);
  (void)NU;
  if ((part & 1) && pcnt > 0) PREP_LOAD((pt0 * 16 + ph_));
  if (part & 1)
  for (int pk = 0; pk < pcnt; ++pk) { const int u = (pt0 + pk * pstep) * 16 + ph_;
    const int tid = ltid(), lane = tid & 63, wave = __builtin_amdgcn_readfirstlane(tid >> 6), fr = lane & 15, fq = lane >> 4;
    const int h = u & 15, m0 = (u >> 4) * 32, b = m0 / L, t0 = m0 % L;
    __syncthreads();
    if (h != cur_h) { cur_h = h;
#pragma unroll 4
      for (int i = tid; i < 4 * 64 * 64; i += NT) { const int mt = i >> 12, j = (i >> 6) & 63, c = i & 63, d = mt >> 1;
        const float* src = (mt & 1) ? a.in[11] : a.in[9];
        WT[(mt * 64 + c) * WTP + j] = (f16)src[(((size_t)l * 2 + d) * 64 + j) * 1024 + h * 64 + c]; }
      for (int i = tid; i < 1344; i += NT) { float v;
        if (i < 512) v = mu[(i >> 8) * 3328 + C_WD + (i & 255)];
        else if (i < 896) { const int q = i - 512, w1 = q / 192, e = q % 192; v = mu[w1 * 3328 + (e >> 6) * 1024 + h * 64 + (e & 63)]; }
        else if (i < 960) v = a.in[13][l * 1024 + h * 64 + (i - 896)];
        else if (i < 1024) v = a.in[14][l * 1024 + h * 64 + (i - 960)];
        else if (i < 1088) v = a.in[15][l * 1024 + h * 64 + (i - 1024)];
        else if (i < 1216) { const int q = i - 1088; v = a.in[10][(l * 2 + (q >> 6)) * 1024 + h * 64 + (q & 63)]; }
        else { const int q = i - 1216; v = a.in[12][(l * 2 + (q >> 6)) * 1024 + h * 64 + (q & 63)]; }
        CST[i] = v; } }
#pragma unroll
    for (int i = 0; i < 4; ++i) { const int q = tid + NT * i; if (q < 34 * 56) { const int row = q / 56, cu = q % 56;
      *(f16x8*)(RAW + row * RAWP + (cu < 24 ? cu * 8 : 192 + (cu - 24) * 8)) = pre[i]; } }
    __syncthreads();
    if (pk + 1 < pcnt) PREP_LOAD((u + pstep * 16));
    { const int tok = tid >> 4, cg = tid & 15, t = t0 + tok; const bool zp = (t == 0 || t == NCTX), zn = (t == L - 1 || t == NCTX - 1);
      const f16* rp = RAW + tok * RAWP + 192 + 16 * cg;
      const int c0 = 16 * cg, mt = c0 < 128 ? 2 * (c0 >> 6) : 2 * ((c0 - 128) >> 6) + 1, j0 = c0 & 63;
#pragma unroll
      for (int hf = 0; hf < 2; ++hf) { const f16x8 pv = *(const f16x8*)(rp + hf * 8), cv = *(const f16x8*)(rp + RAWP + hf * 8), nv = *(const f16x8*)(rp + 2 * RAWP + hf * 8);
        const float* m0p = CST + c0 + hf * 8; f16x8 o;
#pragma unroll
        for (int e = 0; e < 8; ++e) { const float sv = (float)cv[e], p = zp ? 0.f : (float)pv[e], n = zn ? 0.f : (float)nv[e];
          float x = sv + m0p[e] * (p - sv) + m0p[256 + e] * (n - sv); if (!(mt & 1)) x = tanh_f(x); o[e] = (f16)x; }
        *(f16x8*)(XA + (mt * 32 + tok) * XAP + j0 + hf * 8) = o; } }
#pragma unroll
    for (int it = 0; it < 2; ++it) { const int q = tid + NT * it; if (q < 32 * 24) { const int tok = q / 24, g8 = q % 24, seg = g8 >> 3, ch = (g8 & 7) * 8, t = t0 + tok;
        const bool zp = (t == 0 || t == NCTX), zn = (t == L - 1 || t == NCTX - 1);
        const f16* rp = RAW + tok * RAWP + g8 * 8; const f16x8 pv = *(const f16x8*)rp, cv = *(const f16x8*)(rp + RAWP), nv = *(const f16x8*)(rp + 2 * RAWP);
        const float* m0p = CST + 512 + seg * 64 + ch; float o[8];
#pragma unroll
        for (int e = 0; e < 8; ++e) { const float sv = (float)cv[e], p = zp ? 0.f : (float)pv[e], n = zn ? 0.f : (float)nv[e]; o[e] = sv + m0p[e] * (p - sv) + m0p[192 + e] * (n - sv); }
        float* dst = SH + (seg * 32 + tok) * 64 + ch; *(f32x4*)dst = (f32x4){o[0], o[1], o[2], o[3]}; *(f32x4*)(dst + 4) = (f32x4){o[4], o[5], o[6], o[7]}; } }
    __syncthreads();
    const int ti = wave & 1, d = (wave >> 1) & 1, chalf = wave >> 2;
    f32x4 acc[2][2];
#pragma unroll
    for (int m2 = 0; m2 < 2; ++m2)
#pragma unroll
      for (int c2 = 0; c2 < 2; ++c2) { acc[m2][c2] = (f32x4){0.f, 0.f, 0.f, 0.f};
#pragma unroll
        for (int ks = 0; ks < 2; ++ks) acc[m2][c2] = __builtin_amdgcn_mfma_f32_16x16x32_f16(*(const f16x8*)(XA + ((2 * d + m2) * 32 + 16 * ti + fr) * XAP + ks * 32 + fq * 8),
                                                                                             *(const f16x8*)(WT + ((2 * d + m2) * 64 + 16 * (2 * chalf + c2) + fr) * WTP + ks * 32 + fq * 8), acc[m2][c2], 0, 0, 0); }
    __syncthreads();
    unsigned char* SR = lds + OFF_RAW;
    { const int tok = 4 * wave + (lane >> 4), c4 = (lane & 15) * 4;
      const f32x4 r4 = *(const f32x4*)(SH + (0 * 32 + tok) * 64 + c4), k4 = *(const f32x4*)(SH + (1 * 32 + tok) * 64 + c4), v4 = *(const f32x4*)(SH + (2 * 32 + tok) * 64 + c4);
      const f32x4 kkw = *(const f32x4*)(CST + 896 + c4), rkw = *(const f32x4*)(CST + 1024 + c4);
      const f32x4 kk = k4 * kkw, rkp = r4 * k4 * rkw;
      const float n2 = red16((kk.x * kk.x + kk.y * kk.y) + (kk.z * kk.z + kk.w * kk.w)), rk = red16((rkp.x + rkp.y) + (rkp.z + rkp.w));
      const float inv = 1.f / fmaxf(sqrtf(n2), 1e-12f);
      unsigned char* o = SR + tok * SIR + c4 * 2;
      uint2 w; w.x = pkh(r4.x, r4.y); w.y = pkh(r4.z, r4.w); *(uint2*)o = w;
      w.x = pkh(k4.x, k4.y); w.y = pkh(k4.z, k4.w); *(uint2*)(o + 128) = w;
      w.x = pkh(v4.x, v4.y); w.y = pkh(v4.z, v4.w); *(uint2*)(o + 256) = w;
      if ((lane & 15) == 0) { *(f32x4*)(SR + tok * SIR + 384) = (f32x4){inv, 0.f, 0.f, 0.f}; RKD[(size_t)(m0 + tok) * 16 + h] = rk; } }
#pragma unroll
    for (int c2 = 0; c2 < 2; ++c2) { const int ch = 16 * (2 * chalf + c2) + fr, c = h * 64 + ch;
      const float w0v = CST[1088 + d * 64 + ch], a0v = CST[1216 + d * 64 + ch];
#pragma unroll
      for (int r = 0; r < 4; ++r) { const int tok = 16 * ti + 4 * fq + r;
        const float wl = w0v + acc[0][c2][r]; const float dec = __expf(-0.6065306597126334f * sigm_f(wl));
        const float ag = sigm_f(a0v + acc[1][c2][r]);
        unsigned char* o = SR + tok * SIR + 400 + d * 256;
        ((f16*)o)[ch] = (f16)(1.f - dec); ((f16*)(o + 128))[ch] = (f16)ag; } }
    __syncthreads();
    { unsigned char* dstg = a.ws + WS_SI + ((size_t)(b * 16 + h) * L + t0) * SIR;
#pragma unroll
      for (int i = 0; i < 4; ++i) { const int q = tid + NT * i; if (q < 32 * SIR / 16) *(u32x4*)(dstg + (size_t)q * 16) = *(const u32x4*)(SR + q * 16); } }
  }
#undef PREP_LOAD
  __syncthreads();
  f16* QN = (f16*)(a.ws + WS_QN); f16* KN = (f16*)(a.ws + WS_KN);
  f32x2* cst = (f32x2*)lds;
  for (int i = tid; i < 64 * 32; i += NT) { const int pos = i >> 5, fi = i & 31; const float ang = (float)pos * powf(10000.f, -(float)(2 * fi) / 64.f); cst[i] = (f32x2){cosf(ang), sinf(ang)}; }
  __syncthreads();
  if (nb == 0) nb = gridDim.x;
  const int gw = (lbid() - b0) * 8 + wave, NGW = nb * 8;
  const int ax = lane >> 5, fi = lane & 31;
  if (part & 2)
  for (int m = gw; m < M; m += NGW) {
    const int t = m % L; const f16* pr = P + (size_t)m * NP;
    float x1[10], x2[10], ss[10];
#pragma unroll
    for (int hh = 0; hh < 10; ++hh) { const int src = hh < 8 ? C_ATQ + hh * 128 : C_ATK + (hh - 8) * 128; x1[hh] = (float)pr[src + ax * 64 + fi]; x2[hh] = (float)pr[src + ax * 64 + 32 + fi]; ss[hh] = x1[hh] * x1[hh] + x2[hh] * x2[hh]; }
    const f16x4 vc = *(const f16x4*)(pr + C_ATV + 4 * lane);
#pragma unroll
    for (int hh = 0; hh < 10; ++hh) ss[hh] = wave_sum(ss[hh]);
    f32x2 cs = {1.f, 0.f};
    if (t >= NCTX) { const int n = t - NCTX; cs = cst[(ax == 0 ? n / 64 : n % 64) * 32 + fi]; }
#pragma unroll
    for (int hh = 0; hh < 10; ++hh) { const float* g = (hh < 8 ? a.in[18] : a.in[19]) + l * 128; const float rstd = rsqrtf(ss[hh] * (1.f / 128.f) + 1e-6f);
      const float y1 = x1[hh] * rstd * g[ax * 64 + fi], y2 = x2[hh] * rstd * g[ax * 64 + 32 + fi];
      f16* dst = hh < 8 ? QN + (size_t)m * 1024 + hh * 128 : KN + (size_t)m * 512 + (hh - 8) * 128;
      dst[ax * 64 + fi] = (f16)(y1 * cs.x - y2 * cs.y); dst[ax * 64 + 32 + fi] = (f16)(y1 * cs.y + y2 * cs.x); }
    *(f16x4*)(KN + (size_t)m * 512 + 256 + 4 * lane) = vc;
  }
}

__device__ __forceinline__ int scan_tok(int dir, int i) { return dir == 0 ? i : (i < NCTX ? NCTX - 1 - i : L - 1 - (i - NCTX)); }

namespace rw {
constexpr int T = 16;
constexpr int STEPF = 6 * 64;
constexpr int BUFF = T * STEPF;
constexpr int YR_OFF = 2 * BUFF, YRING = T * 512;
template <int CTRL> __device__ __forceinline__ float dpp(float x) { return __int_as_float(__builtin_amdgcn_update_dpp(0, __float_as_int(x), CTRL, 0xF, 0xF, true)); }
__device__ __forceinline__ float red8(float x) { x += dpp<0xB1>(x); x += dpp<0x4E>(x); x += dpp<0x141>(x); return x; }
struct Ops { f32x4 r0, r1, k0, k1, w0, w1, b0, b1, d0, d1; f32x2 v; };
typedef __attribute__((address_space(3))) const float lcf;
__device__ __forceinline__ void ld_ops(Ops& o, lcf* st, lcf* vp) {
  o.r0 = *(const __attribute__((address_space(3))) f32x4*)(st); o.r1 = *(const __attribute__((address_space(3))) f32x4*)(st + 4);
  o.k0 = *(const __attribute__((address_space(3))) f32x4*)(st + 64); o.k1 = *(const __attribute__((address_space(3))) f32x4*)(st + 68);
  o.w0 = *(const __attribute__((address_space(3))) f32x4*)(st + 192); o.w1 = *(const __attribute__((address_space(3))) f32x4*)(st + 196);
  o.b0 = *(const __attribute__((address_space(3))) f32x4*)(st + 256); o.b1 = *(const __attribute__((address_space(3))) f32x4*)(st + 260);
  o.d0 = *(const __attribute__((address_space(3))) f32x4*)(st + 320); o.d1 = *(const __attribute__((address_space(3))) f32x4*)(st + 324);
  o.v = *(const __attribute__((address_space(3))) f32x2*)(vp);
}
#define RW_LO(v_) __builtin_shufflevector(v_, v_, 0, 1)
#define RW_HI(v_) __builtin_shufflevector(v_, v_, 2, 3)
#define RW_FMA(a_, b_, c_) __builtin_elementwise_fma(a_, b_, c_)
#define RW_DPP(r_, ctrl) "v_add_f32_dpp " r_ ", " r_ ", " r_ " " ctrl " row_mask:0xf bank_mask:0xf bound_ctrl:1\n\t"
__device__ __forceinline__ void step(f32x2 (&S0)[4], f32x2 (&S1)[4], const Ops& o, __attribute__((address_space(3))) f32x2* yw) {
  const f32x2 K[4] = {RW_LO(o.k0), RW_HI(o.k0), RW_LO(o.k1), RW_HI(o.k1)}, R[4] = {RW_LO(o.r0), RW_HI(o.r0), RW_LO(o.r1), RW_HI(o.r1)};
  const f32x2 W[4] = {RW_LO(o.w0), RW_HI(o.w0), RW_LO(o.w1), RW_HI(o.w1)}, Bv[4] = {RW_LO(o.b0), RW_HI(o.b0), RW_LO(o.b1), RW_HI(o.b1)};
  const f32x2 Dv[4] = {RW_LO(o.d0), RW_HI(o.d0), RW_LO(o.d1), RW_HI(o.d1)};
  f32x2 a0 = S0[0] * K[0], a1 = S1[0] * K[0];
#pragma unroll
  for (int j = 1; j < 4; ++j) { a0 = RW_FMA(S0[j], K[j], a0); a1 = RW_FMA(S1[j], K[j], a1); }
  float x0 = a0.x + a0.y, x1 = a1.x + a1.y;
  f32x2 m0, m1;
  asm("s_nop 1\n\t" RW_DPP("%0", "quad_perm:[1,0,3,2]") RW_DPP("%1", "quad_perm:[1,0,3,2]") "v_pk_mul_f32 %2, %4, %6\n\t"
      RW_DPP("%0", "quad_perm:[2,3,0,1]") RW_DPP("%1", "quad_perm:[2,3,0,1]") "v_pk_mul_f32 %3, %5, %6\n\t"
      RW_DPP("%0", "row_half_mirror") RW_DPP("%1", "row_half_mirror")
      : "+v"(x0), "+v"(x1), "=&v"(m0), "=&v"(m1) : "v"(S0[0]), "v"(S1[0]), "v"(W[0]));
  const f32x2 vx = {o.v.x, o.v.x}, vy = {o.v.y, o.v.y};
  f32x2 t0[4], t1[4];
  t0[0] = RW_FMA(vx, Dv[0], m0); t1[0] = RW_FMA(vy, Dv[0], m1);
#pragma unroll
  for (int j = 1; j < 4; ++j) { t0[j] = RW_FMA(vx, Dv[j], S0[j] * W[j]); t1[j] = RW_FMA(vy, Dv[j], S1[j] * W[j]); }
  const f32x2 n0 = {-x0, -x0}, n1 = {-x1, -x1};
#pragma unroll
  for (int j = 0; j < 4; ++j) { S0[j] = RW_FMA(n0, Bv[j], t0[j]); S1[j] = RW_FMA(n1, Bv[j], t1[j]); }
  f32x2 y0 = S0[0] * R[0], y1 = S1[0] * R[0];
#pragma unroll
  for (int j = 1; j < 4; ++j) { y0 = RW_FMA(S0[j], R[j], y0); y1 = RW_FMA(S1[j], R[j], y1); }
  float ya = y0.x + y0.y, yb = y1.x + y1.y; asm("" : "+v"(ya), "+v"(yb));
  *yw = (f32x2){ya, yb};
}
__device__ __forceinline__ void scan_unit(const Args& a, int l, int u, unsigned char* ldsb) {
  const int tid = ltid(), wave = tid >> 6;
  const int dir = u & 1, bh = u >> 1, b = bh >> 4, h = bh & 15;
  const unsigned char* SIb = a.ws + WS_SI + (size_t)bh * L * SIR;
  f16* Y = (f16*)(a.ws + WS_YRW) + (size_t)dir * M * 1024 + (size_t)b * L * 1024 + h * 64;
  float* sbuf = (float*)ldsb;
  constexpr int NC = L / T;
  if (wave >= 4) {
    const int lt = tid - 256;
    const int lpart = lt >> 7, ls = (lt >> 3) & 15, lg = lt & 7;
    float ckk[8], cka[8];
#pragma unroll
    for (int e = 0; e < 8; ++e) { ckk[e] = a.in[13][l * 1024 + h * 64 + lg * 8 + e]; cka[e] = a.in[14][l * 1024 + h * 64 + lg * 8 + e]; }
    u32x4 regs[3];
    auto issue = [&](int c) {
      const unsigned char* rec = SIb + (size_t)scan_tok(dir, c * T + ls) * SIR; const int dof = 400 + dir * 256 + lg * 16;
      regs[0] = *(const u32x4*)(rec + (lpart ? 128 : 0) + lg * 16);
      regs[1] = *(const u32x4*)(rec + (lpart ? dof + 128 : 256 + lg * 16));
      regs[2] = *(const u32x4*)(rec + (lpart ? 384 : dof));
    };
    auto commit = [&](int c) {
      float* d0 = sbuf + (c & 1) * BUFF + ls * STEPF + lg * 8;
      const f16x8 h0 = __builtin_bit_cast(f16x8, regs[0]), h1 = __builtin_bit_cast(f16x8, regs[1]);
      float o0[8], o1[8], o2[8];
      if (lpart == 0) { const f16x8 h2 = __builtin_bit_cast(f16x8, regs[2]);
#pragma unroll
        for (int e = 0; e < 8; ++e) { o0[e] = (float)h0[e]; o1[e] = (float)h1[e]; o2[e] = 1.f - (float)h2[e]; }
        *(f32x4*)(d0) = (f32x4){o0[0], o0[1], o0[2], o0[3]}; *(f32x4*)(d0 + 4) = (f32x4){o0[4], o0[5], o0[6], o0[7]};
        *(f32x4*)(d0 + 128) = (f32x4){o1[0], o1[1], o1[2], o1[3]}; *(f32x4*)(d0 + 132) = (f32x4){o1[4], o1[5], o1[6], o1[7]};
        *(f32x4*)(d0 + 192) = (f32x4){o2[0], o2[1], o2[2], o2[3]}; *(f32x4*)(d0 + 196) = (f32x4){o2[4], o2[5], o2[6], o2[7]}; }
      else { const float inv = __uint_as_float(regs[2].x);
#pragma unroll
        for (int e = 0; e < 8; ++e) { const float k = (float)h0[e], ag = (float)h1[e]; o0[e] = k * ckk[e] * inv; o1[e] = o0[e] * ag; o2[e] = k * (1.f + (ag - 1.f) * cka[e]); }
        *(f32x4*)(d0 + 64) = (f32x4){o0[0], o0[1], o0[2], o0[3]}; *(f32x4*)(d0 + 68) = (f32x4){o0[4], o0[5], o0[6], o0[7]};
        *(f32x4*)(d0 + 256) = (f32x4){o1[0], o1[1], o1[2], o1[3]}; *(f32x4*)(d0 + 260) = (f32x4){o1[4], o1[5], o1[6], o1[7]};
        *(f32x4*)(d0 + 320) = (f32x4){o2[0], o2[1], o2[2], o2[3]}; *(f32x4*)(d0 + 324) = (f32x4){o2[4], o2[5], o2[6], o2[7]}; }
    };
    auto yred = [&](int c) {
      const float* ring = sbuf + YR_OFF + (c & 1) * YRING;
#pragma unroll
      for (int i = 0; i < (T * 32) / 256; ++i) { const int it = lt + 256 * i, s = it >> 5, p = it & 31;
        const f32x4* src = (const f32x4*)(ring + s * 512 + p * 16);
        const f32x4 q = (src[0] + src[1]) + (src[2] + src[3]);
        *(unsigned*)(Y + (size_t)scan_tok(dir, c * T + s) * 1024 + 2 * p) = pkh(q.x + q.z, q.y + q.w); }
    };
    issue(0); commit(0);
    __syncthreads();
    for (int c = 0; c < NC; ++c) {
      if (c + 1 < NC) issue(c + 1);
      if (c > 0) yred(c - 1);
      if (c + 1 < NC) commit(c + 1);
      __syncthreads();
    }
    yred(NC - 1);
  } else {
    const int p = tid >> 3, ks = tid & 7;
    __builtin_amdgcn_s_setprio(2);
    f32x2 S0[4], S1[4];
#pragma unroll
    for (int k = 0; k < 4; ++k) { S0[k] = (f32x2){0.f, 0.f}; S1[k] = (f32x2){0.f, 0.f}; }
    typedef __attribute__((address_space(3))) f32x2 lf2;
    __syncthreads();
    for (int c = 0; c < NC; ++c) {
      lcf* buf = (lcf*)(sbuf + (c & 1) * BUFF) + ks * 8; lcf* vb = (lcf*)(sbuf + (c & 1) * BUFF) + 128 + 2 * p;
      lf2* yw = (lf2*)(sbuf + YR_OFF + (c & 1) * YRING) + tid;
      Ops A, B;
      ld_ops(A, buf, vb);
#pragma unroll 1
      for (int s = 0; s < T; s += 2) {
        ld_ops(B, buf + (s + 1) * STEPF, vb + (s + 1) * STEPF);
        step(S0, S1, A, yw + s * 256);
        __builtin_amdgcn_sched_barrier(0);
        ld_ops(A, buf + (s + 2) * STEPF, vb + (s + 2) * STEPF);
        step(S0, S1, B, yw + (s + 1) * 256);
        __builtin_amdgcn_sched_barrier(0);
      }
      __syncthreads();
    }
    __builtin_amdgcn_s_setprio(0);
  }
}
}


namespace ml {
constexpr int PT = 136;
constexpr int OFF_Q = 0, OFF_K = 128 * PT * 2, OFF_KT = 2 * 128 * PT * 2, OFF_VT = 3 * 128 * PT * 2, OFF_CT = OFF_VT + 80 * PT * 2, OFF_SC = OFF_CT + 80 * PT * 2;
constexpr int LDS_NEED = OFF_SC + 6 * 512 + 256 + 64;
static_assert(LDS_NEED <= LDS_BYTES, "mLSTM LDS");
constexpr int NCH = L / 128;
#define MFMA16(a_, b_, c_) __builtin_amdgcn_mfma_f32_16x16x32_f16(a_, b_, c_, 0, 0, 0)
__device__ __forceinline__ void mlstm_unit(const Args& a, int l, int u, unsigned char* lds) {
  const int tid = ltid(), lane = tid & 63, w = __builtin_amdgcn_readfirstlane(tid >> 6), fr = lane & 15, fq = lane >> 4;
  const int dir = u & 1, vs = (u >> 1) & 3, bh = u >> 3, b = bh >> 2, h = bh & 3;
  const f16* P = (const f16*)(a.ws + WS_P) + (size_t)b * L * NP; const float* GP = (const float*)(a.ws + WS_GPRE) + (size_t)b * L * 16; const float* gb = a.in[20] + l * 16;
  f16* HM = (f16*)(a.ws + WS_HM) + (size_t)dir * M * 1024 + (size_t)b * L * 1024 + h * 256 + vs * 64;
  f16* Qs = (f16*)(lds + OFF_Q); f16* Ks = (f16*)(lds + OFF_K); f16* KTs = (f16*)(lds + OFF_KT); f16* VTs = (f16*)(lds + OFF_VT); f16* CTs = (f16*)(lds + OFF_CT);
  float* sc = (float*)(lds + OFF_SC); float* li = sc; float* bcs = sc + 128; float* uu = sc + 256; float* Mx = sc + 384; float* wint = sc + 512; float* emt = sc + 640; f16* wah = (f16*)(sc + 768);
  const float bi = gb[dir * 4 + h], bfg = gb[(2 + dir) * 4 + h];
  __syncthreads();
  for (int i = tid; i < 16 * PT; i += NT) VTs[64 * PT + i] = (f16)(i < PT ? 1.f : 0.f);
  for (int i = tid; i < 80 * PT; i += NT) CTs[i] = (f16)0.f;
  f32x4 CT[5];
#pragma unroll
  for (int n = 0; n < 5; ++n) CT[n] = (f32x4){0.f, 0.f, 0.f, 0.f};
  float mcar = 0.f;
  const int sgn = dir ? -1 : 1;
  f16x8 pq[4], pk[4], pv[2];
#define ML_LOAD(c) do { const int tb_ = scan_tok(dir, 128 * (c)); \
    _Pragma("unroll") for (int i = 0; i < 4; ++i) { const int un = tid + NT * i, j = un >> 4, d8 = un & 15; const f16* rp = P + (size_t)(tb_ + sgn * j) * NP; \
      pq[i] = *(const f16x8*)(rp + C_MLQ + h * 128 + d8 * 8); pk[i] = *(const f16x8*)(rp + C_MLK + h * 128 + d8 * 8); } \
    _Pragma("unroll") for (int i = 0; i < 2; ++i) { const int un = tid + NT * i, j = un >> 3, v8 = un & 7; \
      pv[i] = *(const f16x8*)(P + (size_t)(tb_ + sgn * j) * NP + C_MLV + h * 256 + vs * 64 + v8 * 8); } } while (0)
  ML_LOAD(0);
  for (int c = 0; c < NCH; ++c) {
    const int tb = scan_tok(dir, 128 * c);
    __syncthreads();
#pragma unroll
    for (int i = 0; i < 4; ++i) { const int un = tid + NT * i, j = un >> 4, d8 = un & 15;
      f16x8 qv;
#pragma unroll
      for (int e = 0; e < 8; ++e) qv[e] = (f16)((float)pq[i][e] * 0.08838834764831845f);
      *(f16x8*)(Qs + j * PT + d8 * 8) = qv; *(f16x8*)(Ks + j * PT + d8 * 8) = pk[i];
#pragma unroll
      for (int e = 0; e < 8; ++e) KTs[(d8 * 8 + e) * PT + (j ^ (d8 * 8))] = pk[i][e]; }
#pragma unroll
    for (int i = 0; i < 2; ++i) { const int un = tid + NT * i, j = un >> 3, v8 = un & 7;
#pragma unroll
      for (int e = 0; e < 8; ++e) VTs[(v8 * 8 + e) * PT + (j ^ (v8 * 8))] = pv[i][e]; }
    if (tid < 128) { const float* gp = GP + (size_t)(tb + sgn * tid) * 16;
      const float pi = gp[dir * 4 + h] + bi, pf = gp[(2 + dir) * 4 + h] + bfg;
      li[tid] = 15.f * tanhf(pi * (1.f / 15.f)); bcs[tid] = -softplus_f(-15.f * tanhf(pf * (1.f / 15.f))); }
    if (c + 1 < NCH) ML_LOAD(c + 1);
    __syncthreads();
    if (w == 0) {
      const float x0 = bcs[2 * lane], x1 = bcs[2 * lane + 1]; const float ps = x0 + x1; float inc = ps;
#pragma unroll
      for (int o = 1; o < 64; o <<= 1) { const float t = __shfl_up(inc, o); if (lane >= o) inc += t; }
      const float b0 = inc - ps + x0, b1 = b0 + x1;
      const float u0 = li[2 * lane] - b0, u1 = li[2 * lane + 1] - b1;
      float incm = fmaxf(u0, u1);
#pragma unroll
      for (int o = 1; o < 64; o <<= 1) { const float t = __shfl_up(incm, o); if (lane >= o) incm = fmaxf(incm, t); }
      float exm = __shfl_up(incm, 1); if (lane == 0) exm = -INFINITY;
      const float pm0 = fmaxf(exm, u0), pm1 = incm;
      const float M0 = fmaxf(mcar, pm0), M1 = fmaxf(mcar, pm1); const float Ml = __shfl(M1, 63);
      bcs[2 * lane] = b0; bcs[2 * lane + 1] = b1; uu[2 * lane] = u0; uu[2 * lane + 1] = u1; Mx[2 * lane] = M0; Mx[2 * lane + 1] = M1;
      wint[2 * lane] = expf(mcar - M0); wint[2 * lane + 1] = expf(mcar - M1); emt[2 * lane] = expf(-(b0 + M0)); emt[2 * lane + 1] = expf(-(b1 + M1));
      wah[2 * lane] = (f16)expf(u0 - Ml); wah[2 * lane + 1] = (f16)expf(u1 - Ml);
    }
    f16x8 af[4];
#pragma unroll
    for (int ks = 0; ks < 4; ++ks) af[ks] = *(const f16x8*)(Qs + (16 * w + fr) * PT + ks * 32 + fq * 8);
    f32x4 acc[8];
#pragma unroll
    for (int n = 0; n < 8; ++n) { acc[n] = (f32x4){0.f, 0.f, 0.f, 0.f};
#pragma unroll
      for (int ks = 0; ks < 4; ++ks) acc[n] = MFMA16(af[ks], *(const f16x8*)(Ks + (16 * n + fr) * PT + ks * 32 + fq * 8), acc[n]); }
    __syncthreads();
    const float Mlast = Mx[127], gsum = bcs[127]; const float cs = expf(mcar - Mlast);
    f16* Ss = Ks;
    { float Mt[4];
#pragma unroll
      for (int r = 0; r < 4; ++r) Mt[r] = Mx[16 * w + 4 * fq + r];
#pragma unroll
      for (int n = 0; n < 8; ++n) { const int s = 16 * n + fr; const float us = uu[s];
#pragma unroll
        for (int r = 0; r < 4; ++r) { const int t = 16 * w + 4 * fq + r; const float v = (s <= t) ? acc[n][r] * __expf(us - Mt[r]) : 0.f; Ss[t * PT + s] = (f16)v; } } }
    f32x4 QC[5], SV[5];
#pragma unroll
    for (int n = 0; n < 5; ++n) { QC[n] = (f32x4){0.f, 0.f, 0.f, 0.f}; SV[n] = (f32x4){0.f, 0.f, 0.f, 0.f};
#pragma unroll
      for (int ks = 0; ks < 4; ++ks) QC[n] = MFMA16(af[ks], *(const f16x8*)(CTs + (16 * n + fr) * PT + ks * 32 + fq * 8), QC[n]); }
#pragma unroll
    for (int ks = 0; ks < 4; ++ks) if (32 * ks <= 16 * w + 15) { const f16x8 sf = *(const f16x8*)(Ss + (16 * w + fr) * PT + ks * 32 + fq * 8);
#pragma unroll
      for (int n = 0; n < 5; ++n) SV[n] = MFMA16(sf, *(const f16x8*)(VTs + (16 * n + fr) * PT + ((ks * 32 + fq * 8) ^ ((((16 * n + fr) >> 3) & 7) * 8))), SV[n]); }
#pragma unroll
    for (int r = 0; r < 4; ++r) { const int t = 16 * w + 4 * fq + r; const float wi = wint[t];
      const float den = __shfl(wi * QC[4][r] + SV[4][r], lane & 48); const float inv = 1.f / fmaxf(fabsf(den), emt[t]);
      f16* hp = HM + (size_t)(tb + sgn * t) * 1024 + fr;
#pragma unroll
      for (int n = 0; n < 4; ++n) hp[16 * n] = (f16)((wi * QC[n][r] + SV[n][r]) * inv); }
#pragma unroll
    for (int n = 0; n < 5; ++n) CT[n] = CT[n] * cs;
#pragma unroll
    for (int ks = 0; ks < 4; ++ks) { const f16x8 bfr = *(const f16x8*)(KTs + (16 * w + fr) * PT + ((ks * 32 + fq * 8) ^ ((((16 * w + fr) >> 3) & 15) * 8))) * *(const f16x8*)(wah + ks * 32 + fq * 8);
#pragma unroll
      for (int n = 0; n < 5; ++n) CT[n] = MFMA16(*(const f16x8*)(VTs + (16 * n + fr) * PT + ((ks * 32 + fq * 8) ^ ((((16 * n + fr) >> 3) & 7) * 8))), bfr, CT[n]); }
    __syncthreads();
#pragma unroll
    for (int n = 0; n < 5; ++n)
#pragma unroll
      for (int r = 0; r < 4; ++r) CTs[(16 * n + 4 * fq + r) * PT + 16 * w + fr] = (f16)CT[n][r];
    mcar = gsum + Mlast;
  }
#undef ML_LOAD
}
#undef MFMA16
}

namespace att {
constexpr int AD = 128, NW = 8, QBLK = 32, KVBLK = 64;
constexpr float SCALE = 0.088388347648318440f;
constexpr float THR = 8.f;
constexpr int LDQ = 1024, LDK = 512, LDV = 512, LDO = 1024;
constexpr size_t SHM_V = KVBLK * AD * 2, SHM_K = KVBLK * AD * 2, SHM_ATTN = 2 * SHM_V + 2 * SHM_K + NW * 64 * 4;
using s16x4 = __attribute__((ext_vector_type(4))) short;
using f32x16 = __attribute__((ext_vector_type(16))) float;
#define KSWZ(row, colB) ((row) * 256 + ((colB) ^ (((row) & 7) << 4)))
#define SBAR() __builtin_amdgcn_sched_barrier(0)
__device__ __forceinline__ int crow(int r, int hi) { return (r & 3) + 8 * (r >> 2) + 4 * hi; }
__device__ __forceinline__ unsigned cvtpk(float lo, float hi) { unsigned r; asm volatile("v_cvt_pk_f16_f32 %0, %1, %2" : "=v"(r) : "v"(lo), "v"(hi)); return r; }
__device__ __forceinline__ void partialSM(f32x16& p0, f32x16& p1, float& m_reg, float& mn, float& alpha) {
  constexpr float C = SCALE * 1.4426950408889634f;
  float pmax = p0[0];
#pragma unroll
  for (int r = 1; r < 16; ++r) pmax = fmaxf(pmax, p0[r]);
#pragma unroll
  for (int r = 0; r < 16; ++r) pmax = fmaxf(pmax, p1[r]);
  { auto rr = __builtin_amdgcn_permlane32_swap(__float_as_uint(pmax), __float_as_uint(pmax), false, false);
    pmax = fmaxf(__uint_as_float(rr[0]), __uint_as_float(rr[1])); }
  if (__builtin_expect(__all(pmax - m_reg <= THR / SCALE), 1)) { mn = m_reg; alpha = 1.f; }
  else { mn = fmaxf(m_reg, pmax); alpha = __builtin_amdgcn_exp2f((m_reg - mn) * C); m_reg = mn; }
  float mnC = -mn * C;
#pragma unroll
  for (int r = 0; r < 16; ++r) p0[r] = fmaf(p0[r], C, mnC);
#pragma unroll
  for (int r = 0; r < 16; ++r) p1[r] = fmaf(p1[r], C, mnC);
#pragma unroll
  for (int r = 0; r < 16; ++r) p0[r] = __builtin_amdgcn_exp2f(p0[r]);
}
__device__ __forceinline__ void finishSM(f32x16& p0, f32x16& p1, float alpha, float& l_reg, f16x8& pa0, f16x8& pa1, f16x8& pa2, f16x8& pa3) {
#pragma unroll
  for (int r = 0; r < 16; ++r) p1[r] = __builtin_amdgcn_exp2f(p1[r]);
  float ps = 0;
#pragma unroll
  for (int r = 0; r < 16; ++r) ps += p0[r];
#pragma unroll
  for (int r = 0; r < 16; ++r) ps += p1[r];
  { auto rr = __builtin_amdgcn_permlane32_swap(__float_as_uint(ps), __float_as_uint(ps), false, false);
    ps = __uint_as_float(rr[0]) + __uint_as_float(rr[1]); }
  l_reg = l_reg * alpha + ps;
#define PK4(P, BASE, OUT) do { unsigned a0 = cvtpk(P[BASE + 0], P[BASE + 1]), a1 = cvtpk(P[BASE + 2], P[BASE + 3]);   \
    unsigned b0 = cvtpk(P[BASE + 4], P[BASE + 5]), b1 = cvtpk(P[BASE + 6], P[BASE + 7]);                              \
    auto r0 = __builtin_amdgcn_permlane32_swap(a0, b0, false, false); auto r1 = __builtin_amdgcn_permlane32_swap(a1, b1, false, false); \
    u32x4 w = {r0[0], r1[0], r0[1], r1[1]}; OUT = __builtin_bit_cast(f16x8, w); } while (0)
  PK4(p0, 0, pa0); PK4(p0, 8, pa1); PK4(p1, 0, pa2); PK4(p1, 8, pa3);
#undef PK4
}
__device__ __forceinline__ void qkt(f32x16& p0, f32x16& p1, const char* Ks, const f16x8* qr, int r32, int hi) {
  p0 = f32x16{}; p1 = f32x16{};
#pragma unroll
  for (int d0 = 0; d0 < 8; ++d0) { int cb = (d0 * 16 + hi * 8) * 2;
    f16x8 b0 = *reinterpret_cast<const f16x8*>(Ks + KSWZ(r32, cb));
    f16x8 b1 = *reinterpret_cast<const f16x8*>(Ks + KSWZ(32 + r32, cb));
    p0 = __builtin_amdgcn_mfma_f32_32x32x16_f16(b0, qr[d0], p0, 0, 0, 0);
    p1 = __builtin_amdgcn_mfma_f32_32x32x16_f16(b1, qr[d0], p1, 0, 0, 0); }
}
__device__ __forceinline__ int v_st(int k, int c) { const int kk = (k & ~0xC) | ((k & 4) << 1) | ((k & 8) >> 1); return ((kk >> 3) * 4 + (c >> 5)) * 512 + ((kk & 7) * 32 + (c & 31)) * 2; }
__device__ __forceinline__ int v_rd_base(int lane) { return ((lane & 3) << 3) | (((lane >> 2) & 3) << 6) | (((lane >> 4) & 1) << 5) | (((lane >> 5) & 1) << 8); }
constexpr int v_rd_off(int d0, int ks, int half) { return d0 * 512 + ks * 4096 + half * 2048; }
template <int OFF> __device__ __forceinline__ s16x4 tr_read(int vb) {
  s16x4 r; asm volatile("ds_read_b64_tr_b16 %0, %1 offset:%2" : "=&v"(r) : "v"(vb), "i"(OFF) : "memory"); return r;
}
template <int D0> __device__ __forceinline__ void pv_one(f32x16& od, int vb, f16x8 pa0, f16x8 pa1, f16x8 pa2, f16x8 pa3) {
  const s16x4 l0 = tr_read<v_rd_off(D0, 0, 0)>(vb), h0 = tr_read<v_rd_off(D0, 0, 1)>(vb), l1 = tr_read<v_rd_off(D0, 1, 0)>(vb), h1 = tr_read<v_rd_off(D0, 1, 1)>(vb);
  const s16x4 l2 = tr_read<v_rd_off(D0, 2, 0)>(vb), h2 = tr_read<v_rd_off(D0, 2, 1)>(vb), l3 = tr_read<v_rd_off(D0, 3, 0)>(vb), h3 = tr_read<v_rd_off(D0, 3, 1)>(vb);
  asm volatile("s_waitcnt lgkmcnt(0)" ::: "memory"); SBAR();
  typedef short s16x8 __attribute__((ext_vector_type(8)));
#define PK(Lo, Hi) __builtin_bit_cast(f16x8, (s16x8){Lo[0], Lo[1], Lo[2], Lo[3], Hi[0], Hi[1], Hi[2], Hi[3]})
  od = __builtin_amdgcn_mfma_f32_32x32x16_f16(pa0, PK(l0, h0), od, 0, 0, 0);
  od = __builtin_amdgcn_mfma_f32_32x32x16_f16(pa1, PK(l1, h1), od, 0, 0, 0);
  od = __builtin_amdgcn_mfma_f32_32x32x16_f16(pa2, PK(l2, h2), od, 0, 0, 0);
  od = __builtin_amdgcn_mfma_f32_32x32x16_f16(pa3, PK(l3, h3), od, 0, 0, 0);
#undef PK
}
__device__ __forceinline__ void pv_d0(f32x16* o, int vb, f16x8 pa0, f16x8 pa1, f16x8 pa2, f16x8 pa3) {
  pv_one<0>(o[0], vb, pa0, pa1, pa2, pa3); pv_one<1>(o[1], vb, pa0, pa1, pa2, pa3); pv_one<2>(o[2], vb, pa0, pa1, pa2, pa3); pv_one<3>(o[3], vb, pa0, pa1, pa2, pa3);
}
__device__ __forceinline__ void attn_dense_body(const f16* __restrict__ Qb, const f16* __restrict__ Kh, const f16* __restrict__ Vh, f16* __restrict__ Ob, int seq, char* lds) {
  const int tid = ltid(), wid = tid >> 6, lane = tid & 63, r32 = lane & 31, hi = lane >> 5;
  char* V_lds = lds; char* K_lds = lds + 2 * SHM_V;
  float* ws = (float*)(lds + 2 * SHM_V + 2 * SHM_K) + wid * 64; float* li_l = ws; float* al_l = ws + 32;
  float m_reg = -1e30f, l_reg = 0; f32x16 o[4] = {}; f16x8 qr[8];
  const f16* Qw = Qb + (long)(wid * QBLK + r32) * LDQ + hi * 8;
#pragma unroll
  for (int d0 = 0; d0 < 8; ++d0) qr[d0] = *reinterpret_cast<const f16x8*>(Qw + d0 * 16);
  const int sr = tid >> 4, sc = (tid & 15) * 8, vst0 = v_st(sr, sc), vst1 = v_st(32 + sr, sc);
  const int vb0 = (int)(uintptr_t)V_lds + v_rd_base(lane);
  struct { f16x8 vs0, vs1, ks0, ks1; } sr_[2];
#define SLOAD(i, k0) do { sr_[i].vs0 = *(const f16x8*)(&Vh[(long)((k0) + sr) * LDV + sc]); sr_[i].vs1 = *(const f16x8*)(&Vh[(long)((k0) + 32 + sr) * LDV + sc]); \
    sr_[i].ks0 = *(const f16x8*)(&Kh[(long)((k0) + sr) * LDK + sc]); sr_[i].ks1 = *(const f16x8*)(&Kh[(long)((k0) + 32 + sr) * LDK + sc]); } while (0)
#define SWRITE(b, i) do { *(f16x8*)(V_lds + (b) * SHM_V + vst0) = sr_[i].vs0;          \
    *(f16x8*)(V_lds + (b) * SHM_V + vst1) = sr_[i].vs1; int kc = sc * 2;               \
    *(f16x8*)(K_lds + (b) * SHM_K + KSWZ(sr, kc)) = sr_[i].ks0;                       \
    *(f16x8*)(K_lds + (b) * SHM_K + KSWZ(32 + sr, kc)) = sr_[i].ks1; } while (0)
#define SWAIT() asm volatile("s_waitcnt vmcnt(4)" ::: "memory")
#define RESC(a) do { if (__any((a) < 1.f)) { if (hi == 0) al_l[r32] = (a); asm volatile("s_waitcnt lgkmcnt(0)" ::: "memory"); \
    _Pragma("unroll") for (int d = 0; d < 4; ++d) _Pragma("unroll") for (int r = 0; r < 16; ++r) o[d][r] *= al_l[crow(r, hi)]; } } while (0)
  f32x16 pA0, pA1, pB0, pB1; float mnA, mnB, alA, alB; f16x8 pa0, pa1, pa2, pa3; const int NTl = seq / KVBLK;
  constexpr int SE = 0, SO = 1;
  SLOAD(SE, 0); asm volatile("s_waitcnt vmcnt(0)" ::: "memory"); SWRITE(0, SE); __syncthreads();
  qkt(pA0, pA1, K_lds, qr, r32, hi); partialSM(pA0, pA1, m_reg, mnA, alA);
  SLOAD(SO, KVBLK); if (2 < NTl) SLOAD(SE, 2 * KVBLK);
  SWAIT(); SWRITE(1, SO); __syncthreads();
  for (int j = 1; j + 1 < NTl; j += 2) {
    SBAR(); qkt(pB0, pB1, K_lds + SHM_K, qr, r32, hi);
    finishSM(pA0, pA1, alA, l_reg, pa0, pa1, pa2, pa3); SBAR();
    SLOAD(SO, (j + 2) * KVBLK); SBAR();
    pv_d0(o, vb0, pa0, pa1, pa2, pa3); partialSM(pB0, pB1, m_reg, mnB, alB);
    __syncthreads(); SWAIT(); SWRITE(0, SE);
    RESC(alB); __syncthreads();
    SBAR(); qkt(pA0, pA1, K_lds, qr, r32, hi);
    finishSM(pB0, pB1, alB, l_reg, pa0, pa1, pa2, pa3); SBAR();
    if (j + 3 < NTl) SLOAD(SE, (j + 3) * KVBLK); SBAR();
    pv_d0(o, vb0 + (int)SHM_V, pa0, pa1, pa2, pa3); partialSM(pA0, pA1, m_reg, mnA, alA);
    __syncthreads(); SWAIT(); SWRITE(1, SO);
    RESC(alA); __syncthreads();
  }
  SBAR(); qkt(pB0, pB1, K_lds + SHM_K, qr, r32, hi);
  finishSM(pA0, pA1, alA, l_reg, pa0, pa1, pa2, pa3); SBAR();
  pv_d0(o, vb0, pa0, pa1, pa2, pa3); partialSM(pB0, pB1, m_reg, mnB, alB);
  __syncthreads(); RESC(alB);
  finishSM(pB0, pB1, alB, l_reg, pa0, pa1, pa2, pa3); SBAR();
  pv_d0(o, vb0 + (int)SHM_V, pa0, pa1, pa2, pa3);
  if (hi == 0) li_l[r32] = l_reg; asm volatile("s_waitcnt lgkmcnt(0)" ::: "memory");
  float rli[16];
#pragma unroll
  for (int r = 0; r < 16; ++r) rli[r] = __builtin_amdgcn_rcpf(li_l[crow(r, hi)]);
  f16* Ow = Ob + (long)(wid * QBLK) * LDO;
#pragma unroll
  for (int r = 0; r < 16; ++r) { int orow = crow(r, hi);
#pragma unroll
    for (int d0 = 0; d0 < 4; ++d0) Ow[(long)orow * LDO + d0 * 32 + r32] = (f16)(o[d0][r] * rli[r]); }
#undef SLOAD
#undef SWRITE
#undef SWAIT
#undef RESC
}
#undef KSWZ
#undef SBAR
__device__ __forceinline__ void attn_unit(const Args& a, int u, char* lds) {
  int b, hq, t0, seq;
  if (u < 256) { const int qb = u & 15, r = (u >> 4) & 3, g = (u >> 6) & 1; b = u >> 7; hq = g * 4 + r; t0 = NCTX + 256 * qb; seq = L; }
  else { const int v = u - 256; b = v >> 3; hq = v & 7; t0 = 0; seq = NCTX; }
  const size_t m0 = (size_t)b * L + t0, k0 = (size_t)b * L; const int g = hq >> 2;
  const f16* Kh = (const f16*)(a.ws + WS_KN) + k0 * 512 + g * 128;
  attn_dense_body((const f16*)(a.ws + WS_QN) + m0 * 1024 + hq * 128, Kh, Kh + 256, (f16*)(a.ws + WS_AO) + m0 * 1024 + hq * 128, seq, lds);
}
}

__device__ __forceinline__ void ph_post(const Args& a, int l, int part = 3, int b0 = 0, int nb = 0) {
  const int tid = ltid(), lane = tid & 63, wave = tid >> 6;
  if (nb == 0) nb = gridDim.x;
  const int gw = (lbid() - b0) * 8 + wave, NGW = nb * 8;
  const f16* P = (const f16*)(a.ws + WS_P); f16* Y = (f16*)(a.ws + WS_Y);
  const f16* YRW = (const f16*)(a.ws + WS_YRW); const f16* AO = (const f16*)(a.ws + WS_AO); const f16* HM = (const f16*)(a.ws + WS_HM);
  const unsigned char* SIp = a.ws + WS_SI; const float* RKD = (const float*)(a.ws + WS_RKD);
  for (int m = gw; m < M; m += NGW) {
    const int lane = ltid() & 63, hq = lane >> 4, c4 = (lane & 15) * 4;
    const int b = m / L, t = m % L; const f16* pr = P + (size_t)m * NP; f16* yr = Y + (size_t)m * 3072;
    if (part & 1) {
    f16x4 ya[4], yb[4]; f32x4 vv[4], lw[4], lb[4]; f16x4 ga[4]; float rk[4];
#pragma unroll
    for (int g = 0; g < 4; ++g) { const int h = 4 * g + hq, c = h * 64 + c4;
      ya[g] = *(const f16x4*)(YRW + (size_t)m * 1024 + c); yb[g] = *(const f16x4*)(YRW + (size_t)(M + m) * 1024 + c);
      { const f16x4 vh = *(const f16x4*)(SIp + ((size_t)(b * 16 + h) * L + t) * SIR + 256 + c4 * 2); vv[g] = (f32x4){(float)vh[0], (float)vh[1], (float)vh[2], (float)vh[3]}; } ga[g] = *(const f16x4*)(pr + C_RWG + c);
      lw[g] = *(const f32x4*)(a.in[16] + l * 1024 + c); lb[g] = *(const f32x4*)(a.in[17] + l * 1024 + c); rk[g] = RKD[(size_t)m * 16 + h]; }
#pragma unroll
    for (int g = 0; g < 4; ++g) { const int c = (4 * g + hq) * 64 + c4; const f32x4 y = (f32x4){(float)ya[g][0] + (float)yb[g][0], (float)ya[g][1] + (float)yb[g][1], (float)ya[g][2] + (float)yb[g][2], (float)ya[g][3] + (float)yb[g][3]};
      const float mu = red16(y.x + y.y + y.z + y.w) * (1.f / 64.f); const f32x4 dv = y - mu;
      const float var = red16(dv.x * dv.x + dv.y * dv.y + dv.z * dv.z + dv.w * dv.w) * (1.f / 64.f); const float rs = rsqrtf(var + 64e-5f);
      float o[4];
#pragma unroll
      for (int e = 0; e < 4; ++e) o[e] = (dv[e] * rs * lw[g][e] + lb[g][e] + rk[g] * vv[g][e]) * silu_f((float)ga[g][e]);
      uint2 w; w.x = pkh(o[0], o[1]); w.y = pkh(o[2], o[3]); *(uint2*)(yr + c) = w; }
    }
    if (part & 2) {
    f16x4 ao[4]; f16x4 gb[4];
#pragma unroll
    for (int j = 0; j < 4; ++j) { const int c = j * 256 + lane * 4; ao[j] = *(const f16x4*)(AO + (size_t)m * 1024 + c); gb[j] = *(const f16x4*)(pr + C_ATG + c); }
    f32x4 ha[4], ng[4]; f16x4 hha[4], hhb[4], go[4], gg[4];
#pragma unroll
    for (int h = 0; h < 4; ++h) { const int c = h * 256 + lane * 4; hha[h] = *(const f16x4*)(HM + (size_t)m * 1024 + c); hhb[h] = *(const f16x4*)(HM + (size_t)(M + m) * 1024 + c);
      ng[h] = *(const f32x4*)(a.in[21] + l * 1024 + c); go[h] = *(const f16x4*)(pr + C_MLO + c); gg[h] = *(const f16x4*)(pr + C_MLG + c); }
#pragma unroll
    for (int j = 0; j < 4; ++j) { const int c = j * 256 + lane * 4; float o[4];
#pragma unroll
      for (int e = 0; e < 4; ++e) o[e] = (float)ao[j][e] * silu_f((float)gb[j][e]);
      uint2 w; w.x = pkh(o[0], o[1]); w.y = pkh(o[2], o[3]); *(uint2*)(yr + 1024 + c) = w; }
    float ss[4];
#pragma unroll
    for (int h = 0; h < 4; ++h) { ha[h] = (f32x4){(float)hha[h][0] + (float)hhb[h][0], (float)hha[h][1] + (float)hhb[h][1], (float)hha[h][2] + (float)hhb[h][2], (float)hha[h][3] + (float)hhb[h][3]}; ss[h] = ha[h].x * ha[h].x + ha[h].y * ha[h].y + ha[h].z * ha[h].z + ha[h].w * ha[h].w; }
#pragma unroll
    for (int o = 32; o >= 1; o >>= 1) {
#pragma unroll
      for (int h = 0; h < 4; ++h) ss[h] += __shfl_xor(ss[h], o); }
#pragma unroll
    for (int h = 0; h < 4; ++h) { const int c = h * 256 + lane * 4; const float rstd = rsqrtf(ss[h] * (1.f / 256.f) + 1e-6f); float o[4];
#pragma unroll
      for (int e = 0; e < 4; ++e) o[e] = sigm_f((float)go[h][e]) * (ha[h][e] * rstd * ng[h][e]) * silu_f((float)gg[h][e]);
      uint2 w; w.x = pkh(o[0], o[1]); w.y = pkh(o[2], o[3]); *(uint2*)(yr + 2048 + c) = w; }
    }
  }
}

__device__ __forceinline__ void ph_sum3(const Args& a) {
  const f16* G3 = (const f16*)(a.ws + WS_G3); const f16* G3b = (const f16*)(a.ws + WS_G3B); f16* MG = (f16*)(a.ws + WS_MRG);
  const size_t n8 = (size_t)M * D / 8;
  for (size_t i = (size_t)lbid() * NT + ltid(); i < n8; i += (size_t)gridDim.x * NT) {
    const f16x8 x = *(const f16x8*)(G3 + i * 8), y = *(const f16x8*)(G3b + i * 8), z = *(const f16x8*)(G3b + (size_t)M * D + i * 8);
    f16x8 o;
#pragma unroll
    for (int e = 0; e < 8; ++e) o[e] = (f16)((float)x[e] + (float)y[e] + (float)z[e]);
    *(f16x8*)(MG + i * 8) = o; }
}

__device__ __forceinline__ void ph_final(const Args& a) {
  const int tid = ltid(), lane = tid & 63, wave = tid >> 6;
  const int gw = lbid() * 8 + wave, NGW = gridDim.x * 8;
  const float* Z = (const float*)(a.ws + WS_Z); const float* fg = a.in[24];
  for (int r = gw; r < BATCH * SEQ; r += NGW) {
    const int b = r / SEQ, t = r % SEQ; const float* zr = Z + ((size_t)b * L + NCTX + t) * D; float* o = a.out + (size_t)r * D;
    f32x4 v[8]; float ss = 0.f;
#pragma unroll
    for (int j = 0; j < 8; ++j) { v[j] = *(const f32x4*)(zr + 4 * (lane + 64 * j)); ss += v[j].x * v[j].x + v[j].y * v[j].y + v[j].z * v[j].z + v[j].w * v[j].w; }
    const float rstd = rsqrtf(wave_sum(ss) * (1.f / D) + 1e-6f);
#pragma unroll
    for (int j = 0; j < 8; ++j) { const int k = 4 * (lane + 64 * j); *(f32x4*)(o + k) = v[j] * rstd * *(const f32x4*)(fg + k); }
  }
}


#define XLAS __attribute__((address_space(3)))
#define XB_TMO      128
#define XB_XCNT(j)  (256  + 64 * (j))
#define XB_XSUB(j)  (1280 + 64 * (j))
#define XB_XGEN(j)  (2304 + 64 * (j))
#define XB_TOP      3328
#define XB_TOPGEN   3392
#define XCD_BAR_WORDS 3456
#define XB_SPIN_CAP (1u << 18)
__device__ __forceinline__ unsigned xb_ld(unsigned* p)              { return __hip_atomic_load(p, __ATOMIC_RELAXED, __HIP_MEMORY_SCOPE_AGENT); }
__device__ __forceinline__ unsigned xb_add(unsigned* p, unsigned v) { return __hip_atomic_fetch_add(p, v, __ATOMIC_RELAXED, __HIP_MEMORY_SCOPE_AGENT); }
__device__ __forceinline__ unsigned xb_xcc_id() { return (unsigned)__builtin_amdgcn_s_getreg((3 << 11) | 20) & 0xFu; }
#define XB_SPIN(cond, bar) do { unsigned _sp = 0; while (cond) { __builtin_amdgcn_s_sleep(1); \
    if ((++_sp & 255u) == 0u) { if (xb_ld(&(bar)[XB_TMO])) break; if (_sp > XB_SPIN_CAP) { atomicAdd(&(bar)[XB_TMO], 1u); break; } } } } while (0)
struct XcdBarrier { unsigned* bar; unsigned x; volatile XLAS unsigned* st; };
__device__ __forceinline__ XcdBarrier xcd_barrier_post(unsigned* bar, volatile XLAS unsigned* st) {
    XcdBarrier b; b.bar = bar; b.x = xb_xcc_id(); b.st = st;
    if (threadIdx.x == 0) (void)xb_add(&bar[XB_XCNT(b.x)], 1u);
    return b;
}
__device__ __forceinline__ void xcd_barrier_complete(unsigned* bar, unsigned x, unsigned& nloc, unsigned& nx) {
    const unsigned G = gridDim.x * gridDim.y * gridDim.z;
    unsigned sum, cnt, mine, sp = 0u;
    for (;;) {
        sum = 0u; cnt = 0u; mine = 0u;
#pragma unroll
        for (unsigned j = 0; j < 16; ++j) { const unsigned c = xb_ld(&bar[XB_XCNT(j)]); sum += c; cnt += (c > 0u) ? 1u : 0u; mine = (j == x) ? c : mine; }
        if (sum == G) break;
        __builtin_amdgcn_s_sleep(1);
        if ((++sp & 255u) == 0u) { if (xb_ld(&bar[XB_TMO])) break; if (sp > XB_SPIN_CAP) { atomicAdd(&bar[XB_TMO], 1u); break; } }
    }
    nloc = mine > 0u ? mine : 1u; nx = cnt > 0u ? cnt : 1u;
}
__device__ __forceinline__ void xcd_barrier(const XcdBarrier& b) {
    asm volatile("s_waitcnt vmcnt(0)" ::: "memory");
    __syncthreads();
    if (threadIdx.x == 0) {
        unsigned* bar = b.bar;
        __builtin_amdgcn_s_waitcnt(0);
        unsigned nloc = b.st[0], nx = b.st[1];
        if (nloc == 0u) { xcd_barrier_complete(bar, b.x, nloc, nx); b.st[0] = nloc; b.st[1] = nx; }
        const unsigned old = xb_add(&bar[XB_XSUB(b.x)], 1u);
        const unsigned gen = old / nloc;
        if (old + 1u == (gen + 1u) * nloc) {
            __builtin_amdgcn_fence(__ATOMIC_RELEASE, "agent");
            asm volatile("s_waitcnt vmcnt(0)" ::: "memory");
            const unsigned og = xb_add(&bar[XB_TOP], 1u);
            const unsigned tg = og / nx;
            if (og + 1u == (tg + 1u) * nx) xb_add(&bar[XB_TOPGEN], 1u);
            else XB_SPIN(xb_ld(&bar[XB_TOPGEN]) == tg, bar);
            __builtin_amdgcn_fence(__ATOMIC_ACQUIRE, "agent");
            xb_add(&bar[XB_XGEN(b.x)], 1u);
            asm volatile("s_waitcnt vmcnt(0)" ::: "memory");
        } else {
            XB_SPIN(xb_ld(&bar[XB_XGEN(b.x)]) == gen, bar);
            __builtin_amdgcn_fence(__ATOMIC_ACQUIRE, "agent");
            asm volatile("s_waitcnt vmcnt(0)" ::: "memory");
        }
    }
    __syncthreads();
}


__device__ __forceinline__ void sub_barrier(unsigned* bar, volatile XLAS unsigned* st, unsigned G) {
    asm volatile("s_waitcnt vmcnt(0)" ::: "memory");
    __syncthreads();
    if (threadIdx.x == 0) {
        const unsigned x = xb_xcc_id();
        __builtin_amdgcn_s_waitcnt(0);
        unsigned nloc = st[0], nx = st[1];
        if (nloc == 0u) {
            unsigned sum, cnt, mine, sp = 0u;
            for (;;) { sum = 0u; cnt = 0u; mine = 0u;
#pragma unroll
                for (unsigned j = 0; j < 16; ++j) { const unsigned c = xb_ld(&bar[XB_XCNT(j)]); sum += c; cnt += (c > 0u) ? 1u : 0u; mine = (j == x) ? c : mine; }
                if (sum == G) break;
                __builtin_amdgcn_s_sleep(1);
                if ((++sp & 255u) == 0u) { if (xb_ld(&bar[XB_TMO])) break; if (sp > XB_SPIN_CAP) { atomicAdd(&bar[XB_TMO], 1u); break; } } }
            nloc = mine > 0u ? mine : 1u; nx = cnt > 0u ? cnt : 1u; st[0] = nloc; st[1] = nx; }
        const unsigned old = xb_add(&bar[XB_XSUB(x)], 1u);
        const unsigned gen = old / nloc;
        if (old + 1u == (gen + 1u) * nloc) {
            __builtin_amdgcn_fence(__ATOMIC_RELEASE, "agent");
            asm volatile("s_waitcnt vmcnt(0)" ::: "memory");
            const unsigned og = xb_add(&bar[XB_TOP], 1u);
            const unsigned tg = og / nx;
            if (og + 1u == (tg + 1u) * nx) xb_add(&bar[XB_TOPGEN], 1u);
            else XB_SPIN(xb_ld(&bar[XB_TOPGEN]) == tg, bar);
            __builtin_amdgcn_fence(__ATOMIC_ACQUIRE, "agent");
            xb_add(&bar[XB_XGEN(x)], 1u);
            asm volatile("s_waitcnt vmcnt(0)" ::: "memory");
        } else {
            XB_SPIN(xb_ld(&bar[XB_XGEN(x)]) == gen, bar);
            __builtin_amdgcn_fence(__ATOMIC_ACQUIRE, "agent");
            asm volatile("s_waitcnt vmcnt(0)" ::: "memory");
        }
    }
    __syncthreads();
}

__device__ __forceinline__ int mix_grab(unsigned* ctr, volatile unsigned* slot) {
  __syncthreads();
  if (ltid() == 0) *slot = __hip_atomic_fetch_add(ctr, 1u, __ATOMIC_RELAXED, __HIP_MEMORY_SCOPE_AGENT);
  __syncthreads();
  return (int)*slot;
}
constexpr int MFULL = 8192;
constexpr int NSCAN = 64;
constexpr int NT_RW = 13;
__device__ __forceinline__ void ph_mix(const Args& a, int l, unsigned char* lds) {
  const int bx = lbid();
  if (bx < NSCAN) {
    if (ltid() == 0) { unsigned* pd = (unsigned*)(a.ws + WS_CTL) + 1024 + 64 * l + 32; while (xb_ld(pd) < gridDim.x) __builtin_amdgcn_s_sleep(2); __builtin_amdgcn_fence(__ATOMIC_ACQUIRE, "agent"); }
    __syncthreads();
    rw::scan_unit(a, l, bx, lds); return; }
  const int NB = gridDim.x - NSCAN;
  unsigned* bar2 = (unsigned*)(a.ws + WS_CTL) + 8192 + l * XCD_BAR_WORDS;
  volatile XLAS unsigned* st2 = (volatile XLAS unsigned*)((XLAS unsigned char*)lds + (LDS_BYTES - 48));
  if (ltid() < 2) st2[ltid()] = 0u;
  __syncthreads();
  if (ltid() == 0) (void)xb_add(&bar2[XB_XCNT(xb_xcc_id())], 1u);
  { pg8::Gemm g{(const f16*)(a.ws + WS_H), (const f16*)(a.ws + WS_WIN) + (size_t)NT_RW * 256 * D, D, D, D, 1 << 20, 0}; pg8::StaticOrder So; So.init(M, NP - NT_RW * 256, NB, bx - NSCAN);
    pg8::gemm_phase((PG8_LAS unsigned char*)lds, g, So, pg8::EpiP{(f16*)(a.ws + WS_P), NT_RW * 256}); }
  sub_barrier(bar2, st2, (unsigned)NB);
  ph_prep(a, l, lds, 2, NSCAN, NB);
  sub_barrier(bar2, st2, (unsigned)NB);
  unsigned* ctr = (unsigned*)(a.ws + WS_CTL) + 64 * (1 + l);
  volatile unsigned* slot = (volatile unsigned*)(lds + LDS_BYTES - 64);
  int u = mix_grab(ctr, slot);
  while (u < 64) { ml::mlstm_unit(a, l, u, lds); u = mix_grab(ctr, slot); }
  while (u < 336) { att::attn_unit(a, u - 64, (char*)lds); u = mix_grab(ctr, slot); }
  sub_barrier(bar2, st2, (unsigned)NB);
  ph_post(a, l, 2, NSCAN, NB);
  sub_barrier(bar2, st2, (unsigned)NB);
  { pg8::Gemm g{(const f16*)(a.ws + WS_Y), (const f16*)(a.ws + WS_WBR), 3072, BR, BR, 8, 1024}; pg8::StaticOrder So; So.init(M, 2 * D, NB, bx - NSCAN, 8);
    pg8::gemm_phase((PG8_LAS unsigned char*)lds, g, So, pg8::EpiBr{(f16*)(a.ws + WS_G3), (f16*)(a.ws + WS_G3B), (const f16*)(a.ws + WS_P), nullptr}); }
  if (l + 1 < DEPTH) ph_convert(a, l + 1, lds, 1, NSCAN, NB);
}

__global__ void __launch_bounds__(NT) mega(Args a) {
  extern __shared__ __attribute__((aligned(16))) unsigned char lds[];
  { volatile XLAS unsigned* st0 = (volatile XLAS unsigned*)((XLAS unsigned char*)lds + (LDS_BYTES - 48)); if (threadIdx.x < 6) st0[threadIdx.x] = 0u; }
  __syncthreads();
  (void)xcd_barrier_post((unsigned*)(a.ws + WS_CTL) + 4096, (volatile XLAS unsigned*)((XLAS unsigned char*)lds + (LDS_BYTES - 32)));
#define GRID_SYNC() do { XcdBarrier xb_; xb_.bar = (unsigned*)(a.ws + WS_CTL) + 4096; xb_.x = xb_xcc_id(); xb_.st = (volatile XLAS unsigned*)((XLAS unsigned char*)lds + (LDS_BYTES - 32)); xcd_barrier(xb_); } while (0)
  const f16* P = (const f16*)(a.ws + WS_P);
  ph_modv(a, lds); __syncthreads(); ph_convert(a, 0, lds, 3);
  GRID_SYNC();
#pragma unroll 1
  for (int l = 0; l < DEPTH; ++l) {
    if (l > 0) { ph_convert(a, l, lds, 2); __syncthreads(); }
    ph_norm(a, l, lds);
    GRID_SYNC();
    { pg8::Gemm g{(const f16*)(a.ws + WS_H), (const f16*)(a.ws + WS_WIN), D, D, D, 1 << 20, 0}; pg8::StaticOrder So; So.init(M, NT_RW * 256, gridDim.x, lbid());
      pg8::gemm_phase((PG8_LAS unsigned char*)lds, g, So, pg8::EpiP{(f16*)(a.ws + WS_P), 0}); }
    GRID_SYNC();
    ph_prep(a, l, lds, 1);
    asm volatile("s_waitcnt vmcnt(0)" ::: "memory"); __syncthreads();
    if (ltid() == 0) { __builtin_amdgcn_fence(__ATOMIC_RELEASE, "agent"); (void)xb_add((unsigned*)(a.ws + WS_CTL) + 1024 + 64 * l + 32, 1u); }
    ph_mix(a, l, lds);
    GRID_SYNC();
    ph_post(a, l, 1);
    GRID_SYNC();
    { pg8::Gemm g{(const f16*)(a.ws + WS_Y), (const f16*)(a.ws + WS_WBR), 3072, BR, BR, 8, 1024}; pg8::StaticOrder So; So.init(MFULL, D, gridDim.x, lbid());
      pg8::gemm_phase((PG8_LAS unsigned char*)lds, g, So, pg8::EpiBr{(f16*)(a.ws + WS_G3), (f16*)(a.ws + WS_G3B), P, (f16*)(a.ws + WS_MRG)});
      tail_gemm((const f16*)(a.ws + WS_Y), 3072, (const f16*)(a.ws + WS_WBR), BR, MFULL, M - MFULL, D, BR, lds, EpiBranchMerge{(f16*)(a.ws + WS_MRG), (const f16*)(a.ws + WS_G3B), P}); }
    GRID_SYNC();
    { pg8::Gemm g{(const f16*)(a.ws + WS_MRG), (const f16*)(a.ws + WS_WOUT), D, D, D, 1 << 20, 0}; pg8::StaticOrder So; So.init(MFULL, D, gridDim.x, lbid());
      pg8::gemm_phase((PG8_LAS unsigned char*)lds, g, So, pg8::EpiZ{a, l});
      tail_gemm((const f16*)(a.ws + WS_MRG), D, (const f16*)(a.ws + WS_WOUT), D, MFULL, M - MFULL, D, D, lds, EpiOut{a, l}); }
    GRID_SYNC();
  }
  ph_final(a);
}

extern "C" void kernel_launch(void* const* d_in, const int* in_sizes, int n_in, void* d_out, int out_size, void* d_ws, size_t ws_size, hipStream_t stream) {
  static int grid_blocks = 0;
  if (grid_blocks == 0) {
    if (n_in != 25 || out_size != BATCH * SEQ * D || ws_size < WS_END) { fprintf(stderr, "kernel_launch: bad shapes n_in %d out %d ws %zu (need %zu)\n", n_in, out_size, ws_size, (size_t)WS_END); grid_blocks = -1; return; }
    if (hipFuncSetAttribute((const void*)mega, hipFuncAttributeMaxDynamicSharedMemorySize, LDS_BYTES) != hipSuccess) { fprintf(stderr, "kernel_launch: LDS attribute failed\n"); grid_blocks = -1; return; }
    int dev = 0, cus = 0, per_cu = 0;
    hipGetDevice(&dev); hipDeviceGetAttribute(&cus, hipDeviceAttributeMultiprocessorCount, dev);
    if (hipOccupancyMaxActiveBlocksPerMultiprocessor(&per_cu, (const void*)mega, NT, LDS_BYTES) != hipSuccess || per_cu < 1) { fprintf(stderr, "kernel_launch: occupancy query says %d\n", per_cu); (void)hipGetLastError(); per_cu = 1; }
    grid_blocks = cus * 1;
    fprintf(stderr, "kernel_launch: cus %d per_cu %d grid %d\n", cus, per_cu, grid_blocks);
  }
  if (grid_blocks < 0) return;
  (void)hipMemsetAsync((char*)d_ws + WS_CTL, 0, 65536, stream);
  Args a{};
  for (int i = 0; i < 25; ++i) a.in[i] = (const float*)d_in[i];
  a.out = (float*)d_out; a.ws = (unsigned char*)d_ws;
  hipLaunchKernelGGL(mega, dim3(grid_blocks), dim3(NT), LDS_BYTES, stream, a);
  const hipError_t e = hipPeekAtLastError();
  if (e != hipSuccess) fprintf(stderr, "launch failed: %s (grid %d)\n", hipGetErrorString(e), grid_blocks);
}
```

```cpp
#include <hip/hip_runtime.h>
#include <hip/hip_cooperative_groups.h>
#include <cstdio>
#include <cstdint>

constexpr int D = 2048, BATCH = 2, SEQ = 4096, NCTX = 256, L = NCTX + SEQ, M = BATCH * L, DEPTH = 2;
constexpr int NIN = 17168, NP = 17152;
constexpr int BR = 1024;
constexpr int C_R = 0, C_K = 1024, C_V = 2048, C_WD = 3072, C_AD = 3200, C_RWG = 3328, C_ATQ = 4352, C_ATK = 5376, C_ATV = 5632,
              C_ATG = 5888, C_MLQ = 6912, C_MLK = 7424, C_MLV = 7936, C_MLO = 8960, C_MLG = 9984, C_MRG = 11008;
constexpr int GATE_COL = 9984;
constexpr int SIV = 9 * 64;
constexpr int SIR = 912;

namespace cg = cooperative_groups;
typedef _Float16 f16;
typedef _Float16 f16x8 __attribute__((ext_vector_type(8)));
typedef _Float16 f16x4 __attribute__((ext_vector_type(4)));
typedef _Float16 f16x2 __attribute__((ext_vector_type(2)));
typedef float f32x4 __attribute__((ext_vector_type(4)));
typedef float f32x2 __attribute__((ext_vector_type(2)));
typedef unsigned u32x4 __attribute__((ext_vector_type(4)));

constexpr size_t MiB = 1u << 20;
constexpr size_t al(size_t x) { return (x + 255) / 256 * 256; }
constexpr size_t WS_CTL = 0;
constexpr size_t WS_MODV = 1 * MiB;
constexpr size_t WS_WIN = WS_MODV + al((size_t)2 * 3 * 6144 * 4);
constexpr size_t WS_WBR = WS_WIN + al((size_t)NP * D * 2);
constexpr size_t WS_WOUT = WS_WBR + al((size_t)3 * D * BR * 2);
constexpr size_t WS_H = WS_WOUT + al((size_t)D * D * 2);
constexpr size_t WS_QN = WS_H;
constexpr size_t WS_KN = WS_QN + al((size_t)M * 1024 * 2);
constexpr size_t WS_GPRE = WS_H + al((size_t)M * D * 2);
constexpr size_t WS_RKD = WS_GPRE + al((size_t)M * 16 * 4);
constexpr size_t WS_P = WS_RKD + al((size_t)M * 16 * 4);
constexpr size_t WS_SI = WS_P + al((size_t)M * NP * 2);
constexpr size_t WS_G3 = WS_SI;
constexpr size_t WS_MRG = WS_G3 + al((size_t)3 * M * D * 2);
constexpr size_t WS_YRW = WS_SI + al((size_t)BATCH * 16 * L * SIV * 4);
constexpr size_t WS_AO = WS_YRW + al((size_t)2 * M * 1024 * 4);
constexpr size_t WS_HM = WS_AO + al((size_t)M * 1024 * 4);
constexpr size_t WS_Y = WS_HM + al((size_t)2 * M * 1024 * 4);
constexpr size_t WS_Z = WS_Y + al((size_t)M * 3072 * 2);
constexpr size_t WS_G3B = WS_Z + al((size_t)M * D * 4);
constexpr size_t WS_END = WS_G3B + al((size_t)2 * M * D * 2);
static_assert(WS_MRG + (size_t)M * D * 2 <= WS_YRW, "G3|MERGED overlay fits in SI");
static_assert(WS_KN + (size_t)M * 512 * 2 <= WS_GPRE, "QN|KN overlay fits in H");

#ifndef PROBE_PHASE
#define PROBE_PHASE 0
#endif
constexpr int NT = 512;
constexpr int LDS_BYTES = 152 * 1024;

struct Args { const float* in[25]; float* out; unsigned char* ws; int ph_lo, ph_hi; };

__device__ __forceinline__ int ltid() { int t = threadIdx.x; asm volatile("" : "+v"(t)); return t; }
__device__ __forceinline__ int lbid() { int t = blockIdx.x; asm volatile("" : "+s"(t)); return t; }
__device__ __forceinline__ float wave_sum(float v) {
#pragma unroll
  for (int o = 32; o >= 1; o >>= 1) v += __shfl_xor(v, o);
  return v;
}
template <int CTRL> __device__ __forceinline__ float dppf(float x) { return __int_as_float(__builtin_amdgcn_update_dpp(0, __float_as_int(x), CTRL, 0xF, 0xF, true)); }
__device__ __forceinline__ float red16(float x) { x += dppf<0xB1>(x); x += dppf<0x4E>(x); x += dppf<0x141>(x); x += dppf<0x140>(x); return x; }
template <int CTRL> __device__ __forceinline__ float dppx(float x) { return __int_as_float(__builtin_amdgcn_update_dpp(0, __float_as_int(x), CTRL, 0xF, 0xF, true)); }
__device__ __forceinline__ float wsum_fast(float x) { x += dppx<0xB1>(x); x += dppx<0x4E>(x); x += dppx<0x141>(x); x += dppx<0x140>(x); x += __shfl_xor(x, 16); x += __shfl_xor(x, 32); return x; }

__device__ __forceinline__ float wave_max(float v) {
#pragma unroll
  for (int o = 32; o >= 1; o >>= 1) v = fmaxf(v, __shfl_xor(v, o));
  return v;
}
__device__ __forceinline__ float sigm_f(float x) { return __builtin_amdgcn_rcpf(1.f + __expf(-x)); }
__device__ __forceinline__ float silu_f(float x) { return x * sigm_f(x); }
__device__ __forceinline__ float tanh_f(float x) { const float t = __expf(-2.f * fabsf(x)); return copysignf((1.f - t) * __builtin_amdgcn_rcpf(1.f + t), x); }
__device__ __forceinline__ float softplus_f(float x) { return x > 20.f ? x : log1pf(expf(x)); }
__device__ __forceinline__ unsigned pkh(float lo, float hi) { f32x2 v = {lo, hi}; f16x2 h = __builtin_convertvector(v, f16x2); return __builtin_bit_cast(unsigned, h); }

__device__ __forceinline__ const float* zrow(const Args& a, int l, int m) {
  if (l > 0) return (const float*)(a.ws + WS_Z) + (size_t)m * D;
  const int b = m / L, t = m % L;
  return t < NCTX ? a.in[2] + ((size_t)b * NCTX + t) * D : a.in[0] + ((size_t)b * SEQ + (t - NCTX)) * D;
}

__device__ __forceinline__ void ph_modv(const Args& a, unsigned char* lds) {
  const int tid = ltid(), lane = tid & 63, wave = tid >> 6;
  float* sv = (float*)lds;
  float* red = sv + 3 * 2048;
  float* modv = (float*)(a.ws + WS_MODV);
  for (int i = tid; i < 3 * 2048; i += NT) { const int w = i / 2048, k = i % 2048; sv[i] = silu_f(w < 2 ? a.in[1][w * 2048 + k] : a.in[3][k]); }
  __syncthreads();
  for (int u = lbid(); u < 192; u += gridDim.x) {
    const int l = u / 96, j0 = (u % 96) * 64;
    const float* w = a.in[5] + (size_t)l * 2048 * 6144 + j0 + lane;
    float a0 = 0.f, a1 = 0.f, a2 = 0.f;
    for (int k = wave * 256; k < wave * 256 + 256; ++k) { const float wv = w[(size_t)k * 6144]; a0 += sv[k] * wv; a1 += sv[2048 + k] * wv; a2 += sv[4096 + k] * wv; }
    red[(wave * 3 + 0) * 64 + lane] = a0; red[(wave * 3 + 1) * 64 + lane] = a1; red[(wave * 3 + 2) * 64 + lane] = a2;
    __syncthreads();
    if (tid < 192) { const int i = tid >> 6; float s = a.in[6][l * 6144 + j0 + lane];
      for (int w8 = 0; w8 < 8; ++w8) s += red[(w8 * 3 + i) * 64 + lane];
      modv[(size_t)(l * 3 + i) * 6144 + j0 + lane] = s; }
    __syncthreads();
  }
}

__device__ __forceinline__ void transpose_item(const float* W, int ldw, int ncol0, int k0, f16* WT, int K, int row0, float* scr, int lane) {
#pragma unroll 8
  for (int i = 0; i < 32; ++i) { const int kk = 2 * i + (lane >> 5); scr[kk * 33 + (lane & 31)] = W[(size_t)(k0 + kk) * ldw + ncol0 + (lane & 31)]; }
  asm volatile("s_waitcnt lgkmcnt(0)" ::: "memory");
  const int c = lane & 7;
#pragma unroll
  for (int j = 0; j < 4; ++j) { const int n = (lane >> 3) + 8 * j; const float* s = scr + (8 * c) * 33 + n;
    u32x4 o; o.x = pkh(s[0 * 33], s[1 * 33]); o.y = pkh(s[2 * 33], s[3 * 33]); o.z = pkh(s[4 * 33], s[5 * 33]); o.w = pkh(s[6 * 33], s[7 * 33]);
    *(u32x4*)(WT + (size_t)(row0 + n) * K + k0 + 8 * c) = o; }
  asm volatile("s_waitcnt lgkmcnt(0)" ::: "memory");
}
__device__ __forceinline__ void ph_convert(const Args& a, int l, unsigned char* lds, int part = 3, int b0 = 0, int nb = 0) {
  const int tid = ltid(), lane = tid & 63, wave = tid >> 6;
  float* scr = (float*)lds + wave * (64 * 33);
  if (nb == 0) nb = gridDim.x;
  const int gw = (lbid() - b0) * 8 + wave, NGW = nb * 8;
  constexpr int I_IN = (D / 64) * (NP / 32), I_BR = (BR / 64) * (D / 32), I_OUT = (D / 64) * (D / 32);
  f16* WIN = (f16*)(a.ws + WS_WIN); f16* WBR = (f16*)(a.ws + WS_WBR); f16* WOUT = (f16*)(a.ws + WS_WOUT);
  for (int it = gw + ((part & 1) ? 0 : I_IN); it < ((part & 2) ? I_IN + 3 * I_BR + I_OUT : I_IN); it += NGW) {
    int r = it;
    if (r < I_IN) { const int nblk = NP / 32, kb = r / nblk, nb = r % nblk, n0 = nb * 32;
      transpose_item(a.in[7] + (size_t)l * D * NIN, NIN, n0 + (n0 >= GATE_COL ? 16 : 0), kb * 64, WIN, D, n0, scr, lane); continue; }
    r -= I_IN;
    if (r < 3 * I_BR) { const int br = r / I_BR, q = r % I_BR, nblk = D / 32, kb = q / nblk, nb = q % nblk;
      transpose_item(a.in[22] + ((size_t)l * 3 + br) * BR * D, D, nb * 32, kb * 64, WBR, BR, br * D + nb * 32, scr, lane); continue; }
    r -= 3 * I_BR;
    { const int nblk = D / 32, kb = r / nblk, nb = r % nblk;
      transpose_item(a.in[23] + (size_t)l * D * D, D, nb * 32, kb * 64, WOUT, D, nb * 32, scr, lane); }
  }
}

__device__ __forceinline__ void ph_norm(const Args& a, int l, unsigned char* lds) {
  const int tid = ltid(), lane = tid & 63, wave = tid >> 6;
  const int gw = lbid() * 8 + wave, NGW = gridDim.x * 8;
  float* wg = (float*)lds;
  { const float* w = a.in[7] + (size_t)l * D * NIN + GATE_COL;
    for (int i = tid; i < 2048 * 4; i += NT) { const int k = i >> 2, q = i & 3; const f32x4 v = *(const f32x4*)(w + (size_t)k * NIN + q * 4);
      wg[(q * 4 + 0) * 2048 + k] = v.x; wg[(q * 4 + 1) * 2048 + k] = v.y; wg[(q * 4 + 2) * 2048 + k] = v.z; wg[(q * 4 + 3) * 2048 + k] = v.w; } }
  __syncthreads();
  const float* modv = (const float*)(a.ws + WS_MODV) + (size_t)l * 3 * 6144;
  const float* ng = a.in[4] + l * D;
  f16* H = (f16*)(a.ws + WS_H); float* GP = (float*)(a.ws + WS_GPRE);
  for (int m = gw; m < M; m += NGW) {
    const int b = m / L, t = m % L; const float* zr = zrow(a, l, m);
    const float* mv = modv + (size_t)(t < NCTX ? 2 : b) * 6144;
    f32x4 v[8]; float ss = 0.f;
#pragma unroll
    for (int j = 0; j < 8; ++j) { v[j] = *(const f32x4*)(zr + 4 * (lane + 64 * j)); ss += v[j].x * v[j].x + v[j].y * v[j].y + v[j].z * v[j].z + v[j].w * v[j].w; }
    const float rstd = rsqrtf(wave_sum(ss) * (1.f / D) + 1e-6f);
#pragma unroll
    for (int j = 0; j < 8; ++j) { const int k = 4 * (lane + 64 * j);
      const f32x4 g = *(const f32x4*)(ng + k), sh = *(const f32x4*)(mv + k), sc = *(const f32x4*)(mv + 2048 + k);
      v[j] = (v[j] * rstd * g) * (1.f + sc) + sh;
      uint2 o; o.x = pkh(v[j].x, v[j].y); o.y = pkh(v[j].z, v[j].w); *(uint2*)(H + (size_t)m * D + k) = o; }
    float p[16];
#pragma unroll
    for (int g = 0; g < 16; ++g) { float pp = 0.f;
#pragma unroll
      for (int j = 0; j < 8; ++j) { const f32x4 w = *(const f32x4*)(wg + g * 2048 + 4 * (lane + 64 * j)); pp += v[j].x * w.x + v[j].y * w.y + v[j].z * w.z + v[j].w * w.w; }
      p[g] = pp; if ((g & 1) == 1) __builtin_amdgcn_sched_barrier(0); }
    const bool b3 = lane & 8, b2 = lane & 4, b1 = lane & 2, b0 = lane & 1;
#define NRM_DPP(x_, ctrl_) __int_as_float(__builtin_amdgcn_update_dpp(0, __float_as_int(x_), ctrl_, 0xF, 0xF, true))
    float q8[8], q4[4], q2[2];
#pragma unroll
    for (int g = 0; g < 8; ++g) { const float keep = b3 ? p[g + 8] : p[g], send = b3 ? p[g] : p[g + 8]; q8[g] = keep + NRM_DPP(send, 0x128); }
#pragma unroll
    for (int g = 0; g < 4; ++g) { const float keep = b2 ? q8[g + 4] : q8[g], send = b2 ? q8[g] : q8[g + 4]; q4[g] = keep + NRM_DPP(send, 0x141); }
#pragma unroll
    for (int g = 0; g < 2; ++g) { const float keep = b1 ? q4[g + 2] : q4[g], send = b1 ? q4[g] : q4[g + 2]; q2[g] = keep + NRM_DPP(send, 0x4E); }
    float gsum = (b0 ? q2[1] : q2[0]) + NRM_DPP((b0 ? q2[0] : q2[1]), 0xB1);
#undef NRM_DPP
    gsum += __shfl_xor(gsum, 16); gsum += __shfl_xor(gsum, 32);
    if (lane < 16) GP[(size_t)m * 16 + lane] = gsum;
  }
}

template <class Epi>
__device__ __forceinline__ void tail_gemm(const f16* A, int lda, const f16* Bt, int ldb, int m0, int Mrows, int Ncols, int K, unsigned char* lds, const Epi& epi) {
  const int tid = ltid(), lane = tid & 63, wave = __builtin_amdgcn_readfirstlane(tid >> 6), fr = lane & 15, fq = lane >> 4;
  const int ntn = Ncols / 64, nun = (Mrows / 64) * ntn, KW = K / 8;
  float* part = (float*)lds;
  for (int u = lbid(); u < nun; u += (int)gridDim.x) {
    const int tm = u / ntn, tn = u % ntn;
    f32x4 acc[4][4];
#pragma unroll
    for (int i = 0; i < 4; ++i)
#pragma unroll
      for (int j = 0; j < 4; ++j) acc[i][j] = (f32x4){0.f, 0.f, 0.f, 0.f};
    const f16* ap = A + (size_t)(m0 + tm * 64 + fr) * lda + wave * KW + fq * 8; const f16* bp = Bt + (size_t)(tn * 64 + fr) * ldb + wave * KW + fq * 8;
    for (int k0 = 0; k0 < KW; k0 += 64) {
      f16x8 af[4], bf[4], an[4], bn[4];
#pragma unroll
      for (int i = 0; i < 4; ++i) { af[i] = *(const f16x8*)(ap + (size_t)i * 16 * lda + k0); bf[i] = *(const f16x8*)(bp + (size_t)i * 16 * ldb + k0);
                                    an[i] = *(const f16x8*)(ap + (size_t)i * 16 * lda + k0 + 32); bn[i] = *(const f16x8*)(bp + (size_t)i * 16 * ldb + k0 + 32); }
#pragma unroll
      for (int i = 0; i < 4; ++i)
#pragma unroll
        for (int j = 0; j < 4; ++j) { acc[i][j] = __builtin_amdgcn_mfma_f32_16x16x32_f16(af[i], bf[j], acc[i][j], 0, 0, 0); acc[i][j] = __builtin_amdgcn_mfma_f32_16x16x32_f16(an[i], bn[j], acc[i][j], 0, 0, 0); }
    }
    __syncthreads();
#pragma unroll
    for (int i = 0; i < 4; ++i)
#pragma unroll
      for (int j = 0; j < 4; ++j)
#pragma unroll
        for (int r = 0; r < 4; ++r) part[((wave * 16 + i * 4 + j) * 4 + r) * 64 + lane] = acc[i][j][r];
    __syncthreads();
#pragma unroll
    for (int q = 0; q < 2; ++q) { const int f = 2 * wave + q, i = f >> 2, j = f & 3;
#pragma unroll
      for (int r = 0; r < 4; ++r) { float v = 0.f;
#pragma unroll
        for (int w8 = 0; w8 < 8; ++w8) v += part[((w8 * 16 + f) * 4 + r) * 64 + lane];
        epi(m0 + tm * 64 + i * 16 + fq * 4 + r, tn * 64 + j * 16 + fr, v); } }
  }
}
struct EpiBranch { f16* O; const f16* P; int br; __device__ __forceinline__ void operator()(int m, int n, float v) const {
  const float g = sigm_f((float)P[(size_t)m * NP + C_MRG + br * D + n]); O[(size_t)m * D + n] = (f16)(g * v); } };
struct EpiBranchMerge { f16* MRG; const f16* G3b; const f16* P; __device__ __forceinline__ void operator()(int m, int n, float v) const {
  const float g = sigm_f((float)P[(size_t)m * NP + C_MRG + n]); MRG[(size_t)m * D + n] = (f16)(g * v + (float)G3b[(size_t)m * D + n] + (float)G3b[(size_t)M * D + (size_t)m * D + n]); } };
struct EpiOut { Args a; int l; __device__ __forceinline__ void operator()(int m, int n, float v) const {
  const int b = m / L, t = m % L; const float gt = ((const float*)(a.ws + WS_MODV))[(size_t)(l * 3 + (t < NCTX ? 2 : b)) * 6144 + 4096 + n];
  ((float*)(a.ws + WS_Z))[(size_t)m * D + n] = zrow(a, l, m)[n] + gt * v; } };


namespace pg8 {
#define PG8_LAS __attribute__((address_space(3)))
constexpr int BM = 256, BK = 64, HALF = 128, HTB = HALF * BK * 2  , STAGE_BYTES = 8 * HTB, NXCD = 8, WGM = 8;
__host__ __device__ __forceinline__ int lds_byte(int r, int c) { const int st = (r >> 4) * 2 + (c >> 5), rr = r & 15, cc = c & 31, ob = rr * 64 + cc * 2; return st * 1024 + (ob ^ (((ob >> 9) & 1) << 5)); }
__host__ __device__ __forceinline__ void stage_rc(int b, int& R, int& C) { const int st = b / 1024, sb = b % 1024, swz = sb ^ (((sb >> 9) & 1) << 5); R = (st >> 1) * 16 + swz / 64; C = (st & 1) * 32 + (swz % 64) / 2; }
__host__ __device__ __forceinline__ int perm32(int rho) { const int n = rho >> 4, i = rho & 15; return 8 * (i >> 2) + 4 * n + (i & 3); }
struct Unit { int pm, pn; };
struct Gemm { const f16* A; const f16* Bt; int lda, ldb, K, pn_grp, a_grp_cols; };
struct StaticOrder {
    int nM, nN, nwg, G, c, pn_off;
    __device__ void init(int M_, int N_, int G_, int c_, int pn_off_ = 0) { nM = M_ / BM; nN = N_ / BM; nwg = nM * nN; G = G_; c = c_; pn_off = pn_off_; }
    __device__ bool next(int i, Unit& u) const {
        const long Lx = (long)i * G + c; if (Lx >= nwg) return false;
        int wgid = (int)Lx; { const int q = nwg / NXCD, r = nwg % NXCD, xcd = wgid % NXCD, off = wgid / NXCD; wgid = (xcd < r ? xcd * (q + 1) : r * (q + 1) + (xcd - r) * q) + off; }
        const int nig = WGM * nN, gid = wgid / nig, fm = gid * WGM, gsz = (nM - fm) < WGM ? (nM - fm) : WGM;
        u.pm = fm + ((wgid % nig) % gsz); u.pn = pn_off + (wgid % nig) / gsz; return true;
    }
};
template <class Epi>
__device__ __forceinline__ void gemm_phase(PG8_LAS unsigned char* lds, const Gemm g, const StaticOrder& S, const Epi& E) {
    const int tid = ltid(), wid = __builtin_amdgcn_readfirstlane(tid >> 6), lane = tid & 63, wr = wid >> 2, wc = wid & 3, fr = lane & 15, fq = lane >> 4;
    const int K = g.K, nt = K / BK;
    unsigned voffA[2], voffB[2];
#pragma unroll
    for (int i = 0; i < 2; ++i) { int R, C; stage_rc(tid * 16 + i * 8192, R, C); const int Rb = Epi::PERM ? ((R & ~31) + perm32(R & 31)) : R;
        voffA[i] = (unsigned)(R * g.lda + C) * 2u; voffB[i] = (unsigned)(Rb * g.ldb + C) * 2u; }
    const size_t kstep = (size_t)(BK * 2);
    const size_t hstepA = (size_t)HALF * g.lda * 2, hstepB = (size_t)HALF * g.ldb * 2;
    const size_t tstepA = 2 * hstepA, tstepB = 2 * hstepB;
    const unsigned ldsw = (unsigned)wid * 1024u;
    const int aoff = lds_byte(wr * 64 + fr, fq * 8), boff = lds_byte(wc * 32 + fr, fq * 8);
#define PG8_SA(b, h) (((b) * 2 + (h)) * HTB)
#define PG8_SB(b, h) ((4 + (b) * 2 + (h)) * HTB)
#define PG8_STAGE(bufoff, gbase, voff) do { _Pragma("unroll") for (int _i = 0; _i < 2; ++_i) \
        __builtin_amdgcn_global_load_lds((const unsigned*)((const char*)(gbase) + (voff)[_i]), (PG8_LAS unsigned*)(lds + (bufoff) + ldsw + _i * 8192), 16, 0, 0); } while (0)
#define PG8_LDA(dst, b, h) do { _Pragma("unroll") for (int m = 0; m < 4; ++m) _Pragma("unroll") for (int k = 0; k < 2; ++k) dst[m][k] = *(const PG8_LAS f16x8*)(lds + PG8_SA(b, h) + aoff + m * 2048 + k * 1024); } while (0)
#define PG8_LDB(dst, b, h) do { _Pragma("unroll") for (int n = 0; n < 2; ++n) _Pragma("unroll") for (int k = 0; k < 2; ++k) dst[n][k] = *(const PG8_LAS f16x8*)(lds + PG8_SB(b, h) + boff + n * 2048 + k * 1024); } while (0)
#define PG8_MMA(ai, bj, At, Bt) do { __builtin_amdgcn_s_setprio(1); _Pragma("unroll") for (int m = 0; m < 4; ++m) _Pragma("unroll") for (int n = 0; n < 2; ++n) _Pragma("unroll") for (int k = 0; k < 2; ++k) \
        acc[ai][bj][m][n] = __builtin_amdgcn_mfma_f32_16x16x32_f16(Bt[n][k], At[m][k], acc[ai][bj][m][n], 0, 0, 0); __builtin_amdgcn_s_setprio(0); } while (0)
#define PG8_WAIT_V(n) asm volatile("s_waitcnt vmcnt(" #n ")" ::: "memory")
#define PG8_WAIT_L(n) asm volatile("s_waitcnt lgkmcnt(" #n ")" ::: "memory")
#define PG8_BAR __builtin_amdgcn_s_barrier()
#define PG8_SCHED __builtin_amdgcn_sched_barrier(0)
#define PG8_UA(u) ((const char*)g.A + (size_t)(u).pm * tstepA + (size_t)((u).pn / g.pn_grp) * g.a_grp_cols * 2)
#define PG8_UB(u) ((const char*)g.Bt + (size_t)(u).pn * tstepB)
    Unit cur, nxt; int ui = 0;
    if (!S.next(0, cur)) return;
    f32x4 acc[2][2][4][2];
#pragma unroll
    for (int a = 0; a < 2; ++a)
#pragma unroll
        for (int b = 0; b < 2; ++b)
#pragma unroll
            for (int m = 0; m < 4; ++m)
#pragma unroll
                for (int n = 0; n < 2; ++n) acc[a][b][m][n] = (f32x4){0.f, 0.f, 0.f, 0.f};
    f16x8 At[4][2], B0[2][2], B1[2][2];
    const char* cA = PG8_UA(cur); const char* cB = PG8_UB(cur);
    PG8_STAGE(PG8_SB(0, 0), cB, voffB); PG8_STAGE(PG8_SB(0, 1), cB + hstepB, voffB); PG8_STAGE(PG8_SA(0, 0), cA, voffA); PG8_STAGE(PG8_SA(0, 1), cA + hstepA, voffA);
    if (wr == 1) PG8_BAR;
    PG8_WAIT_V(2); PG8_BAR;
    PG8_STAGE(PG8_SB(1, 0), cB + kstep, voffB); PG8_STAGE(PG8_SA(1, 0), cA + kstep, voffA); PG8_STAGE(PG8_SB(1, 1), cB + hstepB + kstep, voffB);
    PG8_WAIT_V(6); PG8_BAR;
    for (;;) {
        const bool has_next = S.next(ui + 1, nxt);
        const char* nA = has_next ? PG8_UA(nxt) : cA; const char* nB = has_next ? PG8_UB(nxt) : cB;
        for (int t = 0; t < nt; t += 2) {
            const bool last = (t == nt - 2);
            const char* a1 = cA + (size_t)(t + 1) * kstep;
            const char* a2 = last ? nA : cA + (size_t)(t + 2) * kstep; const char* b2 = last ? nB : cB + (size_t)(t + 2) * kstep;
            const char* a3 = a2 + kstep; const char* b3 = b2 + kstep;
            PG8_LDB(B0, 0, 0); PG8_LDB(B1, 0, 1); PG8_SCHED; PG8_LDA(At, 0, 0); PG8_STAGE(PG8_SA(1, 1), a1 + hstepA, voffA);
            PG8_WAIT_V(8); PG8_WAIT_L(0); PG8_BAR; PG8_MMA(0, 0, At, B0); PG8_MMA(0, 1, At, B1); PG8_BAR; PG8_SCHED;
            PG8_LDA(At, 0, 1); PG8_STAGE(PG8_SB(0, 0), b2, voffB); PG8_STAGE(PG8_SB(0, 1), b2 + hstepB, voffB); PG8_STAGE(PG8_SA(0, 0), a2, voffA);
            PG8_WAIT_V(8); PG8_WAIT_L(0); PG8_BAR; PG8_MMA(1, 0, At, B0); PG8_MMA(1, 1, At, B1); PG8_BAR; PG8_SCHED;
            PG8_LDB(B0, 1, 0); PG8_LDB(B1, 1, 1); PG8_SCHED; PG8_LDA(At, 1, 0); PG8_STAGE(PG8_SA(0, 1), a2 + hstepA, voffA);
            PG8_WAIT_V(8); PG8_WAIT_L(0); PG8_BAR; PG8_MMA(0, 0, At, B0); PG8_MMA(0, 1, At, B1); PG8_BAR; PG8_SCHED;
            PG8_LDA(At, 1, 1); PG8_STAGE(PG8_SB(1, 0), b3, voffB); PG8_STAGE(PG8_SB(1, 1), b3 + hstepB, voffB); PG8_STAGE(PG8_SA(1, 0), a3, voffA);
            PG8_WAIT_V(8); PG8_WAIT_L(0); PG8_BAR; PG8_MMA(1, 0, At, B0); PG8_MMA(1, 1, At, B1); PG8_BAR; PG8_SCHED;
        }
        if (wr == 0) PG8_BAR;
        E(acc, cur, wr, wc, fr, fq);
        if (!has_next) break;
#pragma unroll
        for (int a = 0; a < 2; ++a)
#pragma unroll
            for (int b = 0; b < 2; ++b)
#pragma unroll
                for (int m = 0; m < 4; ++m)
#pragma unroll
                    for (int n = 0; n < 2; ++n) acc[a][b][m][n] = (f32x4){0.f, 0.f, 0.f, 0.f};
        cur = nxt; cA = nA; cB = nB; ++ui;
        if (wr == 1) PG8_BAR;
    }
    PG8_WAIT_V(0);
    PG8_BAR;
#undef PG8_SA
#undef PG8_SB
#undef PG8_STAGE
#undef PG8_LDA
#undef PG8_LDB
#undef PG8_MMA
#undef PG8_WAIT_V
#undef PG8_WAIT_L
#undef PG8_BAR
#undef PG8_SCHED
#undef PG8_UA
#undef PG8_UB
}
struct EpiP { static constexpr bool PERM = true; f16* O; int coff;
    __device__ __forceinline__ void operator()(const f32x4 (&acc)[2][2][4][2], const Unit& u, int wr, int wc, int fr, int fq) const {
        const int row0 = u.pm * BM + wr * 64 + fr, col0 = coff + u.pn * BM + wc * 32 + 8 * fq;
#pragma unroll
        for (int ai = 0; ai < 2; ++ai)
#pragma unroll
            for (int m = 0; m < 4; ++m) { f16* rowp = O + (size_t)(row0 + ai * HALF + m * 16) * NP + col0;
#pragma unroll
                for (int bj = 0; bj < 2; ++bj) { const f32x4 v0 = acc[ai][bj][m][0], v1 = acc[ai][bj][m][1];
                    u32x4 w; w.x = pkh(v0[0], v0[1]); w.y = pkh(v0[2], v0[3]); w.z = pkh(v1[0], v1[1]); w.w = pkh(v1[2], v1[3]);
                    *(u32x4*)(rowp + bj * HALF) = w; } }
    }
};
struct EpiBr { static constexpr bool PERM = true; f16* G3; f16* G3b; const f16* P; f16* MRG;
    __device__ __forceinline__ void operator()(const f32x4 (&acc)[2][2][4][2], const Unit& u, int wr, int wc, int fr, int fq) const {
        const int row0 = u.pm * BM + wr * 64 + fr, colg = u.pn * BM + wc * 32 + 8 * fq, br = u.pn >> 3, col0 = colg - br * D;
        f16* Ob = MRG ? MRG : G3b + (size_t)(br - 1) * M * D;
#pragma unroll
        for (int ai = 0; ai < 2; ++ai)
#pragma unroll
            for (int m = 0; m < 4; ++m) { const int row = row0 + ai * HALF + m * 16;
#pragma unroll
                for (int bj = 0; bj < 2; ++bj) { const f32x4 v0 = acc[ai][bj][m][0], v1 = acc[ai][bj][m][1];
                    const f16x8 gp = *(const f16x8*)(P + (size_t)row * NP + C_MRG + colg + bj * HALF);
                    float o[8];
#pragma unroll
                    for (int e = 0; e < 8; ++e) o[e] = (e < 4 ? v0[e] : v1[e - 4]) * __builtin_amdgcn_rcpf(1.f + __expf(-(float)gp[e]));
                    if (MRG) { const f16x8 x1 = *(const f16x8*)(G3b + (size_t)row * D + col0 + bj * HALF), x2 = *(const f16x8*)(G3b + (size_t)M * D + (size_t)row * D + col0 + bj * HALF);
#pragma unroll
                        for (int e = 0; e < 8; ++e) o[e] += (float)x1[e] + (float)x2[e]; }
                    u32x4 w; w.x = pkh(o[0], o[1]); w.y = pkh(o[2], o[3]); w.z = pkh(o[4], o[5]); w.w = pkh(o[6], o[7]);
                    *(u32x4*)(Ob + (size_t)row * D + col0 + bj * HALF) = w; } }
    }
};
struct EpiZ { static constexpr bool PERM = false; Args a; int l;
    __device__ __forceinline__ void operator()(const f32x4 (&acc)[2][2][4][2], const Unit& u, int wr, int wc, int fr, int fq) const {
        const int row0 = u.pm * BM + wr * 64 + fr, col0 = u.pn * BM + wc * 32 + 4 * fq;
        float* Z = (float*)(a.ws + WS_Z); const float* modv = (const float*)(a.ws + WS_MODV) + (size_t)l * 3 * 6144 + 4096;
#pragma unroll
        for (int ai = 0; ai < 2; ++ai)
#pragma unroll
            for (int m = 0; m < 4; ++m) { const int row = row0 + ai * HALF + m * 16; const int b = row / L, t = row % L;
                const float* zr = zrow(a, l, row); const float* gt = modv + (size_t)(t < NCTX ? 2 : b) * 6144;
#pragma unroll
                for (int bj = 0; bj < 2; ++bj)
#pragma unroll
                    for (int n = 0; n < 2; ++n) { const int c = col0 + bj * HALF + n * 16;
                        const f32x4 zo = *(const f32x4*)(zr + c), gv = *(const f32x4*)(gt + c);
                        *(f32x4*)(Z + (size_t)row * D + c) = zo + gv * acc[ai][bj][m][n]; } }
    }
};
}

__device__ __forceinline__ float shifted(const f16* P, const float* mu, int m, int col) {
  const int t = m % L; const float s = (float)P[(size_t)m * NP + col];
  const float pv = (t == 0 || t == NCTX) ? 0.f : (float)P[(size_t)(m - 1) * NP + col];
  const float nx = (t == L - 1 || t == NCTX - 1) ? 0.f : (float)P[(size_t)(m + 1) * NP + col];
  return s + mu[col] * (pv - s) + mu[3328 + col] * (nx - s);
}
namespace pp {
constexpr int WTP = 72, RAWP = 456, XAP = 72;
constexpr int OFF_WT = 0, OFF_RAW = OFF_WT + 4 * 64 * WTP * 2, OFF_XA = OFF_RAW + 34 * RAWP * 2, OFF_SH = OFF_XA + 4 * 32 * XAP * 2, OFF_NR = OFF_SH + 3 * 32 * 64 * 4, OFF_CST = OFF_NR + 256, OFF_END = OFF_CST + 1344 * 4;
static_assert(OFF_END <= LDS_BYTES, "prep LDS");
}
__device__ __forceinline__ void ph_prep(const Args& a, int l, unsigned char* lds, int part = 3, int b0 = 0, int nb = 0) {
  using namespace pp;
  const int tid = ltid(), lane = tid & 63, wave = __builtin_amdgcn_readfirstlane(tid >> 6), fr = lane & 15, fq = lane >> 4;
  const f16* P = (const f16*)(a.ws + WS_P);
  const float* mu = a.in[8] + (size_t)l * 2 * 3328;
  f16* WT = (f16*)(lds + OFF_WT); f16* RAW = (f16*)(lds + OFF_RAW); f16* XA = (f16*)(lds + OFF_XA); float* SH = (float*)(lds + OFF_SH); float* NRI = (float*)(lds + OFF_NR); float* CST = (float*)(lds + OFF_CST);
  float* RKD = (float*)(a.ws + WS_RKD);
  int cur_h = -1;
  const int NU = 272 * 16;
  f16x8 pre[4];
#define PREP_LOAD(u_) do { const int h_ = (u_) & 15, m0_ = ((u_) >> 4) * 32; \
    _Pragma("unroll") for (int i = 0; i < 4; ++i) { const int q = tid + NT * i; if (q < 34 * 56) { const int row = q / 56, cu = q % 56; int mm = m0_ - 1 + row; mm = mm < 0 ? 0 : (mm > M - 1 ? M - 1 : mm); \
      const int col = cu < 24 ? (cu >> 3) * 1024 + h_ * 64 + (cu & 7) * 8 : C_WD + (cu - 24) * 8; pre[i] = *(const f16x8*)(P + (size_t)mm * NP + col); } } } while (0)
  const int pg_ = lbid() >> 4, ph_ = lbid() & 15;
  const bool pbal = (gridDim.x == 256);
  const int pt0 = pbal ? pg_ * 17 : pg_, pcnt = pbal ? 17 : (272 - pg_ + (int)(gridDim.x >> 4) - 1) / (int)(gridDim.x >> 4), pstep = pbal ? 1 : (int)(gridDim.x >> 4);
  (void)NU;
  if ((part & 1) && pcnt > 0) PREP_LOAD((pt0 * 16 + ph_));
  if (part & 1)
  for (int pk = 0; pk < pcnt; ++pk) { const int u = (pt0 + pk * pstep) * 16 + ph_;
    const int tid = ltid(), lane = tid & 63, wave = __builtin_amdgcn_readfirstlane(tid >> 6), fr = lane & 15, fq = lane >> 4;
    const int h = u & 15, m0 = (u >> 4) * 32, b = m0 / L, t0 = m0 % L;
    __syncthreads();
    if (h != cur_h) { cur_h = h;
#pragma unroll 4
      for (int i = tid; i < 4 * 64 * 64; i += NT) { const int mt = i >> 12, j = (i >> 6) & 63, c = i & 63, d = mt >> 1;
        const float* src = (mt & 1) ? a.in[11] : a.in[9];
        WT[(mt * 64 + c) * WTP + j] = (f16)src[(((size_t)l * 2 + d) * 64 + j) * 1024 + h * 64 + c]; }
      for (int i = tid; i < 1344; i += NT) { float v;
        if (i < 512) v = mu[(i >> 8) * 3328 + C_WD + (i & 255)];
        else if (i < 896) { const int q = i - 512, w1 = q / 192, e = q % 192; v = mu[w1 * 3328 + (e >> 6) * 1024 + h * 64 + (e & 63)]; }
        else if (i < 960) v = a.in[13][l * 1024 + h * 64 + (i - 896)];
        else if (i < 1024) v = a.in[14][l * 1024 + h * 64 + (i - 960)];
        else if (i < 1088) v = a.in[15][l * 1024 + h * 64 + (i - 1024)];
        else if (i < 1216) { const int q = i - 1088; v = a.in[10][(l * 2 + (q >> 6)) * 1024 + h * 64 + (q & 63)]; }
        else { const int q = i - 1216; v = a.in[12][(l * 2 + (q >> 6)) * 1024 + h * 64 + (q & 63)]; }
        CST[i] = v; } }
#pragma unroll
    for (int i = 0; i < 4; ++i) { const int q = tid + NT * i; if (q < 34 * 56) { const int row = q / 56, cu = q % 56;
      *(f16x8*)(RAW + row * RAWP + (cu < 24 ? cu * 8 : 192 + (cu - 24) * 8)) = pre[i]; } }
    __syncthreads();
    if (pk + 1 < pcnt) PREP_LOAD((u + pstep * 16));
    { const int tok = tid >> 4, cg = tid & 15, t = t0 + tok; const bool zp = (t == 0 || t == NCTX), zn = (t == L - 1 || t == NCTX - 1);
      const f16* rp = RAW + tok * RAWP + 192 + 16 * cg;
      const int c0 = 16 * cg, mt = c0 < 128 ? 2 * (c0 >> 6) : 2 * ((c0 - 128) >> 6) + 1, j0 = c0 & 63;
#pragma unroll
      for (int hf = 0; hf < 2; ++hf) { const f16x8 pv = *(const f16x8*)(rp + hf * 8), cv = *(const f16x8*)(rp + RAWP + hf * 8), nv = *(const f16x8*)(rp + 2 * RAWP + hf * 8);
        const float* m0p = CST + c0 + hf * 8; f16x8 o;
#pragma unroll
        for (int e = 0; e < 8; ++e) { const float sv = (float)cv[e], p = zp ? 0.f : (float)pv[e], n = zn ? 0.f : (float)nv[e];
          float x = sv + m0p[e] * (p - sv) + m0p[256 + e] * (n - sv); if (!(mt & 1)) x = tanh_f(x); o[e] = (f16)x; }
        *(f16x8*)(XA + (mt * 32 + tok) * XAP + j0 + hf * 8) = o; } }
#pragma unroll
    for (int it = 0; it < 2; ++it) { const int q = tid + NT * it; if (q < 32 * 24) { const int tok = q / 24, g8 = q % 24, seg = g8 >> 3, ch = (g8 & 7) * 8, t = t0 + tok;
        const bool zp = (t == 0 || t == NCTX), zn = (t == L - 1 || t == NCTX - 1);
        const f16* rp = RAW + tok * RAWP + g8 * 8; const f16x8 pv = *(const f16x8*)rp, cv = *(const f16x8*)(rp + RAWP), nv = *(const f16x8*)(rp + 2 * RAWP);
        const float* m0p = CST + 512 + seg * 64 + ch; float o[8];
#pragma unroll
        for (int e = 0; e < 8; ++e) { const float sv = (float)cv[e], p = zp ? 0.f : (float)pv[e], n = zn ? 0.f : (float)nv[e]; o[e] = sv + m0p[e] * (p - sv) + m0p[192 + e] * (n - sv); }
        float* dst = SH + (seg * 32 + tok) * 64 + ch; *(f32x4*)dst = (f32x4){o[0], o[1], o[2], o[3]}; *(f32x4*)(dst + 4) = (f32x4){o[4], o[5], o[6], o[7]}; } }
    __syncthreads();
    const int ti = wave & 1, d = (wave >> 1) & 1, chalf = wave >> 2;
    f32x4 acc[2][2];
#pragma unroll
    for (int m2 = 0; m2 < 2; ++m2)
#pragma unroll
      for (int c2 = 0; c2 < 2; ++c2) { acc[m2][c2] = (f32x4){0.f, 0.f, 0.f, 0.f};
#pragma unroll
        for (int ks = 0; ks < 2; ++ks) acc[m2][c2] = __builtin_amdgcn_mfma_f32_16x16x32_f16(*(const f16x8*)(XA + ((2 * d + m2) * 32 + 16 * ti + fr) * XAP + ks * 32 + fq * 8),
                                                                                             *(const f16x8*)(WT + ((2 * d + m2) * 64 + 16 * (2 * chalf + c2) + fr) * WTP + ks * 32 + fq * 8), acc[m2][c2], 0, 0, 0); }
    __syncthreads();
    unsigned char* SR = lds + OFF_RAW;
    { const int tok = 4 * wave + (lane >> 4), c4 = (lane & 15) * 4;
      const f32x4 r4 = *(const f32x4*)(SH + (0 * 32 + tok) * 64 + c4), k4 = *(const f32x4*)(SH + (1 * 32 + tok) * 64 + c4), v4 = *(const f32x4*)(SH + (2 * 32 + tok) * 64 + c4);
      const f32x4 kkw = *(const f32x4*)(CST + 896 + c4), rkw = *(const f32x4*)(CST + 1024 + c4);
      const f32x4 kk = k4 * kkw, rkp = r4 * k4 * rkw;
      const float n2 = red16((kk.x * kk.x + kk.y * kk.y) + (kk.z * kk.z + kk.w * kk.w)), rk = red16((rkp.x + rkp.y) + (rkp.z + rkp.w));
      const float inv = 1.f / fmaxf(sqrtf(n2), 1e-12f);
      unsigned char* o = SR + tok * SIR + c4 * 2;
      uint2 w; w.x = pkh(r4.x, r4.y); w.y = pkh(r4.z, r4.w); *(uint2*)o = w;
      w.x = pkh(k4.x, k4.y); w.y = pkh(k4.z, k4.w); *(uint2*)(o + 128) = w;
      w.x = pkh(v4.x, v4.y); w.y = pkh(v4.z, v4.w); *(uint2*)(o + 256) = w;
      if ((lane & 15) == 0) { *(f32x4*)(SR + tok * SIR + 384) = (f32x4){inv, 0.f, 0.f, 0.f}; RKD[(size_t)(m0 + tok) * 16 + h] = rk; } }
#pragma unroll
    for (int c2 = 0; c2 < 2; ++c2) { const int ch = 16 * (2 * chalf + c2) + fr, c = h * 64 + ch;
      const float w0v = CST[1088 + d * 64 + ch], a0v = CST[1216 + d * 64 + ch];
#pragma unroll
      for (int r = 0; r < 4; ++r) { const int tok = 16 * ti + 4 * fq + r;
        const float wl = w0v + acc[0][c2][r]; const float dec = __expf(-0.6065306597126334f * sigm_f(wl));
        const float ag = sigm_f(a0v + acc[1][c2][r]);
        unsigned char* o = SR + tok * SIR + 400 + d * 256;
        ((f16*)o)[ch] = (f16)(1.f - dec); ((f16*)(o + 128))[ch] = (f16)ag; } }
    __syncthreads();
    { unsigned char* dstg = a.ws + WS_SI + ((size_t)(b * 16 + h) * L + t0) * SIR;
#pragma unroll
      for (int i = 0; i < 4; ++i) { const int q = tid + NT * i; if (q < 32 * SIR / 16) *(u32x4*)(dstg + (size_t)q * 16) = *(const u32x4*)(SR + q * 16); } }
  }
#undef PREP_LOAD
  __syncthreads();
  f16* QN = (f16*)(a.ws + WS_QN); f16* KN = (f16*)(a.ws + WS_KN);
  f32x2* cst = (f32x2*)lds;
  for (int i = tid; i < 64 * 32; i += NT) { const int pos = i >> 5, fi = i & 31; const float ang = (float)pos * powf(10000.f, -(float)(2 * fi) / 64.f); cst[i] = (f32x2){cosf(ang), sinf(ang)}; }
  __syncthreads();
  if (nb == 0) nb = gridDim.x;
  const int gw = (lbid() - b0) * 8 + wave, NGW = nb * 8;
  const int ax = lane >> 5, fi = lane & 31;
  if (part & 2)
  for (int m = gw; m < M; m += NGW) {
    const int t = m % L; const f16* pr = P + (size_t)m * NP;
    float x1[10], x2[10], ss[10];
#pragma unroll
    for (int hh = 0; hh < 10; ++hh) { const int src = hh < 8 ? C_ATQ + hh * 128 : C_ATK + (hh - 8) * 128; x1[hh] = (float)pr[src + ax * 64 + fi]; x2[hh] = (float)pr[src + ax * 64 + 32 + fi]; ss[hh] = x1[hh] * x1[hh] + x2[hh] * x2[hh]; }
    const f16x4 vc = *(const f16x4*)(pr + C_ATV + 4 * lane);
#pragma unroll
    for (int hh = 0; hh < 10; ++hh) ss[hh] = wave_sum(ss[hh]);
    f32x2 cs = {1.f, 0.f};
    if (t >= NCTX) { const int n = t - NCTX; cs = cst[(ax == 0 ? n / 64 : n % 64) * 32 + fi]; }
#pragma unroll
    for (int hh = 0; hh < 10; ++hh) { const float* g = (hh < 8 ? a.in[18] : a.in[19]) + l * 128; const float rstd = rsqrtf(ss[hh] * (1.f / 128.f) + 1e-6f);
      const float y1 = x1[hh] * rstd * g[ax * 64 + fi], y2 = x2[hh] * rstd * g[ax * 64 + 32 + fi];
      f16* dst = hh < 8 ? QN + (size_t)m * 1024 + hh * 128 : KN + (size_t)m * 512 + (hh - 8) * 128;
      dst[ax * 64 + fi] = (f16)(y1 * cs.x - y2 * cs.y); dst[ax * 64 + 32 + fi] = (f16)(y1 * cs.y + y2 * cs.x); }
    *(f16x4*)(KN + (size_t)m * 512 + 256 + 4 * lane) = vc;
  }
}

__device__ __forceinline__ int scan_tok(int dir, int i) { return dir == 0 ? i : (i < NCTX ? NCTX - 1 - i : L - 1 - (i - NCTX)); }

namespace rw {
constexpr int T = 16;
constexpr int STEPF = 6 * 64;
constexpr int BUFF = T * STEPF;
constexpr int YR_OFF = 2 * BUFF, YRING = T * 512;
template <int CTRL> __device__ __forceinline__ float dpp(float x) { return __int_as_float(__builtin_amdgcn_update_dpp(0, __float_as_int(x), CTRL, 0xF, 0xF, true)); }
__device__ __forceinline__ float red8(float x) { x += dpp<0xB1>(x); x += dpp<0x4E>(x); x += dpp<0x141>(x); return x; }
struct Ops { f32x4 r0, r1, k0, k1, w0, w1, b0, b1, d0, d1; f32x2 v; };
typedef __attribute__((address_space(3))) const float lcf;
__device__ __forceinline__ void ld_ops(Ops& o, lcf* st, lcf* vp) {
  o.r0 = *(const __attribute__((address_space(3))) f32x4*)(st); o.r1 = *(const __attribute__((address_space(3))) f32x4*)(st + 4);
  o.k0 = *(const __attribute__((address_space(3))) f32x4*)(st + 64); o.k1 = *(const __attribute__((address_space(3))) f32x4*)(st + 68);
  o.w0 = *(const __attribute__((address_space(3))) f32x4*)(st + 192); o.w1 = *(const __attribute__((address_space(3))) f32x4*)(st + 196);
  o.b0 = *(const __attribute__((address_space(3))) f32x4*)(st + 256); o.b1 = *(const __attribute__((address_space(3))) f32x4*)(st + 260);
  o.d0 = *(const __attribute__((address_space(3))) f32x4*)(st + 320); o.d1 = *(const __attribute__((address_space(3))) f32x4*)(st + 324);
  o.v = *(const __attribute__((address_space(3))) f32x2*)(vp);
}
#define RW_LO(v_) __builtin_shufflevector(v_, v_, 0, 1)
#define RW_HI(v_) __builtin_shufflevector(v_, v_, 2, 3)
#define RW_FMA(a_, b_, c_) __builtin_elementwise_fma(a_, b_, c_)
#define RW_DPP(r_, ctrl) "v_add_f32_dpp " r_ ", " r_ ", " r_ " " ctrl " row_mask:0xf bank_mask:0xf bound_ctrl:1\n\t"
__device__ __forceinline__ void step(f32x2 (&S0)[4], f32x2 (&S1)[4], const Ops& o, __attribute__((address_space(3))) f32x2* yw) {
  const f32x2 K[4] = {RW_LO(o.k0), RW_HI(o.k0), RW_LO(o.k1), RW_HI(o.k1)}, R[4] = {RW_LO(o.r0), RW_HI(o.r0), RW_LO(o.r1), RW_HI(o.r1)};
  const f32x2 W[4] = {RW_LO(o.w0), RW_HI(o.w0), RW_LO(o.w1), RW_HI(o.w1)}, Bv[4] = {RW_LO(o.b0), RW_HI(o.b0), RW_LO(o.b1), RW_HI(o.b1)};
  const f32x2 Dv[4] = {RW_LO(o.d0), RW_HI(o.d0), RW_LO(o.d1), RW_HI(o.d1)};
  f32x2 a0 = S0[0] * K[0], a1 = S1[0] * K[0];
#pragma unroll
  for (int j = 1; j < 4; ++j) { a0 = RW_FMA(S0[j], K[j], a0); a1 = RW_FMA(S1[j], K[j], a1); }
  float x0 = a0.x + a0.y, x1 = a1.x + a1.y;
  f32x2 m0, m1;
  asm("s_nop 1\n\t" RW_DPP("%0", "quad_perm:[1,0,3,2]") RW_DPP("%1", "quad_perm:[1,0,3,2]") "v_pk_mul_f32 %2, %4, %6\n\t"
      RW_DPP("%0", "quad_perm:[2,3,0,1]") RW_DPP("%1", "quad_perm:[2,3,0,1]") "v_pk_mul_f32 %3, %5, %6\n\t"
      RW_DPP("%0", "row_half_mirror") RW_DPP("%1", "row_half_mirror")
      : "+v"(x0), "+v"(x1), "=&v"(m0), "=&v"(m1) : "v"(S0[0]), "v"(S1[0]), "v"(W[0]));
  const f32x2 vx = {o.v.x, o.v.x}, vy = {o.v.y, o.v.y};
  f32x2 t0[4], t1[4];
  t0[0] = RW_FMA(vx, Dv[0], m0); t1[0] = RW_FMA(vy, Dv[0], m1);
#pragma unroll
  for (int j = 1; j < 4; ++j) { t0[j] = RW_FMA(vx, Dv[j], S0[j] * W[j]); t1[j] = RW_FMA(vy, Dv[j], S1[j] * W[j]); }
  const f32x2 n0 = {-x0, -x0}, n1 = {-x1, -x1};
#pragma unroll
  for (int j = 0; j < 4; ++j) { S0[j] = RW_FMA(n0, Bv[j], t0[j]); S1[j] = RW_FMA(n1, Bv[j], t1[j]); }
  f32x2 y0 = S0[0] * R[0], y1 = S1[0] * R[0];
#pragma unroll
  for (int j = 1; j < 4; ++j) { y0 = RW_FMA(S0[j], R[j], y0); y1 = RW_FMA(S1[j], R[j], y1); }
  float ya = y0.x + y0.y, yb = y1.x + y1.y; asm("" : "+v"(ya), "+v"(yb));
  *yw = (f32x2){ya, yb};
}
__device__ __forceinline__ void scan_unit(const Args& a, int l, int u, unsigned char* ldsb) {
  const int tid = ltid(), wave = tid >> 6;
  const int dir = u & 1, bh = u >> 1, b = bh >> 4, h = bh & 15;
  const unsigned char* SIb = a.ws + WS_SI + (size_t)bh * L * SIR;
  f16* Y = (f16*)(a.ws + WS_YRW) + (size_t)dir * M * 1024 + (size_t)b * L * 1024 + h * 64;
  float* sbuf = (float*)ldsb;
  constexpr int NC = L / T;
  if (wave >= 4) {
    const int lt = tid - 256;
    const int lpart = lt >> 7, ls = (lt >> 3) & 15, lg = lt & 7;
    float ckk[8], cka[8];
#pragma unroll
    for (int e = 0; e < 8; ++e) { ckk[e] = a.in[13][l * 1024 + h * 64 + lg * 8 + e]; cka[e] = a.in[14][l * 1024 + h * 64 + lg * 8 + e]; }
    u32x4 regs[3];
    auto issue = [&](int c) {
      const unsigned char* rec = SIb + (size_t)scan_tok(dir, c * T + ls) * SIR; const int dof = 400 + dir * 256 + lg * 16;
      regs[0] = *(const u32x4*)(rec + (lpart ? 128 : 0) + lg * 16);
      regs[1] = *(const u32x4*)(rec + (lpart ? dof + 128 : 256 + lg * 16));
      regs[2] = *(const u32x4*)(rec + (lpart ? 384 : dof));
    };
    auto commit = [&](int c) {
      float* d0 = sbuf + (c & 1) * BUFF + ls * STEPF + lg * 8;
      const f16x8 h0 = __builtin_bit_cast(f16x8, regs[0]), h1 = __builtin_bit_cast(f16x8, regs[1]);
      float o0[8], o1[8], o2[8];
      if (lpart == 0) { const f16x8 h2 = __builtin_bit_cast(f16x8, regs[2]);
#pragma unroll
        for (int e = 0; e < 8; ++e) { o0[e] = (float)h0[e]; o1[e] = (float)h1[e]; o2[e] = 1.f - (float)h2[e]; }
        *(f32x4*)(d0) = (f32x4){o0[0], o0[1], o0[2], o0[3]}; *(f32x4*)(d0 + 4) = (f32x4){o0[4], o0[5], o0[6], o0[7]};
        *(f32x4*)(d0 + 128) = (f32x4){o1[0], o1[1], o1[2], o1[3]}; *(f32x4*)(d0 + 132) = (f32x4){o1[4], o1[5], o1[6], o1[7]};
        *(f32x4*)(d0 + 192) = (f32x4){o2[0], o2[1], o2[2], o2[3]}; *(f32x4*)(d0 + 196) = (f32x4){o2[4], o2[5], o2[6], o2[7]}; }
      else { const float inv = __uint_as_float(regs[2].x);
#pragma unroll
        for (int e = 0; e < 8; ++e) { const float k = (float)h0[e], ag = (float)h1[e]; o0[e] = k * ckk[e] * inv; o1[e] = o0[e] * ag; o2[e] = k * (1.f + (ag - 1.f) * cka[e]); }
        *(f32x4*)(d0 + 64) = (f32x4){o0[0], o0[1], o0[2], o0[3]}; *(f32x4*)(d0 + 68) = (f32x4){o0[4], o0[5], o0[6], o0[7]};
        *(f32x4*)(d0 + 256) = (f32x4){o1[0], o1[1], o1[2], o1[3]}; *(f32x4*)(d0 + 260) = (f32x4){o1[4], o1[5], o1[6], o1[7]};
        *(f32x4*)(d0 + 320) = (f32x4){o2[0], o2[1], o2[2], o2[3]}; *(f32x4*)(d0 + 324) = (f32x4){o2[4], o2[5], o2[6], o2[7]}; }
    };
    auto yred = [&](int c) {
      const float* ring = sbuf + YR_OFF + (c & 1) * YRING;
#pragma unroll
      for (int i = 0; i < (T * 32) / 256; ++i) { const int it = lt + 256 * i, s = it >> 5, p = it & 31;
        const f32x4* src = (const f32x4*)(ring + s * 512 + p * 16);
        const f32x4 q = (src[0] + src[1]) + (src[2] + src[3]);
        *(unsigned*)(Y + (size_t)scan_tok(dir, c * T + s) * 1024 + 2 * p) = pkh(q.x + q.z, q.y + q.w); }
    };
    issue(0); commit(0);
    __syncthreads();
    for (int c = 0; c < NC; ++c) {
      if (c + 1 < NC) issue(c + 1);
      if (c > 0) yred(c - 1);
      if (c + 1 < NC) commit(c + 1);
      __syncthreads();
    }
    yred(NC - 1);
  } else {
    const int p = tid >> 3, ks = tid & 7;
    __builtin_amdgcn_s_setprio(2);
    f32x2 S0[4], S1[4];
#pragma unroll
    for (int k = 0; k < 4; ++k) { S0[k] = (f32x2){0.f, 0.f}; S1[k] = (f32x2){0.f, 0.f}; }
    typedef __attribute__((address_space(3))) f32x2 lf2;
    __syncthreads();
    for (int c = 0; c < NC; ++c) {
      lcf* buf = (lcf*)(sbuf + (c & 1) * BUFF) + ks * 8; lcf* vb = (lcf*)(sbuf + (c & 1) * BUFF) + 128 + 2 * p;
      lf2* yw = (lf2*)(sbuf + YR_OFF + (c & 1) * YRING) + tid;
      Ops A, B;
      ld_ops(A, buf, vb);
#pragma unroll 1
      for (int s = 0; s < T; s += 2) {
        ld_ops(B, buf + (s + 1) * STEPF, vb + (s + 1) * STEPF);
        step(S0, S1, A, yw + s * 256);
        __builtin_amdgcn_sched_barrier(0);
        ld_ops(A, buf + (s + 2) * STEPF, vb + (s + 2) * STEPF);
        step(S0, S1, B, yw + (s + 1) * 256);
        __builtin_amdgcn_sched_barrier(0);
      }
      __syncthreads();
    }
    __builtin_amdgcn_s_setprio(0);
  }
}
}


namespace ml {
constexpr int PT = 136;
constexpr int OFF_Q = 0, OFF_K = 128 * PT * 2, OFF_KT = 2 * 128 * PT * 2, OFF_VT = 3 * 128 * PT * 2, OFF_CT = OFF_VT + 80 * PT * 2, OFF_SC = OFF_CT + 80 * PT * 2;
constexpr int LDS_NEED = OFF_SC + 6 * 512 + 256 + 64;
static_assert(LDS_NEED <= LDS_BYTES, "mLSTM LDS");
constexpr int NCH = L / 128;
#define MFMA16(a_, b_, c_) __builtin_amdgcn_mfma_f32_16x16x32_f16(a_, b_, c_, 0, 0, 0)
__device__ __forceinline__ void mlstm_unit(const Args& a, int l, int u, unsigned char* lds) {
  const int tid = ltid(), lane = tid & 63, w = __builtin_amdgcn_readfirstlane(tid >> 6), fr = lane & 15, fq = lane >> 4;
  const int dir = u & 1, vs = (u >> 1) & 3, bh = u >> 3, b = bh >> 2, h = bh & 3;
  const f16* P = (const f16*)(a.ws + WS_P) + (size_t)b * L * NP; const float* GP = (const float*)(a.ws + WS_GPRE) + (size_t)b * L * 16; const float* gb = a.in[20] + l * 16;
  f16* HM = (f16*)(a.ws + WS_HM) + (size_t)dir * M * 1024 + (size_t)b * L * 1024 + h * 256 + vs * 64;
  f16* Qs = (f16*)(lds + OFF_Q); f16* Ks = (f16*)(lds + OFF_K); f16* KTs = (f16*)(lds + OFF_KT); f16* VTs = (f16*)(lds + OFF_VT); f16* CTs = (f16*)(lds + OFF_CT);
  float* sc = (float*)(lds + OFF_SC); float* li = sc; float* bcs = sc + 128; float* uu = sc + 256; float* Mx = sc + 384; float* wint = sc + 512; float* emt = sc + 640; f16* wah = (f16*)(sc + 768);
  const float bi = gb[dir * 4 + h], bfg = gb[(2 + dir) * 4 + h];
  __syncthreads();
  for (int i = tid; i < 16 * PT; i += NT) VTs[64 * PT + i] = (f16)(i < PT ? 1.f : 0.f);
  for (int i = tid; i < 80 * PT; i += NT) CTs[i] = (f16)0.f;
  f32x4 CT[5];
#pragma unroll
  for (int n = 0; n < 5; ++n) CT[n] = (f32x4){0.f, 0.f, 0.f, 0.f};
  float mcar = 0.f;
  const int sgn = dir ? -1 : 1;
  f16x8 pq[4], pk[4], pv[2];
#define ML_LOAD(c) do { const int tb_ = scan_tok(dir, 128 * (c)); \
    _Pragma("unroll") for (int i = 0; i < 4; ++i) { const int un = tid + NT * i, j = un >> 4, d8 = un & 15; const f16* rp = P + (size_t)(tb_ + sgn * j) * NP; \
      pq[i] = *(const f16x8*)(rp + C_MLQ + h * 128 + d8 * 8); pk[i] = *(const f16x8*)(rp + C_MLK + h * 128 + d8 * 8); } \
    _Pragma("unroll") for (int i = 0; i < 2; ++i) { const int un = tid + NT * i, j = un >> 3, v8 = un & 7; \
      pv[i] = *(const f16x8*)(P + (size_t)(tb_ + sgn * j) * NP + C_MLV + h * 256 + vs * 64 + v8 * 8); } } while (0)
  ML_LOAD(0);
  for (int c = 0; c < NCH; ++c) {
    const int tb = scan_tok(dir, 128 * c);
    __syncthreads();
#pragma unroll
    for (int i = 0; i < 4; ++i) { const int un = tid + NT * i, j = un >> 4, d8 = un & 15;
      f16x8 qv;
#pragma unroll
      for (int e = 0; e < 8; ++e) qv[e] = (f16)((float)pq[i][e] * 0.08838834764831845f);
      *(f16x8*)(Qs + j * PT + d8 * 8) = qv; *(f16x8*)(Ks + j * PT + d8 * 8) = pk[i];
#pragma unroll
      for (int e = 0; e < 8; ++e) KTs[(d8 * 8 + e) * PT + (j ^ (d8 * 8))] = pk[i][e]; }
#pragma unroll
    for (int i = 0; i < 2; ++i) { const int un = tid + NT * i, j = un >> 3, v8 = un & 7;
#pragma unroll
      for (int e = 0; e < 8; ++e) VTs[(v8 * 8 + e) * PT + (j ^ (v8 * 8))] = pv[i][e]; }
    if (tid < 128) { const float* gp = GP + (size_t)(tb + sgn * tid) * 16;
      const float pi = gp[dir * 4 + h] + bi, pf = gp[(2 + dir) * 4 + h] + bfg;
      li[tid] = 15.f * tanhf(pi * (1.f / 15.f)); bcs[tid] = -softplus_f(-15.f * tanhf(pf * (1.f / 15.f))); }
    if (c + 1 < NCH) ML_LOAD(c + 1);
    __syncthreads();
    if (w == 0) {
      const float x0 = bcs[2 * lane], x1 = bcs[2 * lane + 1]; const float ps = x0 + x1; float inc = ps;
#pragma unroll
      for (int o = 1; o < 64; o <<= 1) { const float t = __shfl_up(inc, o); if (lane >= o) inc += t; }
      const float b0 = inc - ps + x0, b1 = b0 + x1;
      const float u0 = li[2 * lane] - b0, u1 = li[2 * lane + 1] - b1;
      float incm = fmaxf(u0, u1);
#pragma unroll
      for (int o = 1; o < 64; o <<= 1) { const float t = __shfl_up(incm, o); if (lane >= o) incm = fmaxf(incm, t); }
      float exm = __shfl_up(incm, 1); if (lane == 0) exm = -INFINITY;
      const float pm0 = fmaxf(exm, u0), pm1 = incm;
      const float M0 = fmaxf(mcar, pm0), M1 = fmaxf(mcar, pm1); const float Ml = __shfl(M1, 63);
      bcs[2 * lane] = b0; bcs[2 * lane + 1] = b1; uu[2 * lane] = u0; uu[2 * lane + 1] = u1; Mx[2 * lane] = M0; Mx[2 * lane + 1] = M1;
      wint[2 * lane] = expf(mcar - M0); wint[2 * lane + 1] = expf(mcar - M1); emt[2 * lane] = expf(-(b0 + M0)); emt[2 * lane + 1] = expf(-(b1 + M1));
      wah[2 * lane] = (f16)expf(u0 - Ml); wah[2 * lane + 1] = (f16)expf(u1 - Ml);
    }
    f16x8 af[4];
#pragma unroll
    for (int ks = 0; ks < 4; ++ks) af[ks] = *(const f16x8*)(Qs + (16 * w + fr) * PT + ks * 32 + fq * 8);
    f32x4 acc[8];
#pragma unroll
    for (int n = 0; n < 8; ++n) { acc[n] = (f32x4){0.f, 0.f, 0.f, 0.f};
#pragma unroll
      for (int ks = 0; ks < 4; ++ks) acc[n] = MFMA16(af[ks], *(const f16x8*)(Ks + (16 * n + fr) * PT + ks * 32 + fq * 8), acc[n]); }
    __syncthreads();
    const float Mlast = Mx[127], gsum = bcs[127]; const float cs = expf(mcar - Mlast);
    f16* Ss = Ks;
    { float Mt[4];
#pragma unroll
      for (int r = 0; r < 4; ++r) Mt[r] = Mx[16 * w + 4 * fq + r];
#pragma unroll
      for (int n = 0; n < 8; ++n) { const int s = 16 * n + fr; const float us = uu[s];
#pragma unroll
        for (int r = 0; r < 4; ++r) { const int t = 16 * w + 4 * fq + r; const float v = (s <= t) ? acc[n][r] * __expf(us - Mt[r]) : 0.f; Ss[t * PT + s] = (f16)v; } } }
    f32x4 QC[5], SV[5];
#pragma unroll
    for (int n = 0; n < 5; ++n) { QC[n] = (f32x4){0.f, 0.f, 0.f, 0.f}; SV[n] = (f32x4){0.f, 0.f, 0.f, 0.f};
#pragma unroll
      for (int ks = 0; ks < 4; ++ks) QC[n] = MFMA16(af[ks], *(const f16x8*)(CTs + (16 * n + fr) * PT + ks * 32 + fq * 8), QC[n]); }
#pragma unroll
    for (int ks = 0; ks < 4; ++ks) if (32 * ks <= 16 * w + 15) { const f16x8 sf = *(const f16x8*)(Ss + (16 * w + fr) * PT + ks * 32 + fq * 8);
#pragma unroll
      for (int n = 0; n < 5; ++n) SV[n] = MFMA16(sf, *(const f16x8*)(VTs + (16 * n + fr) * PT + ((ks * 32 + fq * 8) ^ ((((16 * n + fr) >> 3) & 7) * 8))), SV[n]); }
#pragma unroll
    for (int r = 0; r < 4; ++r) { const int t = 16 * w + 4 * fq + r; const float wi = wint[t];
      const float den = __shfl(wi * QC[4][r] + SV[4][r], lane & 48); const float inv = 1.f / fmaxf(fabsf(den), emt[t]);
      f16* hp = HM + (size_t)(tb + sgn * t) * 1024 + fr;
#pragma unroll
      for (int n = 0; n < 4; ++n) hp[16 * n] = (f16)((wi * QC[n][r] + SV[n][r]) * inv); }
#pragma unroll
    for (int n = 0; n < 5; ++n) CT[n] = CT[n] * cs;
#pragma unroll
    for (int ks = 0; ks < 4; ++ks) { const f16x8 bfr = *(const f16x8*)(KTs + (16 * w + fr) * PT + ((ks * 32 + fq * 8) ^ ((((16 * w + fr) >> 3) & 15) * 8))) * *(const f16x8*)(wah + ks * 32 + fq * 8);
#pragma unroll
      for (int n = 0; n < 5; ++n) CT[n] = MFMA16(*(const f16x8*)(VTs + (16 * n + fr) * PT + ((ks * 32 + fq * 8) ^ ((((16 * n + fr) >> 3) & 7) * 8))), bfr, CT[n]); }
    __syncthreads();
#pragma unroll
    for (int n = 0; n < 5; ++n)
#pragma unroll
      for (int r = 0; r < 4; ++r) CTs[(16 * n + 4 * fq + r) * PT + 16 * w + fr] = (f16)CT[n][r];
    mcar = gsum + Mlast;
  }
#undef ML_LOAD
}
#undef MFMA16
}

namespace att {
constexpr int AD = 128, NW = 8, QBLK = 32, KVBLK = 64;
constexpr float SCALE = 0.088388347648318440f;
constexpr float THR = 8.f;
constexpr int LDQ = 1024, LDK = 512, LDV = 512, LDO = 1024;
constexpr size_t SHM_V = KVBLK * AD * 2, SHM_K = KVBLK * AD * 2, SHM_ATTN = 2 * SHM_V + 2 * SHM_K + NW * 64 * 4;
using s16x4 = __attribute__((ext_vector_type(4))) short;
using f32x16 = __attribute__((ext_vector_type(16))) float;
#define KSWZ(row, colB) ((row) * 256 + ((colB) ^ (((row) & 7) << 4)))
#define SBAR() __builtin_amdgcn_sched_barrier(0)
__device__ __forceinline__ int crow(int r, int hi) { return (r & 3) + 8 * (r >> 2) + 4 * hi; }
__device__ __forceinline__ unsigned cvtpk(float lo, float hi) { unsigned r; asm volatile("v_cvt_pk_f16_f32 %0, %1, %2" : "=v"(r) : "v"(lo), "v"(hi)); return r; }
__device__ __forceinline__ void partialSM(f32x16& p0, f32x16& p1, float& m_reg, float& mn, float& alpha) {
  constexpr float C = SCALE * 1.4426950408889634f;
  float pmax = p0[0];
#pragma unroll
  for (int r = 1; r < 16; ++r) pmax = fmaxf(pmax, p0[r]);
#pragma unroll
  for (int r = 0; r < 16; ++r) pmax = fmaxf(pmax, p1[r]);
  { auto rr = __builtin_amdgcn_permlane32_swap(__float_as_uint(pmax), __float_as_uint(pmax), false, false);
    pmax = fmaxf(__uint_as_float(rr[0]), __uint_as_float(rr[1])); }
  if (__builtin_expect(__all(pmax - m_reg <= THR / SCALE), 1)) { mn = m_reg; alpha = 1.f; }
  else { mn = fmaxf(m_reg, pmax); alpha = __builtin_amdgcn_exp2f((m_reg - mn) * C); m_reg = mn; }
  float mnC = -mn * C;
#pragma unroll
  for (int r = 0; r < 16; ++r) p0[r] = fmaf(p0[r], C, mnC);
#pragma unroll
  for (int r = 0; r < 16; ++r) p1[r] = fmaf(p1[r], C, mnC);
#pragma unroll
  for (int r = 0; r < 16; ++r) p0[r] = __builtin_amdgcn_exp2f(p0[r]);
}
__device__ __forceinline__ void finishSM(f32x16& p0, f32x16& p1, float alpha, float& l_reg, f16x8& pa0, f16x8& pa1, f16x8& pa2, f16x8& pa3) {
#pragma unroll
  for (int r = 0; r < 16; ++r) p1[r] = __builtin_amdgcn_exp2f(p1[r]);
  float ps = 0;
#pragma unroll
  for (int r = 0; r < 16; ++r) ps += p0[r];
#pragma unroll
  for (int r = 0; r < 16; ++r) ps += p1[r];
  { auto rr = __builtin_amdgcn_permlane32_swap(__float_as_uint(ps), __float_as_uint(ps), false, false);
    ps = __uint_as_float(rr[0]) + __uint_as_float(rr[1]); }
  l_reg = l_reg * alpha + ps;
#define PK4(P, BASE, OUT) do { unsigned a0 = cvtpk(P[BASE + 0], P[BASE + 1]), a1 = cvtpk(P[BASE + 2], P[BASE + 3]);   \
    unsigned b0 = cvtpk(P[BASE + 4], P[BASE + 5]), b1 = cvtpk(P[BASE + 6], P[BASE + 7]);                              \
    auto r0 = __builtin_amdgcn_permlane32_swap(a0, b0, false, false); auto r1 = __builtin_amdgcn_permlane32_swap(a1, b1, false, false); \
    u32x4 w = {r0[0], r1[0], r0[1], r1[1]}; OUT = __builtin_bit_cast(f16x8, w); } while (0)
  PK4(p0, 0, pa0); PK4(p0, 8, pa1); PK4(p1, 0, pa2); PK4(p1, 8, pa3);
#undef PK4
}
__device__ __forceinline__ void qkt(f32x16& p0, f32x16& p1, const char* Ks, const f16x8* qr, int r32, int hi) {
  p0 = f32x16{}; p1 = f32x16{};
#pragma unroll
  for (int d0 = 0; d0 < 8; ++d0) { int cb = (d0 * 16 + hi * 8) * 2;
    f16x8 b0 = *reinterpret_cast<const f16x8*>(Ks + KSWZ(r32, cb));
    f16x8 b1 = *reinterpret_cast<const f16x8*>(Ks + KSWZ(32 + r32, cb));
    p0 = __builtin_amdgcn_mfma_f32_32x32x16_f16(b0, qr[d0], p0, 0, 0, 0);
    p1 = __builtin_amdgcn_mfma_f32_32x32x16_f16(b1, qr[d0], p1, 0, 0, 0); }
}
__device__ __forceinline__ int v_st(int k, int c) { const int kk = (k & ~0xC) | ((k & 4) << 1) | ((k & 8) >> 1); return ((kk >> 3) * 4 + (c >> 5)) * 512 + ((kk & 7) * 32 + (c & 31)) * 2; }
__device__ __forceinline__ int v_rd_base(int lane) { return ((lane & 3) << 3) | (((lane >> 2) & 3) << 6) | (((lane >> 4) & 1) << 5) | (((lane >> 5) & 1) << 8); }
constexpr int v_rd_off(int d0, int ks, int half) { return d0 * 512 + ks * 4096 + half * 2048; }
template <int OFF> __device__ __forceinline__ s16x4 tr_read(int vb) {
  s16x4 r; asm volatile("ds_read_b64_tr_b16 %0, %1 offset:%2" : "=&v"(r) : "v"(vb), "i"(OFF) : "memory"); return r;
}
template <int D0> __device__ __forceinline__ void pv_one(f32x16& od, int vb, f16x8 pa0, f16x8 pa1, f16x8 pa2, f16x8 pa3) {
  const s16x4 l0 = tr_read<v_rd_off(D0, 0, 0)>(vb), h0 = tr_read<v_rd_off(D0, 0, 1)>(vb), l1 = tr_read<v_rd_off(D0, 1, 0)>(vb), h1 = tr_read<v_rd_off(D0, 1, 1)>(vb);
  const s16x4 l2 = tr_read<v_rd_off(D0, 2, 0)>(vb), h2 = tr_read<v_rd_off(D0, 2, 1)>(vb), l3 = tr_read<v_rd_off(D0, 3, 0)>(vb), h3 = tr_read<v_rd_off(D0, 3, 1)>(vb);
  asm volatile("s_waitcnt lgkmcnt(0)" ::: "memory"); SBAR();
  typedef short s16x8 __attribute__((ext_vector_type(8)));
#define PK(Lo, Hi) __builtin_bit_cast(f16x8, (s16x8){Lo[0], Lo[1], Lo[2], Lo[3], Hi[0], Hi[1], Hi[2], Hi[3]})
  od = __builtin_amdgcn_mfma_f32_32x32x16_f16(pa0, PK(l0, h0), od, 0, 0, 0);
  od = __builtin_amdgcn_mfma_f32_32x32x16_f16(pa1, PK(l1, h1), od, 0, 0, 0);
  od = __builtin_amdgcn_mfma_f32_32x32x16_f16(pa2, PK(l2, h2), od, 0, 0, 0);
  od = __builtin_amdgcn_mfma_f32_32x32x16_f16(pa3, PK(l3, h3), od, 0, 0, 0);
#undef PK
}
__device__ __forceinline__ void pv_d0(f32x16* o, int vb, f16x8 pa0, f16x8 pa1, f16x8 pa2, f16x8 pa3) {
  pv_one<0>(o[0], vb, pa0, pa1, pa2, pa3); pv_one<1>(o[1], vb, pa0, pa1, pa2, pa3); pv_one<2>(o[2], vb, pa0, pa1, pa2, pa3); pv_one<3>(o[3], vb, pa0, pa1, pa2, pa3);
}
__device__ __forceinline__ void attn_dense_body(const f16* __restrict__ Qb, const f16* __restrict__ Kh, const f16* __restrict__ Vh, f16* __restrict__ Ob, int seq, char* lds) {
  const int tid = ltid(), wid = tid >> 6, lane = tid & 63, r32 = lane & 31, hi = lane >> 5;
  char* V_lds = lds; char* K_lds = lds + 2 * SHM_V;
  float* ws = (float*)(lds + 2 * SHM_V + 2 * SHM_K) + wid * 64; float* li_l = ws; float* al_l = ws + 32;
  float m_reg = -1e30f, l_reg = 0; f32x16 o[4] = {}; f16x8 qr[8];
  const f16* Qw = Qb + (long)(wid * QBLK + r32) * LDQ + hi * 8;
#pragma unroll
  for (int d0 = 0; d0 < 8; ++d0) qr[d0] = *reinterpret_cast<const f16x8*>(Qw + d0 * 16);
  const int sr = tid >> 4, sc = (tid & 15) * 8, vst0 = v_st(sr, sc), vst1 = v_st(32 + sr, sc);
  const int vb0 = (int)(uintptr_t)V_lds + v_rd_base(lane);
  struct { f16x8 vs0, vs1, ks0, ks1; } sr_[2];
#define SLOAD(i, k0) do { sr_[i].vs0 = *(const f16x8*)(&Vh[(long)((k0) + sr) * LDV + sc]); sr_[i].vs1 = *(const f16x8*)(&Vh[(long)((k0) + 32 + sr) * LDV + sc]); \
    sr_[i].ks0 = *(const f16x8*)(&Kh[(long)((k0) + sr) * LDK + sc]); sr_[i].ks1 = *(const f16x8*)(&Kh[(long)((k0) + 32 + sr) * LDK + sc]); } while (0)
#define SWRITE(b, i) do { *(f16x8*)(V_lds + (b) * SHM_V + vst0) = sr_[i].vs0;          \
    *(f16x8*)(V_lds + (b) * SHM_V + vst1) = sr_[i].vs1; int kc = sc * 2;               \
    *(f16x8*)(K_lds + (b) * SHM_K + KSWZ(sr, kc)) = sr_[i].ks0;                       \
    *(f16x8*)(K_lds + (b) * SHM_K + KSWZ(32 + sr, kc)) = sr_[i].ks1; } while (0)
#define SWAIT() asm volatile("s_waitcnt vmcnt(4)" ::: "memory")
#define RESC(a) do { if (__any((a) < 1.f)) { if (hi == 0) al_l[r32] = (a); asm volatile("s_waitcnt lgkmcnt(0)" ::: "memory"); \
    _Pragma("unroll") for (int d = 0; d < 4; ++d) _Pragma("unroll") for (int r = 0; r < 16; ++r) o[d][r] *= al_l[crow(r, hi)]; } } while (0)
  f32x16 pA0, pA1, pB0, pB1; float mnA, mnB, alA, alB; f16x8 pa0, pa1, pa2, pa3; const int NTl = seq / KVBLK;
  constexpr int SE = 0, SO = 1;
  SLOAD(SE, 0); asm volatile("s_waitcnt vmcnt(0)" ::: "memory"); SWRITE(0, SE); __syncthreads();
  qkt(pA0, pA1, K_lds, qr, r32, hi); partialSM(pA0, pA1, m_reg, mnA, alA);
  SLOAD(SO, KVBLK); if (2 < NTl) SLOAD(SE, 2 * KVBLK);
  SWAIT(); SWRITE(1, SO); __syncthreads();
  for (int j = 1; j + 1 < NTl; j += 2) {
    SBAR(); qkt(pB0, pB1, K_lds + SHM_K, qr, r32, hi);
    finishSM(pA0, pA1, alA, l_reg, pa0, pa1, pa2, pa3); SBAR();
    SLOAD(SO, (j + 2) * KVBLK); SBAR();
    pv_d0(o, vb0, pa0, pa1, pa2, pa3); partialSM(pB0, pB1, m_reg, mnB, alB);
    __syncthreads(); SWAIT(); SWRITE(0, SE);
    RESC(alB); __syncthreads();
    SBAR(); qkt(pA0, pA1, K_lds, qr, r32, hi);
    finishSM(pB0, pB1, alB, l_reg, pa0, pa1, pa2, pa3); SBAR();
    if (j + 3 < NTl) SLOAD(SE, (j + 3) * KVBLK); SBAR();
    pv_d0(o, vb0 + (int)SHM_V, pa0, pa1, pa2, pa3); partialSM(pA0, pA1, m_reg, mnA, alA);
    __syncthreads(); SWAIT(); SWRITE(1, SO);
    RESC(alA); __syncthreads();
  }
  SBAR(); qkt(pB0, pB1, K_lds + SHM_K, qr, r32, hi);
  finishSM(pA0, pA1, alA, l_reg, pa0, pa1, pa2, pa3); SBAR();
  pv_d0(o, vb0, pa0, pa1, pa2, pa3); partialSM(pB0, pB1, m_reg, mnB, alB);
  __syncthreads(); RESC(alB);
  finishSM(pB0, pB1, alB, l_reg, pa0, pa1, pa2, pa3); SBAR();
  pv_d0(o, vb0 + (int)SHM_V, pa0, pa1, pa2, pa3);
  if (hi == 0) li_l[r32] = l_reg; asm volatile("s_waitcnt lgkmcnt(0)" ::: "memory");
  float rli[16];
#pragma unroll
  for (int r = 0; r < 16; ++r) rli[r] = __builtin_amdgcn_rcpf(li_l[crow(r, hi)]);
  f16* Ow = Ob + (long)(wid * QBLK) * LDO;
#pragma unroll
  for (int r = 0; r < 16; ++r) { int orow = crow(r, hi);
#pragma unroll
    for (int d0 = 0; d0 < 4; ++d0) Ow[(long)orow * LDO + d0 * 32 + r32] = (f16)(o[d0][r] * rli[r]); }
#undef SLOAD
#undef SWRITE
#undef SWAIT
#undef RESC
}
#undef KSWZ
#undef SBAR
__device__ __forceinline__ void attn_unit(const Args& a, int u, char* lds) {
  int b, hq, t0, seq;
  if (u < 256) { const int qb = u & 15, r = (u >> 4) & 3, g = (u >> 6) & 1; b = u >> 7; hq = g * 4 + r; t0 = NCTX + 256 * qb; seq = L; }
  else { const int v = u - 256; b = v >> 3; hq = v & 7; t0 = 0; seq = NCTX; }
  const size_t m0 = (size_t)b * L + t0, k0 = (size_t)b * L; const int g = hq >> 2;
  const f16* Kh = (const f16*)(a.ws + WS_KN) + k0 * 512 + g * 128;
  attn_dense_body((const f16*)(a.ws + WS_QN) + m0 * 1024 + hq * 128, Kh, Kh + 256, (f16*)(a.ws + WS_AO) + m0 * 1024 + hq * 128, seq, lds);
}
}

__device__ __forceinline__ void ph_post(const Args& a, int l, int part = 3, int b0 = 0, int nb = 0) {
  const int tid = ltid(), lane = tid & 63, wave = tid >> 6;
  if (nb == 0) nb = gridDim.x;
  const int gw = (lbid() - b0) * 8 + wave, NGW = nb * 8;
  const f16* P = (const f16*)(a.ws + WS_P); f16* Y = (f16*)(a.ws + WS_Y);
  const f16* YRW = (const f16*)(a.ws + WS_YRW); const f16* AO = (const f16*)(a.ws + WS_AO); const f16* HM = (const f16*)(a.ws + WS_HM);
  const unsigned char* SIp = a.ws + WS_SI; const float* RKD = (const float*)(a.ws + WS_RKD);
  for (int m = gw; m < M; m += NGW) {
    const int lane = ltid() & 63, hq = lane >> 4, c4 = (lane & 15) * 4;
    const int b = m / L, t = m % L; const f16* pr = P + (size_t)m * NP; f16* yr = Y + (size_t)m * 3072;
    if (part & 1) {
    f16x4 ya[4], yb[4]; f32x4 vv[4], lw[4], lb[4]; f16x4 ga[4]; float rk[4];
#pragma unroll
    for (int g = 0; g < 4; ++g) { const int h = 4 * g + hq, c = h * 64 + c4;
      ya[g] = *(const f16x4*)(YRW + (size_t)m * 1024 + c); yb[g] = *(const f16x4*)(YRW + (size_t)(M + m) * 1024 + c);
      { const f16x4 vh = *(const f16x4*)(SIp + ((size_t)(b * 16 + h) * L + t) * SIR + 256 + c4 * 2); vv[g] = (f32x4){(float)vh[0], (float)vh[1], (float)vh[2], (float)vh[3]}; } ga[g] = *(const f16x4*)(pr + C_RWG + c);
      lw[g] = *(const f32x4*)(a.in[16] + l * 1024 + c); lb[g] = *(const f32x4*)(a.in[17] + l * 1024 + c); rk[g] = RKD[(size_t)m * 16 + h]; }
#pragma unroll
    for (int g = 0; g < 4; ++g) { const int c = (4 * g + hq) * 64 + c4; const f32x4 y = (f32x4){(float)ya[g][0] + (float)yb[g][0], (float)ya[g][1] + (float)yb[g][1], (float)ya[g][2] + (float)yb[g][2], (float)ya[g][3] + (float)yb[g][3]};
      const float mu = red16(y.x + y.y + y.z + y.w) * (1.f / 64.f); const f32x4 dv = y - mu;
      const float var = red16(dv.x * dv.x + dv.y * dv.y + dv.z * dv.z + dv.w * dv.w) * (1.f / 64.f); const float rs = rsqrtf(var + 64e-5f);
      float o[4];
#pragma unroll
      for (int e = 0; e < 4; ++e) o[e] = (dv[e] * rs * lw[g][e] + lb[g][e] + rk[g] * vv[g][e]) * silu_f((float)ga[g][e]);
      uint2 w; w.x = pkh(o[0], o[1]); w.y = pkh(o[2], o[3]); *(uint2*)(yr + c) = w; }
    }
    if (part & 2) {
    f16x4 ao[4]; f16x4 gb[4];
#pragma unroll
    for (int j = 0; j < 4; ++j) { const int c = j * 256 + lane * 4; ao[j] = *(const f16x4*)(AO + (size_t)m * 1024 + c); gb[j] = *(const f16x4*)(pr + C_ATG + c); }
    f32x4 ha[4], ng[4]; f16x4 hha[4], hhb[4], go[4], gg[4];
#pragma unroll
    for (int h = 0; h < 4; ++h) { const int c = h * 256 + lane * 4; hha[h] = *(const f16x4*)(HM + (size_t)m * 1024 + c); hhb[h] = *(const f16x4*)(HM + (size_t)(M + m) * 1024 + c);
      ng[h] = *(const f32x4*)(a.in[21] + l * 1024 + c); go[h] = *(const f16x4*)(pr + C_MLO + c); gg[h] = *(const f16x4*)(pr + C_MLG + c); }
#pragma unroll
    for (int j = 0; j < 4; ++j) { const int c = j * 256 + lane * 4; float o[4];
#pragma unroll
      for (int e = 0; e < 4; ++e) o[e] = (float)ao[j][e] * silu_f((float)gb[j][e]);
      uint2 w; w.x = pkh(o[0], o[1]); w.y = pkh(o[2], o[3]); *(uint2*)(yr + 1024 + c) = w; }
    float ss[4];
#pragma unroll
    for (int h = 0; h < 4; ++h) { ha[h] = (f32x4){(float)hha[h][0] + (float)hhb[h][0], (float)hha[h][1] + (float)hhb[h][1], (float)hha[h][2] + (float)hhb[h][2], (float)hha[h][3] + (float)hhb[h][3]}; ss[h] = ha[h].x * ha[h].x + ha[h].y * ha[h].y + ha[h].z * ha[h].z + ha[h].w * ha[h].w; }
#pragma unroll
    for (int o = 32; o >= 1; o >>= 1) {
#pragma unroll
      for (int h = 0; h < 4; ++h) ss[h] += __shfl_xor(ss[h], o); }
#pragma unroll
    for (int h = 0; h < 4; ++h) { const int c = h * 256 + lane * 4; const float rstd = rsqrtf(ss[h] * (1.f / 256.f) + 1e-6f); float o[4];
#pragma unroll
      for (int e = 0; e < 4; ++e) o[e] = sigm_f((float)go[h][e]) * (ha[h][e] * rstd * ng[h][e]) * silu_f((float)gg[h][e]);
      uint2 w; w.x = pkh(o[0], o[1]); w.y = pkh(o[2], o[3]); *(uint2*)(yr + 2048 + c) = w; }
    }
  }
}

__device__ __forceinline__ void ph_sum3(const Args& a) {
  const f16* G3 = (const f16*)(a.ws + WS_G3); const f16* G3b = (const f16*)(a.ws + WS_G3B); f16* MG = (f16*)(a.ws + WS_MRG);
  const size_t n8 = (size_t)M * D / 8;
  for (size_t i = (size_t)lbid() * NT + ltid(); i < n8; i += (size_t)gridDim.x * NT) {
    const f16x8 x = *(const f16x8*)(G3 + i * 8), y = *(const f16x8*)(G3b + i * 8), z = *(const f16x8*)(G3b + (size_t)M * D + i * 8);
    f16x8 o;
#pragma unroll
    for (int e = 0; e < 8; ++e) o[e] = (f16)((float)x[e] + (float)y[e] + (float)z[e]);
    *(f16x8*)(MG + i * 8) = o; }
}

__device__ __forceinline__ void ph_final(const Args& a) {
  const int tid = ltid(), lane = tid & 63, wave = tid >> 6;
  const int gw = lbid() * 8 + wave, NGW = gridDim.x * 8;
  const float* Z = (const float*)(a.ws + WS_Z); const float* fg = a.in[24];
  for (int r = gw; r < BATCH * SEQ; r += NGW) {
    const int b = r / SEQ, t = r % SEQ; const float* zr = Z + ((size_t)b * L + NCTX + t) * D; float* o = a.out + (size_t)r * D;
    f32x4 v[8]; float ss = 0.f;
#pragma unroll
    for (int j = 0; j < 8; ++j) { v[j] = *(const f32x4*)(zr + 4 * (lane + 64 * j)); ss += v[j].x * v[j].x + v[j].y * v[j].y + v[j].z * v[j].z + v[j].w * v[j].w; }
    const float rstd = rsqrtf(wave_sum(ss) * (1.f / D) + 1e-6f);
#pragma unroll
    for (int j = 0; j < 8; ++j) { const int k = 4 * (lane + 64 * j); *(f32x4*)(o + k) = v[j] * rstd * *(const f32x4*)(fg + k); }
  }
}


#define XLAS __attribute__((address_space(3)))
#define XB_TMO      128
#define XB_XCNT(j)  (256  + 64 * (j))
#define XB_XSUB(j)  (1280 + 64 * (j))
#define XB_XGEN(j)  (2304 + 64 * (j))
#define XB_TOP      3328
#define XB_TOPGEN   3392
#define XCD_BAR_WORDS 3456
#define XB_SPIN_CAP (1u << 18)
__device__ __forceinline__ unsigned xb_ld(unsigned* p)              { return __hip_atomic_load(p, __ATOMIC_RELAXED, __HIP_MEMORY_SCOPE_AGENT); }
__device__ __forceinline__ unsigned xb_add(unsigned* p, unsigned v) { return __hip_atomic_fetch_add(p, v, __ATOMIC_RELAXED, __HIP_MEMORY_SCOPE_AGENT); }
__device__ __forceinline__ unsigned xb_xcc_id() { return (unsigned)__builtin_amdgcn_s_getreg((3 << 11) | 20) & 0xFu; }
#define XB_SPIN(cond, bar) do { unsigned _sp = 0; while (cond) { __builtin_amdgcn_s_sleep(1); \
    if ((++_sp & 255u) == 0u) { if (xb_ld(&(bar)[XB_TMO])) break; if (_sp > XB_SPIN_CAP) { atomicAdd(&(bar)[XB_TMO], 1u); break; } } } } while (0)
struct XcdBarrier { unsigned* bar; unsigned x; volatile XLAS unsigned* st; };
__device__ __forceinline__ XcdBarrier xcd_barrier_post(unsigned* bar, volatile XLAS unsigned* st) {
    XcdBarrier b; b.bar = bar; b.x = xb_xcc_id(); b.st = st;
    if (threadIdx.x == 0) (void)xb_add(&bar[XB_XCNT(b.x)], 1u);
    return b;
}
__device__ __forceinline__ void xcd_barrier_complete(unsigned* bar, unsigned x, unsigned& nloc, unsigned& nx) {
    const unsigned G = gridDim.x * gridDim.y * gridDim.z;
    unsigned sum, cnt, mine, sp = 0u;
    for (;;) {
        sum = 0u; cnt = 0u; mine = 0u;
#pragma unroll
        for (unsigned j = 0; j < 16; ++j) { const unsigned c = xb_ld(&bar[XB_XCNT(j)]); sum += c; cnt += (c > 0u) ? 1u : 0u; mine = (j == x) ? c : mine; }
        if (sum == G) break;
        __builtin_amdgcn_s_sleep(1);
        if ((++sp & 255u) == 0u) { if (xb_ld(&bar[XB_TMO])) break; if (sp > XB_SPIN_CAP) { atomicAdd(&bar[XB_TMO], 1u); break; } }
    }
    nloc = mine > 0u ? mine : 1u; nx = cnt > 0u ? cnt : 1u;
}
__device__ __forceinline__ void xcd_barrier(const XcdBarrier& b) {
    asm volatile("s_waitcnt vmcnt(0)" ::: "memory");
    __syncthreads();
    if (threadIdx.x == 0) {
        unsigned* bar = b.bar;
        __builtin_amdgcn_s_waitcnt(0);
        unsigned nloc = b.st[0], nx = b.st[1];
        if (nloc == 0u) { xcd_barrier_complete(bar, b.x, nloc, nx); b.st[0] = nloc; b.st[1] = nx; }
        const unsigned old = xb_add(&bar[XB_XSUB(b.x)], 1u);
        const unsigned gen = old / nloc;
        if (old + 1u == (gen + 1u) * nloc) {
            __builtin_amdgcn_fence(__ATOMIC_RELEASE, "agent");
            asm volatile("s_waitcnt vmcnt(0)" ::: "memory");
            const unsigned og = xb_add(&bar[XB_TOP], 1u);
            const unsigned tg = og / nx;
            if (og + 1u == (tg + 1u) * nx) xb_add(&bar[XB_TOPGEN], 1u);
            else XB_SPIN(xb_ld(&bar[XB_TOPGEN]) == tg, bar);
            __builtin_amdgcn_fence(__ATOMIC_ACQUIRE, "agent");
            xb_add(&bar[XB_XGEN(b.x)], 1u);
            asm volatile("s_waitcnt vmcnt(0)" ::: "memory");
        } else {
            XB_SPIN(xb_ld(&bar[XB_XGEN(b.x)]) == gen, bar);
            __builtin_amdgcn_fence(__ATOMIC_ACQUIRE, "agent");
            asm volatile("s_waitcnt vmcnt(0)" ::: "memory");
        }
    }
    __syncthreads();
}


__device__ __forceinline__ void sub_barrier(unsigned* bar, volatile XLAS unsigned* st, unsigned G) {
    asm volatile("s_waitcnt vmcnt(0)" ::: "memory");
    __syncthreads();
    if (threadIdx.x == 0) {
        const unsigned x = xb_xcc_id();
        __builtin_amdgcn_s_waitcnt(0);
        unsigned nloc = st[0], nx = st[1];
        if (nloc == 0u) {
            unsigned sum, cnt, mine, sp = 0u;
            for (;;) { sum = 0u; cnt = 0u; mine = 0u;
#pragma unroll
                for (unsigned j = 0; j < 16; ++j) { const unsigned c = xb_ld(&bar[XB_XCNT(j)]); sum += c; cnt += (c > 0u) ? 1u : 0u; mine = (j == x) ? c : mine; }
                if (sum == G) break;
                __builtin_amdgcn_s_sleep(1);
                if ((++sp & 255u) == 0u) { if (xb_ld(&bar[XB_TMO])) break; if (sp > XB_SPIN_CAP) { atomicAdd(&bar[XB_TMO], 1u); break; } } }
            nloc = mine > 0u ? mine : 1u; nx = cnt > 0u ? cnt : 1u; st[0] = nloc; st[1] = nx; }
        const unsigned old = xb_add(&bar[XB_XSUB(x)], 1u);
        const unsigned gen = old / nloc;
        if (old + 1u == (gen + 1u) * nloc) {
            __builtin_amdgcn_fence(__ATOMIC_RELEASE, "agent");
            asm volatile("s_waitcnt vmcnt(0)" ::: "memory");
            const unsigned og = xb_add(&bar[XB_TOP], 1u);
            const unsigned tg = og / nx;
            if (og + 1u == (tg + 1u) * nx) xb_add(&bar[XB_TOPGEN], 1u);
            else XB_SPIN(xb_ld(&bar[XB_TOPGEN]) == tg, bar);
            __builtin_amdgcn_fence(__ATOMIC_ACQUIRE, "agent");
            xb_add(&bar[XB_XGEN(x)], 1u);
            asm volatile("s_waitcnt vmcnt(0)" ::: "memory");
        } else {
            XB_SPIN(xb_ld(&bar[XB_XGEN(x)]) == gen, bar);
            __builtin_amdgcn_fence(__ATOMIC_ACQUIRE, "agent");
            asm volatile("s_waitcnt vmcnt(0)" ::: "memory");
        }
    }
    __syncthreads();
}

__device__ __forceinline__ int mix_grab(unsigned* ctr, volatile unsigned* slot) {
  __syncthreads();
  if (ltid() == 0) *slot = __hip_atomic_fetch_add(ctr, 1u, __ATOMIC_RELAXED, __HIP_MEMORY_SCOPE_AGENT);
  __syncthreads();
  return (int)*slot;
}
constexpr int MFULL = 8192;
constexpr int NSCAN = 64;
constexpr int NT_RW = 13;
__device__ __forceinline__ void ph_mix(const Args& a, int l, unsigned char* lds) {
  const int bx = lbid();
  if (bx < NSCAN) {
    if (ltid() == 0) { unsigned* pd = (unsigned*)(a.ws + WS_CTL) + 1024 + 64 * l + 32; while (xb_ld(pd) < gridDim.x) __builtin_amdgcn_s_sleep(2); __builtin_amdgcn_fence(__ATOMIC_ACQUIRE, "agent"); }
    __syncthreads();
    rw::scan_unit(a, l, bx, lds); return; }
  const int NB = gridDim.x - NSCAN;
  unsigned* bar2 = (unsigned*)(a.ws + WS_CTL) + 8192 + l * XCD_BAR_WORDS;
  volatile XLAS unsigned* st2 = (volatile XLAS unsigned*)((XLAS unsigned char*)lds + (LDS_BYTES - 48));
  if (ltid() < 2) st2[ltid()] = 0u;
  __syncthreads();
  if (ltid() == 0) (void)xb_add(&bar2[XB_XCNT(xb_xcc_id())], 1u);
  { pg8::Gemm g{(const f16*)(a.ws + WS_H), (const f16*)(a.ws + WS_WIN) + (size_t)NT_RW * 256 * D, D, D, D, 1 << 20, 0}; pg8::StaticOrder So; So.init(M, NP - NT_RW * 256, NB, bx - NSCAN);
    pg8::gemm_phase((PG8_LAS unsigned char*)lds, g, So, pg8::EpiP{(f16*)(a.ws + WS_P), NT_RW * 256}); }
  sub_barrier(bar2, st2, (unsigned)NB);
  ph_prep(a, l, lds, 2, NSCAN, NB);
  sub_barrier(bar2, st2, (unsigned)NB);
  unsigned* ctr = (unsigned*)(a.ws + WS_CTL) + 64 * (1 + l);
  volatile unsigned* slot = (volatile unsigned*)(lds + LDS_BYTES - 64);
  int u = mix_grab(ctr, slot);
  while (u < 64) { ml::mlstm_unit(a, l, u, lds); u = mix_grab(ctr, slot); }
  while (u < 336) { att::attn_unit(a, u - 64, (char*)lds); u = mix_grab(ctr, slot); }
  sub_barrier(bar2, st2, (unsigned)NB);
  ph_post(a, l, 2, NSCAN, NB);
  sub_barrier(bar2, st2, (unsigned)NB);
  { pg8::Gemm g{(const f16*)(a.ws + WS_Y), (const f16*)(a.ws + WS_WBR), 3072, BR, BR, 8, 1024}; pg8::StaticOrder So; So.init(M, 2 * D, NB, bx - NSCAN, 8);
    pg8::gemm_phase((PG8_LAS unsigned char*)lds, g, So, pg8::EpiBr{(f16*)(a.ws + WS_G3), (f16*)(a.ws + WS_G3B), (const f16*)(a.ws + WS_P), nullptr}); }
  if (l + 1 < DEPTH) ph_convert(a, l + 1, lds, 1, NSCAN, NB);
}

__global__ void __launch_bounds__(NT) mega(Args a) {
  extern __shared__ __attribute__((aligned(16))) unsigned char lds[];
  { volatile XLAS unsigned* st0 = (volatile XLAS unsigned*)((XLAS unsigned char*)lds + (LDS_BYTES - 48)); if (threadIdx.x < 6) st0[threadIdx.x] = 0u; }
  __syncthreads();
  (void)xcd_barrier_post((unsigned*)(a.ws + WS_CTL) + 4096, (volatile XLAS unsigned*)((XLAS unsigned char*)lds + (LDS_BYTES - 32)));
#define GRID_SYNC() do { XcdBarrier xb_; xb_.bar = (unsigned*)(a.ws + WS_CTL) + 4096; xb_.x = xb_xcc_id(); xb_.st = (volatile XLAS unsigned*)((XLAS unsigned char*)lds + (LDS_BYTES - 32)); xcd_barrier(xb_); } while (0)
  const f16* P = (const f16*)(a.ws + WS_P);
  ph_modv(a, lds); __syncthreads(); ph_convert(a, 0, lds, 3);
  GRID_SYNC();
#pragma unroll 1
  for (int l = 0; l < DEPTH; ++l) {
    if (l > 0) { ph_convert(a, l, lds, 2); __syncthreads(); }
    ph_norm(a, l, lds);
    GRID_SYNC();
    { pg8::Gemm g{(const f16*)(a.ws + WS_H), (const f16*)(a.ws + WS_WIN), D, D, D, 1 << 20, 0}; pg8::StaticOrder So; So.init(M, NT_RW * 256, gridDim.x, lbid());
      pg8::gemm_phase((PG8_LAS unsigned char*)lds, g, So, pg8::EpiP{(f16*)(a.ws + WS_P), 0}); }
    GRID_SYNC();
    ph_prep(a, l, lds, 1);
    asm volatile("s_waitcnt vmcnt(0)" ::: "memory"); __syncthreads();
    if (ltid() == 0) { __builtin_amdgcn_fence(__ATOMIC_RELEASE, "agent"); (void)xb_add((unsigned*)(a.ws + WS_CTL) + 1024 + 64 * l + 32, 1u); }
    ph_mix(a, l, lds);
    GRID_SYNC();
    ph_post(a, l, 1);
    GRID_SYNC();
    { pg8::Gemm g{(const f16*)(a.ws + WS_Y), (const f16*)(a.ws + WS_WBR), 3072, BR, BR, 8, 1024}; pg8::StaticOrder So; So.init(MFULL, D, gridDim.x, lbid());
      pg8::gemm_phase((PG8_LAS unsigned char*)lds, g, So, pg8::EpiBr{(f16*)(a.ws + WS_G3), (f16*)(a.ws + WS_G3B), P, (f16*)(a.ws + WS_MRG)});
      tail_gemm((const f16*)(a.ws + WS_Y), 3072, (const f16*)(a.ws + WS_WBR), BR, MFULL, M - MFULL, D, BR, lds, EpiBranchMerge{(f16*)(a.ws + WS_MRG), (const f16*)(a.ws + WS_G3B), P}); }
    GRID_SYNC();
    { pg8::Gemm g{(const f16*)(a.ws + WS_MRG), (const f16*)(a.ws + WS_WOUT), D, D, D, 1 << 20, 0}; pg8::StaticOrder So; So.init(MFULL, D, gridDim.x, lbid());
      pg8::gemm_phase((PG8_LAS unsigned char*)lds, g, So, pg8::EpiZ{a, l});
      tail_gemm((const f16*)(a.ws + WS_MRG), D, (const f16*)(a.ws + WS_WOUT), D, MFULL, M - MFULL, D, D, lds, EpiOut{a, l}); }
    GRID_SYNC();
  }
  ph_final(a);
}

extern "C" void kernel_launch(void* const* d_in, const int* in_sizes, int n_in, void* d_out, int out_size, void* d_ws, size_t ws_size, hipStream_t stream) {
  static int grid_blocks = 0;
  if (grid_blocks == 0) {
    if (n_in != 25 || out_size != BATCH * SEQ * D || ws_size < WS_END) { fprintf(stderr, "kernel_launch: bad shapes n_in %d out %d ws %zu (need %zu)\n", n_in, out_size, ws_size, (size_t)WS_END); grid_blocks = -1; return; }
    if (hipFuncSetAttribute((const void*)mega, hipFuncAttributeMaxDynamicSharedMemorySize, LDS_BYTES) != hipSuccess) { fprintf(stderr, "kernel_launch: LDS attribute failed\n"); grid_blocks = -1; return; }
    int dev = 0, cus = 0, per_cu = 0;
    hipGetDevice(&dev); hipDeviceGetAttribute(&cus, hipDeviceAttributeMultiprocessorCount, dev);
    if (hipOccupancyMaxActiveBlocksPerMultiprocessor(&per_cu, (const void*)mega, NT, LDS_BYTES) != hipSuccess || per_cu < 1) { fprintf(stderr, "kernel_launch: occupancy query says %d\n", per_cu); (void)hipGetLastError(); per_cu = 1; }
    grid_blocks = cus * 1;
    fprintf(stderr, "kernel_launch: cus %d per_cu %d grid %d\n", cus, per_cu, grid_blocks);
  }
  if (grid_blocks < 0) return;
  (void)hipMemsetAsync((char*)d_ws + WS_CTL, 0, 65536, stream);
  Args a{};
  for (int i = 0; i < 25; ++i) a.in[i] = (const float*)d_in[i];
  a.out = (float*)d_out; a.ws = (unsigned char*)d_ws;
  hipLaunchKernelGGL(mega, dim3(grid_blocks), dim3(NT), LDS_BYTES, stream, a);
  const hipError_t e = hipPeekAtLastError();
  if (e != hipSuccess) fprintf(stderr, "launch failed: %s (grid %d)\n", hipGetErrorString(e), grid_blocks);
}
```

```cpp
#include <hip/hip_runtime.h>
#include <hip/hip_cooperative_groups.h>
#include <cstdio>
#include <cstdint>

constexpr int D = 2048, BATCH = 2, SEQ = 4096, NCTX = 256, L = NCTX + SEQ, M = BATCH * L, DEPTH = 2;
constexpr int NIN = 17168, NP = 17152;
constexpr int BR = 1024;
constexpr int C_R = 0, C_K = 1024, C_V = 2048, C_WD = 3072, C_AD = 3200, C_RWG = 3328, C_ATQ = 4352, C_ATK = 5376, C_ATV = 5632,
              C_ATG = 5888, C_MLQ = 6912, C_MLK = 7424, C_MLV = 7936, C_MLO = 8960, C_MLG = 9984, C_MRG = 11008;
constexpr int GATE_COL = 9984;
constexpr int SIV = 9 * 64;
constexpr int SIR = 912;

namespace cg = cooperative_groups;
typedef _Float16 f16;
typedef _Float16 f16x8 __attribute__((ext_vector_type(8)));
typedef _Float16 f16x4 __attribute__((ext_vector_type(4)));
typedef _Float16 f16x2 __attribute__((ext_vector_type(2)));
typedef float f32x4 __attribute__((ext_vector_type(4)));
typedef float f32x2 __attribute__((ext_vector_type(2)));
typedef unsigned u32x4 __attribute__((ext_vector_type(4)));

constexpr size_t MiB = 1u << 20;
constexpr size_t al(size_t x) { return (x + 255) / 256 * 256; }
constexpr size_t WS_CTL = 0;
constexpr size_t WS_MODV = 1 * MiB;
constexpr size_t WS_WIN = WS_MODV + al((size_t)2 * 3 * 6144 * 4);
constexpr size_t WS_WBR = WS_WIN + al((size_t)NP * D * 2);
constexpr size_t WS_WOUT = WS_WBR + al((size_t)3 * D * BR * 2);
constexpr size_t WS_H = WS_WOUT + al((size_t)D * D * 2);
constexpr size_t WS_QN = WS_H;
constexpr size_t WS_KN = WS_QN + al((size_t)M * 1024 * 2);
constexpr size_t WS_GPRE = WS_H + al((size_t)M * D * 2);
constexpr size_t WS_RKD = WS_GPRE + al((size_t)M * 16 * 4);
constexpr size_t WS_P = WS_RKD + al((size_t)M * 16 * 4);
constexpr size_t WS_SI = WS_P + al((size_t)M * NP * 2);
constexpr size_t WS_G3 = WS_SI;
constexpr size_t WS_MRG = WS_G3 + al((size_t)3 * M * D * 2);
constexpr size_t WS_YRW = WS_SI + al((size_t)BATCH * 16 * L * SIV * 4);
constexpr size_t WS_AO = WS_YRW + al((size_t)2 * M * 1024 * 4);
constexpr size_t WS_HM = WS_AO + al((size_t)M * 1024 * 4);
constexpr size_t WS_Y = WS_HM + al((size_t)2 * M * 1024 * 4);
constexpr size_t WS_Z = WS_Y + al((size_t)M * 3072 * 2);
constexpr size_t WS_G3B = WS_Z + al((size_t)M * D * 4);
constexpr size_t WS_END = WS_G3B + al((size_t)2 * M * D * 2);
static_assert(WS_MRG + (size_t)M * D * 2 <= WS_YRW, "G3|MERGED overlay fits in SI");
static_assert(WS_KN + (size_t)M * 512 * 2 <= WS_GPRE, "QN|KN overlay fits in H");

#ifndef PROBE_PHASE
#define PROBE_PHASE 0
#endif
constexpr int NT = 512;
constexpr int LDS_BYTES = 152 * 1024;

struct Args { const float* in[25]; float* out; unsigned char* ws; int ph_lo, ph_hi; };

__device__ __forceinline__ int ltid() { int t = threadIdx.x; asm volatile("" : "+v"(t)); return t; }
__device__ __forceinline__ int lbid() { int t = blockIdx.x; asm volatile("" : "+s"(t)); return t; }
__device__ __forceinline__ float wave_sum(float v) {
#pragma unroll
  for (int o = 32; o >= 1; o >>= 1) v += __shfl_xor(v, o);
  return v;
}
template <int CTRL> __device__ __forceinline__ float dppf(float x) { return __int_as_float(__builtin_amdgcn_update_dpp(0, __float_as_int(x), CTRL, 0xF, 0xF, true)); }
__device__ __forceinline__ float red16(float x) { x += dppf<0xB1>(x); x += dppf<0x4E>(x); x += dppf<0x141>(x); x += dppf<0x140>(x); return x; }
template <int CTRL> __device__ __forceinline__ float dppx(float x) { return __int_as_float(__builtin_amdgcn_update_dpp(0, __float_as_int(x), CTRL, 0xF, 0xF, true)); }
__device__ __forceinline__ float wsum_fast(float x) { x += dppx<0xB1>(x); x += dppx<0x4E>(x); x += dppx<0x141>(x); x += dppx<0x140>(x); x += __shfl_xor(x, 16); x += __shfl_xor(x, 32); return x; }

__device__ __forceinline__ float wave_max(float v) {
#pragma unroll
  for (int o = 32; o >= 1; o >>= 1) v = fmaxf(v, __shfl_xor(v, o));
  return v;
}
__device__ __forceinline__ float sigm_f(float x) { return __builtin_amdgcn_rcpf(1.f + __expf(-x)); }
__device__ __forceinline__ float silu_f(float x) { return x * sigm_f(x); }
__device__ __forceinline__ float tanh_f(float x) { const float t = __expf(-2.f * fabsf(x)); return copysignf((1.f - t) * __builtin_amdgcn_rcpf(1.f + t), x); }
__device__ __forceinline__ float softplus_f(float x) { return x > 20.f ? x : log1pf(expf(x)); }
__device__ __forceinline__ unsigned pkh(float lo, float hi) { f32x2 v = {lo, hi}; f16x2 h = __builtin_convertvector(v, f16x2); return __builtin_bit_cast(unsigned, h); }

__device__ __forceinline__ const float* zrow(const Args& a, int l, int m) {
  if (l > 0) return (const float*)(a.ws + WS_Z) + (size_t)m * D;
  const int b = m / L, t = m % L;
  return t < NCTX ? a.in[2] + ((size_t)b * NCTX + t) * D : a.in[0] + ((size_t)b * SEQ + (t - NCTX)) * D;
}

__device__ __forceinline__ void ph_modv(const Args& a, unsigned char* lds) {
  const int tid = ltid(), lane = tid & 63, wave = tid >> 6;
  float* sv = (float*)lds;
  float* red = sv + 3 * 2048;
  float* modv = (float*)(a.ws + WS_MODV);
  for (int i = tid; i < 3 * 2048; i += NT) { const int w = i / 2048, k = i % 2048; sv[i] = silu_f(w < 2 ? a.in[1][w * 2048 + k] : a.in[3][k]); }
  __syncthreads();
  for (int u = lbid(); u < 192; u += gridDim.x) {
    const int l = u / 96, j0 = (u % 96) * 64;
    const float* w = a.in[5] + (size_t)l * 2048 * 6144 + j0 + lane;
    float a0 = 0.f, a1 = 0.f, a2 = 0.f;
    for (int k = wave * 256; k < wave * 256 + 256; ++k) { const float wv = w[(size_t)k * 6144]; a0 += sv[k] * wv; a1 += sv[2048 + k] * wv; a2 += sv[4096 + k] * wv; }
    red[(wave * 3 + 0) * 64 + lane] = a0; red[(wave * 3 + 1) * 64 + lane] = a1; red[(wave * 3 + 2) * 64 + lane] = a2;
    __syncthreads();
    if (tid < 192) { const int i = tid >> 6; float s = a.in[6][l * 6144 + j0 + lane];
      for (int w8 = 0; w8 < 8; ++w8) s += red[(w8 * 3 + i) * 64 + lane];
      modv[(size_t)(l * 3 + i) * 6144 + j0 + lane] = s; }
    __syncthreads();
  }
}

__device__ __forceinline__ void transpose_item(const float* W, int ldw, int ncol0, int k0, f16* WT, int K, int row0, float* scr, int lane) {
#pragma unroll 8
  for (int i = 0; i < 32; ++i) { const int kk = 2 * i + (lane >> 5); scr[kk * 33 + (lane & 31)] = W[(size_t)(k0 + kk) * ldw + ncol0 + (lane & 31)]; }
  asm volatile("s_waitcnt lgkmcnt(0)" ::: "memory");
  const int c = lane & 7;
#pragma unroll
  for (int j = 0; j < 4; ++j) { const int n = (lane >> 3) + 8 * j; const float* s = scr + (8 * c) * 33 + n;
    u32x4 o; o.x = pkh(s[0 * 33], s[1 * 33]); o.y = pkh(s[2 * 33], s[3 * 33]); o.z = pkh(s[4 * 33], s[5 * 33]); o.w = pkh(s[6 * 33], s[7 * 33]);
    *(u32x4*)(WT + (size_t)(row0 + n) * K + k0 + 8 * c) = o; }
  asm volatile("s_waitcnt lgkmcnt(0)" ::: "memory");
}
__device__ __forceinline__ void ph_convert(const Args& a, int l, unsigned char* lds, int part = 3, int b0 = 0, int nb = 0) {
  const int tid = ltid(), lane = tid & 63, wave = tid >> 6;
  float* scr = (float*)lds + wave * (64 * 33);
  if (nb == 0) nb = gridDim.x;
  const int gw = (lbid() - b0) * 8 + wave, NGW = nb * 8;
  constexpr int I_IN = (D / 64) * (NP / 32), I_BR = (BR / 64) * (D / 32), I_OUT = (D / 64) * (D / 32);
  f16* WIN = (f16*)(a.ws + WS_WIN); f16* WBR = (f16*)(a.ws + WS_WBR); f16* WOUT = (f16*)(a.ws + WS_WOUT);
  for (int it = gw + ((part & 1) ? 0 : I_IN); it < ((part & 2) ? I_IN + 3 * I_BR + I_OUT : I_IN); it += NGW) {
    int r = it;
    if (r < I_IN) { const int nblk = NP / 32, kb = r / nblk, nb = r % nblk, n0 = nb * 32;
      transpose_item(a.in[7] + (size_t)l * D * NIN, NIN, n0 + (n0 >= GATE_COL ? 16 : 0), kb * 64, WIN, D, n0, scr, lane); continue; }
    r -= I_IN;
    if (r < 3 * I_BR) { const int br = r / I_BR, q = r % I_BR, nblk = D / 32, kb = q / nblk, nb = q % nblk;
      transpose_item(a.in[22] + ((size_t)l * 3 + br) * BR * D, D, nb * 32, kb * 64, WBR, BR, br * D + nb * 32, scr, lane); continue; }
    r -= 3 * I_BR;
    { const int nblk = D / 32, kb = r / nblk, nb = r % nblk;
      transpose_item(a.in[23] + (size_t)l * D * D, D, nb * 32, kb * 64, WOUT, D, nb * 32, scr, lane); }
  }
}

__device__ __forceinline__ void ph_norm(const Args& a, int l, unsigned char* lds) {
  const int tid = ltid(), lane = tid & 63, wave = tid >> 6;
  const int gw = lbid() * 8 + wave, NGW = gridDim.x * 8;
  float* wg = (float*)lds;
  { const float* w = a.in[7] + (size_t)l * D * NIN + GATE_COL;
    for (int i = tid; i < 2048 * 4; i += NT) { const int k = i >> 2, q = i & 3; const f32x4 v = *(const f32x4*)(w + (size_t)k * NIN + q * 4);
      wg[(q * 4 + 0) * 2048 + k] = v.x; wg[(q * 4 + 1) * 2048 + k] = v.y; wg[(q * 4 + 2) * 2048 + k] = v.z; wg[(q * 4 + 3) * 2048 + k] = v.w; } }
  __syncthreads();
  const float* modv = (const float*)(a.ws + WS_MODV) + (size_t)l * 3 * 6144;
  const float* ng = a.in[4] + l * D;
  f16* H = (f16*)(a.ws + WS_H); float* GP = (float*)(a.ws + WS_GPRE);
  for (int m = gw; m < M; m += NGW) {
    const int b = m / L, t = m % L; const float* zr = zrow(a, l, m);
    const float* mv = modv + (size_t)(t < NCTX ? 2 : b) * 6144;
    f32x4 v[8]; float ss = 0.f;
#pragma unroll
    for (int j = 0; j < 8; ++j) { v[j] = *(const f32x4*)(zr + 4 * (lane + 64 * j)); ss += v[j].x * v[j].x + v[j].y * v[j].y + v[j].z * v[j].z + v[j].w * v[j].w; }
    const float rstd = rsqrtf(wave_sum(ss) * (1.f / D) + 1e-6f);
#pragma unroll
    for (int j = 0; j < 8; ++j) { const int k = 4 * (lane + 64 * j);
      const f32x4 g = *(const f32x4*)(ng + k), sh = *(const f32x4*)(mv + k), sc = *(const f32x4*)(mv + 2048 + k);
      v[j] = (v[j] * rstd * g) * (1.f + sc) + sh;
      uint2 o; o.x = pkh(v[j].x, v[j].y); o.y = pkh(v[j].z, v[j].w); *(uint2*)(H + (size_t)m * D + k) = o; }
    float p[16];
#pragma unroll
    for (int g = 0; g < 16; ++g) { float pp = 0.f;
#pragma unroll
      for (int j = 0; j < 8; ++j) { const f32x4 w = *(const f32x4*)(wg + g * 2048 + 4 * (lane + 64 * j)); pp += v[j].x * w.x + v[j].y * w.y + v[j].z * w.z + v[j].w * w.w; }
      p[g] = pp; if ((g & 1) == 1) __builtin_amdgcn_sched_barrier(0); }
    const bool b3 = lane & 8, b2 = lane & 4, b1 = lane & 2, b0 = lane & 1;
#define NRM_DPP(x_, ctrl_) __int_as_float(__builtin_amdgcn_update_dpp(0, __float_as_int(x_), ctrl_, 0xF, 0xF, true))
    float q8[8], q4[4], q2[2];
#pragma unroll
    for (int g = 0; g < 8; ++g) { const float keep = b3 ? p[g + 8] : p[g], send = b3 ? p[g] : p[g + 8]; q8[g] = keep + NRM_DPP(send, 0x128); }
#pragma unroll
    for (int g = 0; g < 4; ++g) { const float keep = b2 ? q8[g + 4] : q8[g], send = b2 ? q8[g] : q8[g + 4]; q4[g] = keep + NRM_DPP(send, 0x141); }
#pragma unroll
    for (int g = 0; g < 2; ++g) { const float keep = b1 ? q4[g + 2] : q4[g], send = b1 ? q4[g] : q4[g + 2]; q2[g] = keep + NRM_DPP(send, 0x4E); }
    float gsum = (b0 ? q2[1] : q2[0]) + NRM_DPP((b0 ? q2[0] : q2[1]), 0xB1);
#undef NRM_DPP
    gsum += __shfl_xor(gsum, 16); gsum += __shfl_xor(gsum, 32);
    if (lane < 16) GP[(size_t)m * 16 + lane] = gsum;
  }
}

template <class Epi>
__device__ __forceinline__ void tail_gemm(const f16* A, int lda, const f16* Bt, int ldb, int m0, int Mrows, int Ncols, int K, unsigned char* lds, const Epi& epi) {
  const int tid = ltid(), lane = tid & 63, wave = __builtin_amdgcn_readfirstlane(tid >> 6), fr = lane & 15, fq = lane >> 4;
  const int ntn = Ncols / 64, nun = (Mrows / 64) * ntn, KW = K / 8;
  float* part = (float*)lds;
  for (int u = lbid(); u < nun; u += (int)gridDim.x) {
    const int tm = u / ntn, tn = u % ntn;
    f32x4 acc[4][4];
#pragma unroll
    for (int i = 0; i < 4; ++i)
#pragma unroll
      for (int j = 0; j < 4; ++j) acc[i][j] = (f32x4){0.f, 0.f, 0.f, 0.f};
    const f16* ap = A + (size_t)(m0 + tm * 64 + fr) * lda + wave * KW + fq * 8; const f16* bp = Bt + (size_t)(tn * 64 + fr) * ldb + wave * KW + fq * 8;
    for (int k0 = 0; k0 < KW; k0 += 64) {
      f16x8 af[4], bf[4], an[4], bn[4];
#pragma unroll
      for (int i = 0; i < 4; ++i) { af[i] = *(const f16x8*)(ap + (size_t)i * 16 * lda + k0); bf[i] = *(const f16x8*)(bp + (size_t)i * 16 * ldb + k0);
                                    an[i] = *(const f16x8*)(ap + (size_t)i * 16 * lda + k0 + 32); bn[i] = *(const f16x8*)(bp + (size_t)i * 16 * ldb + k0 + 32); }
#pragma unroll
      for (int i = 0; i < 4; ++i)
#pragma unroll
        for (int j = 0; j < 4; ++j) { acc[i][j] = __builtin_amdgcn_mfma_f32_16x16x32_f16(af[i], bf[j], acc[i][j], 0, 0, 0); acc[i][j] = __builtin_amdgcn_mfma_f32_16x16x32_f16(an[i], bn[j], acc[i][j], 0, 0, 0); }
    }
    __syncthreads();
#pragma unroll
    for (int i = 0; i < 4; ++i)
#pragma unroll
      for (int j = 0; j < 4; ++j)
#pragma unroll
        for (int r = 0; r < 4; ++r) part[((wave * 16 + i * 4 + j) * 4 + r) * 64 + lane] = acc[i][j][r];
    __syncthreads();
#pragma unroll
    for (int q = 0; q < 2; ++q) { const int f = 2 * wave + q, i = f >> 2, j = f & 3;
#pragma unroll
      for (int r = 0; r < 4; ++r) { float v = 0.f;
#pragma unroll
        for (int w8 = 0; w8 < 8; ++w8) v += part[((w8 * 16 + f) * 4 + r) * 64 + lane];
        epi(m0 + tm * 64 + i * 16 + fq * 4 + r, tn * 64 + j * 16 + fr, v); } }
  }
}
struct EpiBranch { f16* O; const f16* P; int br; __device__ __forceinline__ void operator()(int m, int n, float v) const {
  const float g = sigm_f((float)P[(size_t)m * NP + C_MRG + br * D + n]); O[(size_t)m * D + n] = (f16)(g * v); } };
struct EpiBranchMerge { f16* MRG; const f16* G3b; const f16* P; __device__ __forceinline__ void operator()(int m, int n, float v) const {
  const float g = sigm_f((float)P[(size_t)m * NP + C_MRG + n]); MRG[(size_t)m * D + n] = (f16)(g * v + (float)G3b[(size_t)m * D + n] + (float)G3b[(size_t)M * D + (size_t)m * D + n]); } };
struct EpiOut { Args a; int l; __device__ __forceinline__ void operator()(int m, int n, float v) const {
  const int b = m / L, t = m % L; const float gt = ((const float*)(a.ws + WS_MODV))[(size_t)(l * 3 + (t < NCTX ? 2 : b)) * 6144 + 4096 + n];
  ((float*)(a.ws + WS_Z))[(size_t)m * D + n] = zrow(a, l, m)[n] + gt * v; } };


namespace pg8 {
#define PG8_LAS __attribute__((address_space(3)))
constexpr int BM = 256, BK = 64, HALF = 128, HTB = HALF * BK * 2  , STAGE_BYTES = 8 * HTB, NXCD = 8, WGM = 8;
__host__ __device__ __forceinline__ int lds_byte(int r, int c) { const int st = (r >> 4) * 2 + (c >> 5), rr = r & 15, cc = c & 31, ob = rr * 64 + cc * 2; return st * 1024 + (ob ^ (((ob >> 9) & 1) << 5)); }
__host__ __device__ __forceinline__ void stage_rc(int b, int& R, int& C) { const int st = b / 1024, sb = b % 1024, swz = sb ^ (((sb >> 9) & 1) << 5); R = (st >> 1) * 16 + swz / 64; C = (st & 1) * 32 + (swz % 64) / 2; }
__host__ __device__ __forceinline__ int perm32(int rho) { const int n = rho >> 4, i = rho & 15; return 8 * (i >> 2) + 4 * n + (i & 3); }
struct Unit { int pm, pn; };
struct Gemm { const f16* A; const f16* Bt; int lda, ldb, K, pn_grp, a_grp_cols; };
struct StaticOrder {
    int nM, nN, nwg, G, c, pn_off;
    __device__ void init(int M_, int N_, int G_, int c_, int pn_off_ = 0) { nM = M_ / BM; nN = N_ / BM; nwg = nM * nN; G = G_; c = c_; pn_off = pn_off_; }
    __device__ bool next(int i, Unit& u) const {
        const long Lx = (long)i * G + c; if (Lx >= nwg) return false;
        int wgid = (int)Lx; { const int q = nwg / NXCD, r = nwg % NXCD, xcd = wgid % NXCD, off = wgid / NXCD; wgid = (xcd < r ? xcd * (q + 1) : r * (q + 1) + (xcd - r) * q) + off; }
        const int nig = WGM * nN, gid = wgid / nig, fm = gid * WGM, gsz = (nM - fm) < WGM ? (nM - fm) : WGM;
        u.pm = fm + ((wgid % nig) % gsz); u.pn = pn_off + (wgid % nig) / gsz; return true;
    }
};
template <class Epi>
__device__ __forceinline__ void gemm_phase(PG8_LAS unsigned char* lds, const Gemm g, const StaticOrder& S, const Epi& E) {
    const int tid = ltid(), wid = __builtin_amdgcn_readfirstlane(tid >> 6), lane = tid & 63, wr = wid >> 2, wc = wid & 3, fr = lane & 15, fq = lane >> 4;
    const int K = g.K, nt = K / BK;
    unsigned voffA[2], voffB[2];
#pragma unroll
    for (int i = 0; i < 2; ++i) { int R, C; stage_rc(tid * 16 + i * 8192, R, C); const int Rb = Epi::PERM ? ((R & ~31) + perm32(R & 31)) : R;
        voffA[i] = (unsigned)(R * g.lda + C) * 2u; voffB[i] = (unsigned)(Rb * g.ldb + C) * 2u; }
    const size_t kstep = (size_t)(BK * 2);
    const size_t hstepA = (size_t)HALF * g.lda * 2, hstepB = (size_t)HALF * g.ldb * 2;
    const size_t tstepA = 2 * hstepA, tstepB = 2 * hstepB;
    const unsigned ldsw = (unsigned)wid * 1024u;
    const int aoff = lds_byte(wr * 64 + fr, fq * 8), boff = lds_byte(wc * 32 + fr, fq * 8);
#define PG8_SA(b, h) (((b) * 2 + (h)) * HTB)
#define PG8_SB(b, h) ((4 + (b) * 2 + (h)) * HTB)
#define PG8_STAGE(bufoff, gbase, voff) do { _Pragma("unroll") for (int _i = 0; _i < 2; ++_i) \
        __builtin_amdgcn_global_load_lds((const unsigned*)((const char*)(gbase) + (voff)[_i]), (PG8_LAS unsigned*)(lds + (bufoff) + ldsw + _i * 8192), 16, 0, 0); } while (0)
#define PG8_LDA(dst, b, h) do { _Pragma("unroll") for (int m = 0; m < 4; ++m) _Pragma("unroll") for (int k = 0; k < 2; ++k) dst[m][k] = *(const PG8_LAS f16x8*)(lds + PG8_SA(b, h) + aoff + m * 2048 + k * 1024); } while (0)
#define PG8_LDB(dst, b, h) do { _Pragma("unroll") for (int n = 0; n < 2; ++n) _Pragma("unroll") for (int k = 0; k < 2; ++k) dst[n][k] = *(const PG8_LAS f16x8*)(lds + PG8_SB(b, h) + boff + n * 2048 + k * 1024); } while (0)
#define PG8_MMA(ai, bj, At, Bt) do { __builtin_amdgcn_s_setprio(1); _Pragma("unroll") for (int m = 0; m < 4; ++m) _Pragma("unroll") for (int n = 0; n < 2; ++n) _Pragma("unroll") for (int k = 0; k < 2; ++k) \
        acc[ai][bj][m][n] = __builtin_amdgcn_mfma_f32_16x16x32_f16(Bt[n][k], At[m][k], acc[ai][bj][m][n], 0, 0, 0); __builtin_amdgcn_s_setprio(0); } while (0)
#define PG8_WAIT_V(n) asm volatile("s_waitcnt vmcnt(" #n ")" ::: "memory")
#define PG8_WAIT_L(n) asm volatile("s_waitcnt lgkmcnt(" #n ")" ::: "memory")
#define PG8_BAR __builtin_amdgcn_s_barrier()
#define PG8_SCHED __builtin_amdgcn_sched_barrier(0)
#define PG8_UA(u) ((const char*)g.A + (size_t)(u).pm * tstepA + (size_t)((u).pn / g.pn_grp) * g.a_grp_cols * 2)
#define PG8_UB(u) ((const char*)g.Bt + (size_t)(u).pn * tstepB)
    Unit cur, nxt; int ui = 0;
    if (!S.next(0, cur)) return;
    f32x4 acc[2][2][4][2];
#pragma unroll
    for (int a = 0; a < 2; ++a)
#pragma unroll
        for (int b = 0; b < 2; ++b)
#pragma unroll
            for (int m = 0; m < 4; ++m)
#pragma unroll
                for (int n = 0; n < 2; ++n) acc[a][b][m][n] = (f32x4){0.f, 0.f, 0.f, 0.f};
    f16x8 At[4][2], B0[2][2], B1[2][2];
    const char* cA = PG8_UA(cur); const char* cB = PG8_UB(cur);
    PG8_STAGE(PG8_SB(0, 0), cB, voffB); PG8_STAGE(PG8_SB(0, 1), cB + hstepB, voffB); PG8_STAGE(PG8_SA(0, 0), cA, voffA); PG8_STAGE(PG8_SA(0, 1), cA + hstepA, voffA);
    if (wr == 1) PG8_BAR;
    PG8_WAIT_V(2); PG8_BAR;
    PG8_STAGE(PG8_SB(1, 0), cB + kstep, voffB); PG8_STAGE(PG8_SA(1, 0), cA + kstep, voffA); PG8_STAGE(PG8_SB(1, 1), cB + hstepB + kstep, voffB);
    PG8_WAIT_V(6); PG8_BAR;
    for (;;) {
        const bool has_next = S.next(ui + 1, nxt);
        const char* nA = has_next ? PG8_UA(nxt) : cA; const char* nB = has_next ? PG8_UB(nxt) : cB;
        for (int t = 0; t < nt; t += 2) {
            const bool last = (t == nt - 2);
            const char* a1 = cA + (size_t)(t + 1) * kstep;
            const char* a2 = last ? nA : cA + (size_t)(t + 2) * kstep; const char* b2 = last ? nB : cB + (size_t)(t + 2) * kstep;
            const char* a3 = a2 + kstep; const char* b3 = b2 + kstep;
            PG8_LDB(B0, 0, 0); PG8_LDB(B1, 0, 1); PG8_SCHED; PG8_LDA(At, 0, 0); PG8_STAGE(PG8_SA(1, 1), a1 + hstepA, voffA);
            PG8_WAIT_V(8); PG8_WAIT_L(0); PG8_BAR; PG8_MMA(0, 0, At, B0); PG8_MMA(0, 1, At, B1); PG8_BAR; PG8_SCHED;
            PG8_LDA(At, 0, 1); PG8_STAGE(PG8_SB(0, 0), b2, voffB); PG8_STAGE(PG8_SB(0, 1), b2 + hstepB, voffB); PG8_STAGE(PG8_SA(0, 0), a2, voffA);
            PG8_WAIT_V(8); PG8_WAIT_L(0); PG8_BAR; PG8_MMA(1, 0, At, B0); PG8_MMA(1, 1, At, B1); PG8_BAR; PG8_SCHED;
            PG8_LDB(B0, 1, 0); PG8_LDB(B1, 1, 1); PG8_SCHED; PG8_LDA(At, 1, 0); PG8_STAGE(PG8_SA(0, 1), a2 + hstepA, voffA);
            PG8_WAIT_V(8); PG8_WAIT_L(0); PG8_BAR; PG8_MMA(0, 0, At, B0); PG8_MMA(0, 1, At, B1); PG8_BAR; PG8_SCHED;
            PG8_LDA(At, 1, 1); PG8_STAGE(PG8_SB(1, 0), b3, voffB); PG8_STAGE(PG8_SB(1, 1), b3 + hstepB, voffB); PG8_STAGE(PG8_SA(1, 0), a3, voffA);
            PG8_WAIT_V(8); PG8_WAIT_L(0); PG8_BAR; PG8_MMA(1, 0, At, B0); PG8_MMA(1, 1, At, B1); PG8_BAR; PG8_SCHED;
        }
        if (wr == 0) PG8_BAR;
        E(acc, cur, wr, wc, fr, fq);
        if (!has_next) break;
#pragma unroll
        for (int a = 0; a < 2; ++a)
#pragma unroll
            for (int b = 0; b < 2; ++b)
#pragma unroll
                for (int m = 0; m < 4; ++m)
#pragma unroll
                    for (int n = 0; n < 2; ++n) acc[a][b][m][n] = (f32x4){0.f, 0.f, 0.f, 0.f};
        cur = nxt; cA = nA; cB = nB; ++ui;
        if (wr == 1) PG8_BAR;
    }
    PG8_WAIT_V(0);
    PG8_BAR;
#undef PG8_SA
#undef PG8_SB
#undef PG8_STAGE
#undef PG8_LDA
#undef PG8_LDB
#undef PG8_MMA
#undef PG8_WAIT_V
#undef PG8_WAIT_L
#undef PG8_BAR
#undef PG8_SCHED
#undef PG8_UA
#undef PG8_UB
}
struct EpiP { static constexpr bool PERM = true; f16* O; int coff;
    __device__ __forceinline__ void operator()(const f32x4 (&acc)[2][2][4][2], const Unit& u, int wr, int wc, int fr, int fq) const {
        const int row0 = u.pm * BM + wr * 64 + fr, col0 = coff + u.pn * BM + wc * 32 + 8 * fq;
#pragma unroll
        for (int ai = 0; ai < 2; ++ai)
#pragma unroll
            for (int m = 0; m < 4; ++m) { f16* rowp = O + (size_t)(row0 + ai * HALF + m * 16) * NP + col0;
#pragma unroll
                for (int bj = 0; bj < 2; ++bj) { const f32x4 v0 = acc[ai][bj][m][0], v1 = acc[ai][bj][m][1];
                    u32x4 w; w.x = pkh(v0[0], v0[1]); w.y = pkh(v0[2], v0[3]); w.z = pkh(v1[0], v1[1]); w.w = pkh(v1[2], v1[3]);
                    *(u32x4*)(rowp + bj * HALF) = w; } }
    }
};
struct EpiBr { static constexpr bool PERM = true; f16* G3; f16* G3b; const f16* P; f16* MRG;
    __device__ __forceinline__ void operator()(const f32x4 (&acc)[2][2][4][2], const Unit& u, int wr, int wc, int fr, int fq) const {
        const int row0 = u.pm * BM + wr * 64 + fr, colg = u.pn * BM + wc * 32 + 8 * fq, br = u.pn >> 3, col0 = colg - br * D;
        f16* Ob = MRG ? MRG : G3b + (size_t)(br - 1) * M * D;
#pragma unroll
        for (int ai = 0; ai < 2; ++ai)
#pragma unroll
            for (int m = 0; m < 4; ++m) { const int row = row0 + ai * HALF + m * 16;
#pragma unroll
                for (int bj = 0; bj < 2; ++bj) { const f32x4 v0 = acc[ai][bj][m][0], v1 = acc[ai][bj][m][1];
                    const f16x8 gp = *(const f16x8*)(P + (size_t)row * NP + C_MRG + colg + bj * HALF);
                    float o[8];
#pragma unroll
                    for (int e = 0; e < 8; ++e) o[e] = (e < 4 ? v0[e] : v1[e - 4]) * __builtin_amdgcn_rcpf(1.f + __expf(-(float)gp[e]));
                    if (MRG) { const f16x8 x1 = *(const f16x8*)(G3b + (size_t)row * D + col0 + bj * HALF), x2 = *(const f16x8*)(G3b + (size_t)M * D + (size_t)row * D + col0 + bj * HALF);
#pragma unroll
                        for (int e = 0; e < 8; ++e) o[e] += (float)x1[e] + (float)x2[e]; }
                    u32x4 w; w.x = pkh(o[0], o[1]); w.y = pkh(o[2], o[3]); w.z = pkh(o[4], o[5]); w.w = pkh(o[6], o[7]);
                    *(u32x4*)(Ob + (size_t)row * D + col0 + bj * HALF) = w; } }
    }
};
struct EpiZ { static constexpr bool PERM = false; Args a; int l;
    __device__ __forceinline__ void operator()(const f32x4 (&acc)[2][2][4][2], const Unit& u, int wr, int wc, int fr, int fq) const {
        const int row0 = u.pm * BM + wr * 64 + fr, col0 = u.pn * BM + wc * 32 + 4 * fq;
        float* Z = (float*)(a.ws + WS_Z); const float* modv = (const float*)(a.ws + WS_MODV) + (size_t)l * 3 * 6144 + 4096;
#pragma unroll
        for (int ai = 0; ai < 2; ++ai)
#pragma unroll
            for (int m = 0; m < 4; ++m) { const int row = row0 + ai * HALF + m * 16; const int b = row / L, t = row % L;
                const float* zr = zrow(a, l, row); const float* gt = modv + (size_t)(t < NCTX ? 2 : b) * 6144;
#pragma unroll
                for (int bj = 0; bj < 2; ++bj)
#pragma unroll
                    for (int n = 0; n < 2; ++n) { const int c = col0 + bj * HALF + n * 16;
                        const f32x4 zo = *(const f32x4*)(zr + c), gv = *(const f32x4*)(gt + c);
                        *(f32x4*)(Z + (size_t)row * D + c) = zo + gv * acc[ai][bj][m][n]; } }
    }
};
}

__device__ __forceinline__ float shifted(const f16* P, const float* mu, int m, int col) {
  const int t = m % L; const float s = (float)P[(size_t)m * NP + col];
  const float pv = (t == 0 || t == NCTX) ? 0.f : (float)P[(size_t)(m - 1) * NP + col];
  const float nx = (t == L - 1 || t == NCTX - 1) ? 0.f : (float)P[(size_t)(m + 1) * NP + col];
  return s + mu[col] * (pv - s) + mu[3328 + col] * (nx - s);
}
namespace pp {
constexpr int WTP = 72, RAWP = 456, XAP = 72;
constexpr int OFF_WT = 0, OFF_RAW = OFF_WT + 4 * 64 * WTP * 2, OFF_XA = OFF_RAW + 34 * RAWP * 2, OFF_SH = OFF_XA + 4 * 32 * XAP * 2, OFF_NR = OFF_SH + 3 * 32 * 64 * 4, OFF_CST = OFF_NR + 256, OFF_END = OFF_CST + 1344 * 4;
static_assert(OFF_END <= LDS_BYTES, "prep LDS");
}
__device__ __forceinline__ void ph_prep(const Args& a, int l, unsigned char* lds, int part = 3, int b0 = 0, int nb = 0) {
  using namespace pp;
  const int tid = ltid(), lane = tid & 63, wave = __builtin_amdgcn_readfirstlane(tid >> 6), fr = lane & 15, fq = lane >> 4;
  const f16* P = (const f16*)(a.ws + WS_P);
  const float* mu = a.in[8] + (size_t)l * 2 * 3328;
  f16* WT = (f16*)(lds + OFF_WT); f16* RAW = (f16*)(lds + OFF_RAW); f16* XA = (f16*)(lds + OFF_XA); float* SH = (float*)(lds + OFF_SH); float* NRI = (float*)(lds + OFF_NR); float* CST = (float*)(lds + OFF_CST);
  float* RKD = (float*)(a.ws + WS_RKD);
  int cur_h = -1;
  const int NU = 272 * 16;
  f16x8 pre[4];
#define PREP_LOAD(u_) do { const int h_ = (u_) & 15, m0_ = ((u_) >> 4) * 32; \
    _Pragma("unroll") for (int i = 0; i < 4; ++i) { const int q = tid + NT * i; if (q < 34 * 56) { const int row = q / 56, cu = q % 56; int mm = m0_ - 1 + row; mm = mm < 0 ? 0 : (mm > M - 1 ? M - 1 : mm); \
      const int col = cu < 24 ? (cu >> 3) * 1024 + h_ * 64 + (cu & 7) * 8 : C_WD + (cu - 24) * 8; pre[i] = *(const f16x8*)(P + (size_t)mm * NP + col); } } } while (0)
  const int pg_ = lbid() >> 4, ph_ = lbid() & 15;
  const bool pbal = (gridDim.x == 256);
  const int pt0 = pbal ? pg_ * 17 : pg_, pcnt = pbal ? 17 : (272 - pg_ + (int)(gridDim.x >> 4) - 1) / (int)(gridDim.x >> 4), pstep = pbal ? 1 : (int)(gridDim.x >> 4);
  (void)NU;
  if ((part & 1) && pcnt > 0) PREP_LOAD((pt0 * 16 + ph_));
  if (part & 1)
  for (int pk = 0; pk < pcnt; ++pk) { const int u = (pt0 + pk * pstep) * 16 + ph_;
    const int tid = ltid(), lane = tid & 63, wave = __builtin_amdgcn_readfirstlane(tid >> 6), fr = lane & 15, fq = lane >> 4;
    const int h = u & 15, m0 = (u >> 4) * 32, b = m0 / L, t0 = m0 % L;
    __syncthreads();
    if (h != cur_h) { cur_h = h;
#pragma unroll 4
      for (int i = tid; i < 4 * 64 * 64; i += NT) { const int mt = i >> 12, j = (i >> 6) & 63, c = i & 63, d = mt >> 1;
        const float* src = (mt & 1) ? a.in[11] : a.in[9];
        WT[(mt * 64 + c) * WTP + j] = (f16)src[(((size_t)l * 2 + d) * 64 + j) * 1024 + h * 64 + c]; }
      for (int i = tid; i < 1344; i += NT) { float v;
        if (i < 512) v = mu[(i >> 8) * 3328 + C_WD + (i & 255)];
        else if (i < 896) { const int q = i - 512, w1 = q / 192, e = q % 192; v = mu[w1 * 3328 + (e >> 6) * 1024 + h * 64 + (e & 63)]; }
        else if (i < 960) v = a.in[13][l * 1024 + h * 64 + (i - 896)];
        else if (i < 1024) v = a.in[14][l * 1024 + h * 64 + (i - 960)];
        else if (i < 1088) v = a.in[15][l * 1024 + h * 64 + (i - 1024)];
        else if (i < 1216) { const int q = i - 1088; v = a.in[10][(l * 2 + (q >> 6)) * 1024 + h * 64 + (q & 63)]; }
        else { const int q = i - 1216; v = a.in[12][(l * 2 + (q >> 6)) * 1024 + h * 64 + (q & 63)]; }
        CST[i] = v; } }
#pragma unroll
    for (int i = 0; i < 4; ++i) { const int q = tid + NT * i; if (q < 34 * 56) { const int row = q / 56, cu = q % 56;
      *(f16x8*)(RAW + row * RAWP + (cu < 24 ? cu * 8 : 192 + (cu - 24) * 8)) = pre[i]; } }
    __syncthreads();
    if (pk + 1 < pcnt) PREP_LOAD((u + pstep * 16));
    { const int tok = tid >> 4, cg = tid & 15, t = t0 + tok; const bool zp = (t == 0 || t == NCTX), zn = (t == L - 1 || t == NCTX - 1);
      const f16* rp = RAW + tok * RAWP + 192 + 16 * cg;
      const int c0 = 16 * cg, mt = c0 < 128 ? 2 * (c0 >> 6) : 2 * ((c0 - 128) >> 6) + 1, j0 = c0 & 63;
#pragma unroll
      for (int hf = 0; hf < 2; ++hf) { const f16x8 pv = *(const f16x8*)(rp + hf * 8), cv = *(const f16x8*)(rp + RAWP + hf * 8), nv = *(const f16x8*)(rp + 2 * RAWP + hf * 8);
        const float* m0p = CST + c0 + hf * 8; f16x8 o;
#pragma unroll
        for (int e = 0; e < 8; ++e) { const float sv = (float)cv[e], p = zp ? 0.f : (float)pv[e], n = zn ? 0.f : (float)nv[e];
          float x = sv + m0p[e] * (p - sv) + m0p[256 + e] * (n - sv); if (!(mt & 1)) x = tanh_f(x); o[e] = (f16)x; }
        *(f16x8*)(XA + (mt * 32 + tok) * XAP + j0 + hf * 8) = o; } }
#pragma unroll
    for (int it = 0; it < 2; ++it) { const int q = tid + NT * it; if (q < 32 * 24) { const int tok = q / 24, g8 = q % 24, seg = g8 >> 3, ch = (g8 & 7) * 8, t = t0 + tok;
        const bool zp = (t == 0 || t == NCTX), zn = (t == L - 1 || t == NCTX - 1);
        const f16* rp = RAW + tok * RAWP + g8 * 8; const f16x8 pv = *(const f16x8*)rp, cv = *(const f16x8*)(rp + RAWP), nv = *(const f16x8*)(rp + 2 * RAWP);
        const float* m0p = CST + 512 + seg * 64 + ch; float o[8];
#pragma unroll
        for (int e = 0; e < 8; ++e) { const float sv = (float)cv[e], p = zp ? 0.f : (float)pv[e], n = zn ? 0.f : (float)nv[e]; o[e] = sv + m0p[e] * (p - sv) + m0p[192 + e] * (n - sv); }
        float* dst = SH + (seg * 32 + tok) * 64 + ch; *(f32x4*)dst = (f32x4){o[0], o[1], o[2], o[3]}; *(f32x4*)(dst + 4) = (f32x4){o[4], o[5], o[6], o[7]}; } }
    __syncthreads();
    const int ti = wave & 1, d = (wave >> 1) & 1, chalf = wave >> 2;
    f32x4 acc[2][2];
#pragma unroll
    for (int m2 = 0; m2 < 2; ++m2)
#pragma unroll
      for (int c2 = 0; c2 < 2; ++c2) { acc[m2][c2] = (f32x4){0.f, 0.f, 0.f, 0.f};
#pragma unroll
        for (int ks = 0; ks < 2; ++ks) acc[m2][c2] = __builtin_amdgcn_mfma_f32_16x16x32_f16(*(const f16x8*)(XA + ((2 * d + m2) * 32 + 16 * ti + fr) * XAP + ks * 32 + fq * 8),
                                                                                             *(const f16x8*)(WT + ((2 * d + m2) * 64 + 16 * (2 * chalf + c2) + fr) * WTP + ks * 32 + fq * 8), acc[m2][c2], 0, 0, 0); }
    __syncthreads();
    unsigned char* SR = lds + OFF_RAW;
    { const int tok = 4 * wave + (lane >> 4), c4 = (lane & 15) * 4;
      const f32x4 r4 = *(const f32x4*)(SH + (0 * 32 + tok) * 64 + c4), k4 = *(const f32x4*)(SH + (1 * 32 + tok) * 64 + c4), v4 = *(const f32x4*)(SH + (2 * 32 + tok) * 64 + c4);
      const f32x4 kkw = *(const f32x4*)(CST + 896 + c4), rkw = *(const f32x4*)(CST + 1024 + c4);
      const f32x4 kk = k4 * kkw, rkp = r4 * k4 * rkw;
      const float n2 = red16((kk.x * kk.x + kk.y * kk.y) + (kk.z * kk.z + kk.w * kk.w)), rk = red16((rkp.x + rkp.y) + (rkp.z + rkp.w));
      const float inv = 1.f / fmaxf(sqrtf(n2), 1e-12f);
      unsigned char* o = SR + tok * SIR + c4 * 2;
      uint2 w; w.x = pkh(r4.x, r4.y); w.y = pkh(r4.z, r4.w); *(uint2*)o = w;
      w.x = pkh(k4.x, k4.y); w.y = pkh(k4.z, k4.w); *(uint2*)(o + 128) = w;
      w.x = pkh(v4.x, v4.y); w.y = pkh(v4.z, v4.w); *(uint2*)(o + 256) = w;
      if ((lane & 15) == 0) { *(f32x4*)(SR + tok * SIR + 384) = (f32x4){inv, 0.f, 0.f, 0.f}; RKD[(size_t)(m0 + tok) * 16 + h] = rk; } }
#pragma unroll
    for (int c2 = 0; c2 < 2; ++c2) { const int ch = 16 * (2 * chalf + c2) + fr, c = h * 64 + ch;
      const float w0v = CST[1088 + d * 64 + ch], a0v = CST[1216 + d * 64 + ch];
#pragma unroll
      for (int r = 0; r < 4; ++r) { const int tok = 16 * ti + 4 * fq + r;
        const float wl = w0v + acc[0][c2][r]; const float dec = __expf(-0.6065306597126334f * sigm_f(wl));
        const float ag = sigm_f(a0v + acc[1][c2][r]);
        unsigned char* o = SR + tok * SIR + 400 + d * 256;
        ((f16*)o)[ch] = (f16)(1.f - dec); ((f16*)(o + 128))[ch] = (f16)ag; } }
    __syncthreads();
    { unsigned char* dstg = a.ws + WS_SI + ((size_t)(b * 16 + h) * L + t0) * SIR;
#pragma unroll
      for (int i = 0; i < 4; ++i) { const int q = tid + NT * i; if (q < 32 * SIR / 16) *(u32x4*)(dstg + (size_t)q * 16) = *(const u32x4*)(SR + q * 16); } }
  }
#undef PREP_LOAD
  __syncthreads();
  f16* QN = (f16*)(a.ws + WS_QN); f16* KN = (f16*)(a.ws + WS_KN);
  f32x2* cst = (f32x2*)lds;
  for (int i = tid; i < 64 * 32; i += NT) { const int pos = i >> 5, fi = i & 31; const float ang = (float)pos * powf(10000.f, -(float)(2 * fi) / 64.f); cst[i] = (f32x2){cosf(ang), sinf(ang)}; }
  __syncthreads();
  if (nb == 0) nb = gridDim.x;
  const int gw = (lbid() - b0) * 8 + wave, NGW = nb * 8;
  const int ax = lane >> 5, fi = lane & 31;
  if (part & 2)
  for (int m = gw; m < M; m += NGW) {
    const int t = m % L; const f16* pr = P + (size_t)m * NP;
    float x1[10], x2[10], ss[10];
#pragma unroll
    for (int hh = 0; hh < 10; ++hh) { const int src = hh < 8 ? C_ATQ + hh * 128 : C_ATK + (hh - 8) * 128; x1[hh] = (float)pr[src + ax * 64 + fi]; x2[hh] = (float)pr[src + ax * 64 + 32 + fi]; ss[hh] = x1[hh] * x1[hh] + x2[hh] * x2[hh]; }
    const f16x4 vc = *(const f16x4*)(pr + C_ATV + 4 * lane);
#pragma unroll
    for (int hh = 0; hh < 10; ++hh) ss[hh] = wave_sum(ss[hh]);
    f32x2 cs = {1.f, 0.f};
    if (t >= NCTX) { const int n = t - NCTX; cs = cst[(ax == 0 ? n / 64 : n % 64) * 32 + fi]; }
#pragma unroll
    for (int hh = 0; hh < 10; ++hh) { const float* g = (hh < 8 ? a.in[18] : a.in[19]) + l * 128; const float rstd = rsqrtf(ss[hh] * (1.f / 128.f) + 1e-6f);
      const float y1 = x1[hh] * rstd * g[ax * 64 + fi], y2 = x2[hh] * rstd * g[ax * 64 + 32 + fi];
      f16* dst = hh < 8 ? QN + (size_t)m * 1024 + hh * 128 : KN + (size_t)m * 512 + (hh - 8) * 128;
      dst[ax * 64 + fi] = (f16)(y1 * cs.x - y2 * cs.y); dst[ax * 64 + 32 + fi] = (f16)(y1 * cs.y + y2 * cs.x); }
    *(f16x4*)(KN + (size_t)m * 512 + 256 + 4 * lane) = vc;
  }
}

__device__ __forceinline__ int scan_tok(int dir, int i) { return dir == 0 ? i : (i < NCTX ? NCTX - 1 - i : L - 1 - (i - NCTX)); }

namespace rw {
constexpr int T = 16;
constexpr int STEPF = 6 * 64;
constexpr int BUFF = T * STEPF;
constexpr int YR_OFF = 2 * BUFF, YRING = T * 512;
template <int CTRL> __device__ __forceinline__ float dpp(float x) { return __int_as_float(__builtin_amdgcn_update_dpp(0, __float_as_int(x), CTRL, 0xF, 0xF, true)); }
__device__ __forceinline__ float red8(float x) { x += dpp<0xB1>(x); x += dpp<0x4E>(x); x += dpp<0x141>(x); return x; }
struct Ops { f32x4 r0, r1, k0, k1, w0, w1, b0, b1, d0, d1; f32x2 v; };
typedef __attribute__((address_space(3))) const float lcf;
__device__ __forceinline__ void ld_ops(Ops& o, lcf* st, lcf* vp) {
  o.r0 = *(const __attribute__((address_space(3))) f32x4*)(st); o.r1 = *(const __attribute__((address_space(3))) f32x4*)(st + 4);
  o.k0 = *(const __attribute__((address_space(3))) f32x4*)(st + 64); o.k1 = *(const __attribute__((address_space(3))) f32x4*)(st + 68);
  o.w0 = *(const __attribute__((address_space(3))) f32x4*)(st + 192); o.w1 = *(const __attribute__((address_space(3))) f32x4*)(st + 196);
  o.b0 = *(const __attribute__((address_space(3))) f32x4*)(st + 256); o.b1 = *(const __attribute__((address_space(3))) f32x4*)(st + 260);
  o.d0 = *(const __attribute__((address_space(3))) f32x4*)(st + 320); o.d1 = *(const __attribute__((address_space(3))) f32x4*)(st + 324);
  o.v = *(const __attribute__((address_space(3))) f32x2*)(vp);
}
#define RW_LO(v_) __builtin_shufflevector(v_, v_, 0, 1)
#define RW_HI(v_) __builtin_shufflevector(v_, v_, 2, 3)
#define RW_FMA(a_, b_, c_) __builtin_elementwise_fma(a_, b_, c_)
#define RW_DPP(r_, ctrl) "v_add_f32_dpp " r_ ", " r_ ", " r_ " " ctrl " row_mask:0xf bank_mask:0xf bound_ctrl:1\n\t"
__device__ __forceinline__ void step(f32x2 (&S0)[4], f32x2 (&S1)[4], const Ops& o, __attribute__((address_space(3))) f32x2* yw) {
  const f32x2 K[4] = {RW_LO(o.k0), RW_HI(o.k0), RW_LO(o.k1), RW_HI(o.k1)}, R[4] = {RW_LO(o.r0), RW_HI(o.r0), RW_LO(o.r1), RW_HI(o.r1)};
  const f32x2 W[4] = {RW_LO(o.w0), RW_HI(o.w0), RW_LO(o.w1), RW_HI(o.w1)}, Bv[4] = {RW_LO(o.b0), RW_HI(o.b0), RW_LO(o.b1), RW_HI(o.b1)};
  const f32x2 Dv[4] = {RW_LO(o.d0), RW_HI(o.d0), RW_LO(o.d1), RW_HI(o.d1)};
  f32x2 a0 = S0[0] * K[0], a1 = S1[0] * K[0];
#pragma unroll
  for (int j = 1; j < 4; ++j) { a0 = RW_FMA(S0[j], K[j], a0); a1 = RW_FMA(S1[j], K[j], a1); }
  float x0 = a0.x + a0.y, x1 = a1.x + a1.y;
  f32x2 m0, m1;
  asm("s_nop 1\n\t" RW_DPP("%0", "quad_perm:[1,0,3,2]") RW_DPP("%1", "quad_perm:[1,0,3,2]") "v_pk_mul_f32 %2, %4, %6\n\t"
      RW_DPP("%0", "quad_perm:[2,3,0,1]") RW_DPP("%1", "quad_perm:[2,3,0,1]") "v_pk_mul_f32 %3, %5, %6\n\t"
      RW_DPP("%0", "row_half_mirror") RW_DPP("%1", "row_half_mirror")
      : "+v"(x0), "+v"(x1), "=&v"(m0), "=&v"(m1) : "v"(S0[0]), "v"(S1[0]), "v"(W[0]));
  const f32x2 vx = {o.v.x, o.v.x}, vy = {o.v.y, o.v.y};
  f32x2 t0[4], t1[4];
  t0[0] = RW_FMA(vx, Dv[0], m0); t1[0] = RW_FMA(vy, Dv[0], m1);
#pragma unroll
  for (int j = 1; j < 4; ++j) { t0[j] = RW_FMA(vx, Dv[j], S0[j] * W[j]); t1[j] = RW_FMA(vy, Dv[j], S1[j] * W[j]); }
  const f32x2 n0 = {-x0, -x0}, n1 = {-x1, -x1};
#pragma unroll
  for (int j = 0; j < 4; ++j) { S0[j] = RW_FMA(n0, Bv[j], t0[j]); S1[j] = RW_FMA(n1, Bv[j], t1[j]); }
  f32x2 y0 = S0[0] * R[0], y1 = S1[0] * R[0];
#pragma unroll
  for (int j = 1; j < 4; ++j) { y0 = RW_FMA(S0[j], R[j], y0); y1 = RW_FMA(S1[j], R[j], y1); }
  float ya = y0.x + y0.y, yb = y1.x + y1.y; asm("" : "+v"(ya), "+v"(yb));
  *yw = (f32x2){ya, yb};
}
__device__ __forceinline__ void scan_unit(const Args& a, int l, int u, unsigned char* ldsb) {
  const int tid = ltid(), wave = tid >> 6;
  const int dir = u & 1, bh = u >> 1, b = bh >> 4, h = bh & 15;
  const unsigned char* SIb = a.ws + WS_SI + (size_t)bh * L * SIR;
  f16* Y = (f16*)(a.ws + WS_YRW) + (size_t)dir * M * 1024 + (size_t)b * L * 1024 + h * 64;
  float* sbuf = (float*)ldsb;
  constexpr int NC = L / T;
  if (wave >= 4) {
    const int lt = tid - 256;
    const int lpart = lt >> 7, ls = (lt >> 3) & 15, lg = lt & 7;
    float ckk[8], cka[8];
#pragma unroll
    for (int e = 0; e < 8; ++e) { ckk[e] = a.in[13][l * 1024 + h * 64 + lg * 8 + e]; cka[e] = a.in[14][l * 1024 + h * 64 + lg * 8 + e]; }
    u32x4 regs[3];
    auto issue = [&](int c) {
      const unsigned char* rec = SIb + (size_t)scan_tok(dir, c * T + ls) * SIR; const int dof = 400 + dir * 256 + lg * 16;
      regs[0] = *(const u32x4*)(rec + (lpart ? 128 : 0) + lg * 16);
      regs[1] = *(const u32x4*)(rec + (lpart ? dof + 128 : 256 + lg * 16));
      regs[2] = *(const u32x4*)(rec + (lpart ? 384 : dof));
    };
    auto commit = [&](int c) {
      float* d0 = sbuf + (c & 1) * BUFF + ls * STEPF + lg * 8;
      const f16x8 h0 = __builtin_bit_cast(f16x8, regs[0]), h1 = __builtin_bit_cast(f16x8, regs[1]);
      float o0[8], o1[8], o2[8];
      if (lpart == 0) { const f16x8 h2 = __builtin_bit_cast(f16x8, regs[2]);
#pragma unroll
        for (int e = 0; e < 8; ++e) { o0[e] = (float)h0[e]; o1[e] = (float)h1[e]; o2[e] = 1.f - (float)h2[e]; }
        *(f32x4*)(d0) = (f32x4){o0[0], o0[1], o0[2], o0[3]}; *(f32x4*)(d0 + 4) = (f32x4){o0[4], o0[5], o0[6], o0[7]};
        *(f32x4*)(d0 + 128) = (f32x4){o1[0], o1[1], o1[2], o1[3]}; *(f32x4*)(d0 + 132) = (f32x4){o1[4], o1[5], o1[6], o1[7]};
        *(f32x4*)(d0 + 192) = (f32x4){o2[0], o2[1], o2[2], o2[3]}; *(f32x4*)(d0 + 196) = (f32x4){o2[4], o2[5], o2[6], o2[7]}; }
      else { const float inv = __uint_as_float(regs[2].x);
#pragma unroll
        for (int e = 0; e < 8; ++e) { const float k = (float)h0[e], ag = (float)h1[e]; o0[e] = k * ckk[e] * inv; o1[e] = o0[e] * ag; o2[e] = k * (1.f + (ag - 1.f) * cka[e]); }
        *(f32x4*)(d0 + 64) = (f32x4){o0[0], o0[1], o0[2], o0[3]}; *(f32x4*)(d0 + 68) = (f32x4){o0[4], o0[5], o0[6], o0[7]};
        *(f32x4*)(d0 + 256) = (f32x4){o1[0], o1[1], o1[2], o1[3]}; *(f32x4*)(d0 + 260) = (f32x4){o1[4], o1[5], o1[6], o1[7]};
        *(f32x4*)(d0 + 320) = (f32x4){o2[0], o2[1], o2[2], o2[3]}; *(f32x4*)(d0 + 324) = (f32x4){o2[4], o2[5], o2[6], o2[7]}; }
    };
    auto yred = [&](int c) {
      const float* ring = sbuf + YR_OFF + (c & 1) * YRING;
#pragma unroll
      for (int i = 0; i < (T * 32) / 256; ++i) { const int it = lt + 256 * i, s = it >> 5, p = it & 31;
        const f32x4* src = (const f32x4*)(ring + s * 512 + p * 16);
        const f32x4 q = (src[0] + src[1]) + (src[2] + src[3]);
        *(unsigned*)(Y + (size_t)scan_tok(dir, c * T + s) * 1024 + 2 * p) = pkh(q.x + q.z, q.y + q.w); }
    };
    issue(0); commit(0);
    __syncthreads();
    for (int c = 0; c < NC; ++c) {
      if (c + 1 < NC) issue(c + 1);
      if (c > 0) yred(c - 1);
      if (c + 1 < NC) commit(c + 1);
      __syncthreads();
    }
    yred(NC - 1);
  } else {
    const int p = tid >> 3, ks = tid & 7;
    __builtin_amdgcn_s_setprio(2);
    f32x2 S0[4], S1[4];
#pragma unroll
    for (int k = 0; k < 4; ++k) { S0[k] = (f32x2){0.f, 0.f}; S1[k] = (f32x2){0.f, 0.f}; }
    typedef __attribute__((address_space(3))) f32x2 lf2;
    __syncthreads();
    for (int c = 0; c < NC; ++c) {
      lcf* buf = (lcf*)(sbuf + (c & 1) * BUFF) + ks * 8; lcf* vb = (lcf*)(sbuf + (c & 1) * BUFF) + 128 + 2 * p;
      lf2* yw = (lf2*)(sbuf + YR_OFF + (c & 1) * YRING) + tid;
      Ops A, B;
      ld_ops(A, buf, vb);
#pragma unroll 1
      for (int s = 0; s < T; s += 2) {
        ld_ops(B, buf + (s + 1) * STEPF, vb + (s + 1) * STEPF);
        step(S0, S1, A, yw + s * 256);
        __builtin_amdgcn_sched_barrier(0);
        ld_ops(A, buf + (s + 2) * STEPF, vb + (s + 2) * STEPF);
        step(S0, S1, B, yw + (s + 1) * 256);
        __builtin_amdgcn_sched_barrier(0);
      }
      __syncthreads();
    }
    __builtin_amdgcn_s_setprio(0);
  }
}
}


namespace ml {
constexpr int PT = 136;
constexpr int OFF_Q = 0, OFF_K = 128 * PT * 2, OFF_KT = 2 * 128 * PT * 2, OFF_VT = 3 * 128 * PT * 2, OFF_CT = OFF_VT + 80 * PT * 2, OFF_SC = OFF_CT + 80 * PT * 2;
constexpr int LDS_NEED = OFF_SC + 6 * 512 + 256 + 64;
static_assert(LDS_NEED <= LDS_BYTES, "mLSTM LDS");
constexpr int NCH = L / 128;
#define MFMA16(a_, b_, c_) __builtin_amdgcn_mfma_f32_16x16x32_f16(a_, b_, c_, 0, 0, 0)
__device__ __forceinline__ void mlstm_unit(const Args& a, int l, int u, unsigned char* lds) {
  const int tid = ltid(), lane = tid & 63, w = __builtin_amdgcn_readfirstlane(tid >> 6), fr = lane & 15, fq = lane >> 4;
  const int dir = u & 1, vs = (u >> 1) & 3, bh = u >> 3, b = bh >> 2, h = bh & 3;
  const f16* P = (const f16*)(a.ws + WS_P) + (size_t)b * L * NP; const float* GP = (const float*)(a.ws + WS_GPRE) + (size_t)b * L * 16; const float* gb = a.in[20] + l * 16;
  f16* HM = (f16*)(a.ws + WS_HM) + (size_t)dir * M * 1024 + (size_t)b * L * 1024 + h * 256 + vs * 64;
  f16* Qs = (f16*)(lds + OFF_Q); f16* Ks = (f16*)(lds + OFF_K); f16* KTs = (f16*)(lds + OFF_KT); f16* VTs = (f16*)(lds + OFF_VT); f16* CTs = (f16*)(lds + OFF_CT);
  float* sc = (float*)(lds + OFF_SC); float* li = sc; float* bcs = sc + 128; float* uu = sc + 256; float* Mx = sc + 384; float* wint = sc + 512; float* emt = sc + 640; f16* wah = (f16*)(sc + 768);
  const float bi = gb[dir * 4 + h], bfg = gb[(2 + dir) * 4 + h];
  __syncthreads();
  for (int i = tid; i < 16 * PT; i += NT) VTs[64 * PT + i] = (f16)(i < PT ? 1.f : 0.f);
  for (int i = tid; i < 80 * PT; i += NT) CTs[i] = (f16)0.f;
  f32x4 CT[5];
#pragma unroll
  for (int n = 0; n < 5; ++n) CT[n] = (f32x4){0.f, 0.f, 0.f, 0.f};
  float mcar = 0.f;
  const int sgn = dir ? -1 : 1;
  f16x8 pq[4], pk[4], pv[2];
#define ML_LOAD(c) do { const int tb_ = scan_tok(dir, 128 * (c)); \
    _Pragma("unroll") for (int i = 0; i < 4; ++i) { const int un = tid + NT * i, j = un >> 4, d8 = un & 15; const f16* rp = P + (size_t)(tb_ + sgn * j) * NP; \
      pq[i] = *(const f16x8*)(rp + C_MLQ + h * 128 + d8 * 8); pk[i] = *(const f16x8*)(rp + C_MLK + h * 128 + d8 * 8); } \
    _Pragma("unroll") for (int i = 0; i < 2; ++i) { const int un = tid + NT * i, j = un >> 3, v8 = un & 7; \
      pv[i] = *(const f16x8*)(P + (size_t)(tb_ + sgn * j) * NP + C_MLV + h * 256 + vs * 64 + v8 * 8); } } while (0)
  ML_LOAD(0);
  for (int c = 0; c < NCH; ++c) {
    const int tb = scan_tok(dir, 128 * c);
    __syncthreads();
#pragma unroll
    for (int i = 0; i < 4; ++i) { const int un = tid + NT * i, j = un >> 4, d8 = un & 15;
      f16x8 qv;
#pragma unroll
      for (int e = 0; e < 8; ++e) qv[e] = (f16)((float)pq[i][e] * 0.08838834764831845f);
      *(f16x8*)(Qs + j * PT + d8 * 8) = qv; *(f16x8*)(Ks + j * PT + d8 * 8) = pk[i];
#pragma unroll
      for (int e = 0; e < 8; ++e) KTs[(d8 * 8 + e) * PT + (j ^ (d8 * 8))] = pk[i][e]; }
#pragma unroll
    for (int i = 0; i < 2; ++i) { const int un = tid + NT * i, j = un >> 3, v8 = un & 7;
#pragma unroll
      for (int e = 0; e < 8; ++e) VTs[(v8 * 8 + e) * PT + (j ^ (v8 * 8))] = pv[i][e]; }
    if (tid < 128) { const float* gp = GP + (size_t)(tb + sgn * tid) * 16;
      const float pi = gp[dir * 4 + h] + bi, pf = gp[(2 + dir) * 4 + h] + bfg;
      li[tid] = 15.f * tanhf(pi * (1.f / 15.f)); bcs[tid] = -softplus_f(-15.f * tanhf(pf * (1.f / 15.f))); }
    if (c + 1 < NCH) ML_LOAD(c + 1);
    __syncthreads();
    if (w == 0) {
      const float x0 = bcs[2 * lane], x1 = bcs[2 * lane + 1]; const float ps = x0 + x1; float inc = ps;
#pragma unroll
      for (int o = 1; o < 64; o <<= 1) { const float t = __shfl_up(inc, o); if (lane >= o) inc += t; }
      const float b0 = inc - ps + x0, b1 = b0 + x1;
      const float u0 = li[2 * lane] - b0, u1 = li[2 * lane + 1] - b1;
      float incm = fmaxf(u0, u1);
#pragma unroll
      for (int o = 1; o < 64; o <<= 1) { const float t = __shfl_up(incm, o); if (lane >= o) incm = fmaxf(incm, t); }
      float exm = __shfl_up(incm, 1); if (lane == 0) exm = -INFINITY;
      const float pm0 = fmaxf(exm, u0), pm1 = incm;
      const float M0 = fmaxf(mcar, pm0), M1 = fmaxf(mcar, pm1); const float Ml = __shfl(M1, 63);
      bcs[2 * lane] = b0; bcs[2 * lane + 1] = b1; uu[2 * lane] = u0; uu[2 * lane + 1] = u1; Mx[2 * lane] = M0; Mx[2 * lane + 1] = M1;
      wint[2 * lane] = expf(mcar - M0); wint[2 * lane + 1] = expf(mcar - M1); emt[2 * lane] = expf(-(b0 + M0)); emt[2 * lane + 1] = expf(-(b1 + M1));
      wah[2 * lane] = (f16)expf(u0 - Ml); wah[2 * lane + 1] = (f16)expf(u1 - Ml);
    }
    f16x8 af[4];
#pragma unroll
    for (int ks = 0; ks < 4; ++ks) af[ks] = *(const f16x8*)(Qs + (16 * w + fr) * PT + ks * 32 + fq * 8);
    f32x4 acc[8];
#pragma unroll
    for (int n = 0; n < 8; ++n) { acc[n] = (f32x4){0.f, 0.f, 0.f, 0.f};
#pragma unroll
      for (int ks = 0; ks < 4; ++ks) acc[n] = MFMA16(af[ks], *(const f16x8*)(Ks + (16 * n + fr) * PT + ks * 32 + fq * 8), acc[n]); }
    __syncthreads();
    const float Mlast = Mx[127], gsum = bcs[127]; const float cs = expf(mcar - Mlast);
    f16* Ss = Ks;
    { float Mt[4];
#pragma unroll
      for (int r = 0; r < 4; ++r) Mt[r] = Mx[16 * w + 4 * fq + r];
#pragma unroll
      for (int n = 0; n < 8; ++n) { const int s = 16 * n + fr; const float us = uu[s];
#pragma unroll
        for (int r = 0; r < 4; ++r) { const int t = 16 * w + 4 * fq + r; const float v = (s <= t) ? acc[n][r] * __expf(us - Mt[r]) : 0.f; Ss[t * PT + s] = (f16)v; } } }
    f32x4 QC[5], SV[5];
#pragma unroll
    for (int n = 0; n < 5; ++n) { QC[n] = (f32x4){0.f, 0.f, 0.f, 0.f}; SV[n] = (f32x4){0.f, 0.f, 0.f, 0.f};
#pragma unroll
      for (int ks = 0; ks < 4; ++ks) QC[n] = MFMA16(af[ks], *(const f16x8*)(CTs + (16 * n + fr) * PT + ks * 32 + fq * 8), QC[n]); }
#pragma unroll
    for (int ks = 0; ks < 4; ++ks) if (32 * ks <= 16 * w + 15) { const f16x8 sf = *(const f16x8*)(Ss + (16 * w + fr) * PT + ks * 32 + fq * 8);
#pragma unroll
      for (int n = 0; n < 5; ++n) SV[n] = MFMA16(sf, *(const f16x8*)(VTs + (16 * n + fr) * PT + ((ks * 32 + fq * 8) ^ ((((16 * n + fr) >> 3) & 7) * 8))), SV[n]); }
#pragma unroll
    for (int r = 0; r < 4; ++r) { const int t = 16 * w + 4 * fq + r; const float wi = wint[t];
      const float den = __shfl(wi * QC[4][r] + SV[4][r], lane & 48); const float inv = 1.f / fmaxf(fabsf(den), emt[t]);
      f16* hp = HM + (size_t)(tb + sgn * t) * 1024 + fr;
#pragma unroll
      for (int n = 0; n < 4; ++n) hp[16 * n] = (f16)((wi * QC[n][r] + SV[n][r]) * inv); }
#pragma unroll
    for (int n = 0; n < 5; ++n) CT[n] = CT[n] * cs;
#pragma unroll
    for (int ks = 0; ks < 4; ++ks) { const f16x8 bfr = *(const f16x8*)(KTs + (16 * w + fr) * PT + ((ks * 32 + fq * 8) ^ ((((16 * w + fr) >> 3) & 15) * 8))) * *(const f16x8*)(wah + ks * 32 + fq * 8);
#pragma unroll
      for (int n = 0; n < 5; ++n) CT[n] = MFMA16(*(const f16x8*)(VTs + (16 * n + fr) * PT + ((ks * 32 + fq * 8) ^ ((((16 * n + fr) >> 3) & 7) * 8))), bfr, CT[n]); }
    __syncthreads();
#pragma unroll
    for (int n = 0; n < 5; ++n)
#pragma unroll
      for (int r = 0; r < 4; ++r) CTs[(16 * n + 4 * fq + r) * PT + 16 * w + fr] = (f16)CT[n][r];
    mcar = gsum + Mlast;
  }
#undef ML_LOAD
}
#undef MFMA16
}

namespace att {
constexpr int AD = 128, NW = 8, QBLK = 32, KVBLK = 64;
constexpr float SCALE = 0.088388347648318440f;
constexpr float THR = 8.f;
constexpr int LDQ = 1024, LDK = 512, LDV = 512, LDO = 1024;
constexpr size_t SHM_V = KVBLK * AD * 2, SHM_K = KVBLK * AD * 2, SHM_ATTN = 2 * SHM_V + 2 * SHM_K + NW * 64 * 4;
using s16x4 = __attribute__((ext_vector_type(4))) short;
using f32x16 = __attribute__((ext_vector_type(16))) float;
#define KSWZ(row, colB) ((row) * 256 + ((colB) ^ (((row) & 7) << 4)))
#define SBAR() __builtin_amdgcn_sched_barrier(0)
__device__ __forceinline__ int crow(int r, int hi) { return (r & 3) + 8 * (r >> 2) + 4 * hi; }
__device__ __forceinline__ unsigned cvtpk(float lo, float hi) { unsigned r; asm volatile("v_cvt_pk_f16_f32 %0, %1, %2" : "=v"(r) : "v"(lo), "v"(hi)); return r; }
__device__ __forceinline__ void partialSM(f32x16& p0, f32x16& p1, float& m_reg, float& mn, float& alpha) {
  constexpr float C = SCALE * 1.4426950408889634f;
  float pmax = p0[0];
#pragma unroll
  for (int r = 1; r < 16; ++r) pmax = fmaxf(pmax, p0[r]);
#pragma unroll
  for (int r = 0; r < 16; ++r) pmax = fmaxf(pmax, p1[r]);
  { auto rr = __builtin_amdgcn_permlane32_swap(__float_as_uint(pmax), __float_as_uint(pmax), false, false);
    pmax = fmaxf(__uint_as_float(rr[0]), __uint_as_float(rr[1])); }
  if (__builtin_expect(__all(pmax - m_reg <= THR / SCALE), 1)) { mn = m_reg; alpha = 1.f; }
  else { mn = fmaxf(m_reg, pmax); alpha = __builtin_amdgcn_exp2f((m_reg - mn) * C); m_reg = mn; }
  float mnC = -mn * C;
#pragma unroll
  for (int r = 0; r < 16; ++r) p0[r] = fmaf(p0[r], C, mnC);
#pragma unroll
  for (int r = 0; r < 16; ++r) p1[r] = fmaf(p1[r], C, mnC);
#pragma unroll
  for (int r = 0; r < 16; ++r) p0[r] = __builtin_amdgcn_exp2f(p0[r]);
}
__device__ __forceinline__ void finishSM(f32x16& p0, f32x16& p1, float alpha, float& l_reg, f16x8& pa0, f16x8& pa1, f16x8& pa2, f16x8& pa3) {
#pragma unroll
  for (int r = 0; r < 16; ++r) p1[r] = __builtin_amdgcn_exp2f(p1[r]);
  float ps = 0;
#pragma unroll
  for (int r = 0; r < 16; ++r) ps += p0[r];
#pragma unroll
  for (int r = 0; r < 16; ++r) ps += p1[r];
  { auto rr = __builtin_amdgcn_permlane32_swap(__float_as_uint(ps), __float_as_uint(ps), false, false);
    ps = __uint_as_float(rr[0]) + __uint_as_float(rr[1]); }
  l_reg = l_reg * alpha + ps;
#define PK4(P, BASE, OUT) do { unsigned a0 = cvtpk(P[BASE + 0], P[BASE + 1]), a1 = cvtpk(P[BASE + 2], P[BASE + 3]);   \
    unsigned b0 = cvtpk(P[BASE + 4], P[BASE + 5]), b1 = cvtpk(P[BASE + 6], P[BASE + 7]);                              \
    auto r0 = __builtin_amdgcn_permlane32_swap(a0, b0, false, false); auto r1 = __builtin_amdgcn_permlane32_swap(a1, b1, false, false); \
    u32x4 w = {r0[0], r1[0], r0[1], r1[1]}; OUT = __builtin_bit_cast(f16x8, w); } while (0)
  PK4(p0, 0, pa0); PK4(p0, 8, pa1); PK4(p1, 0, pa2); PK4(p1, 8, pa3);
#undef PK4
}
__device__ __forceinline__ void qkt(f32x16& p0, f32x16& p1, const char* Ks, const f16x8* qr, int r32, int hi) {
  p0 = f32x16{}; p1 = f32x16{};
#pragma unroll
  for (int d0 = 0; d0 < 8; ++d0) { int cb = (d0 * 16 + hi * 8) * 2;
    f16x8 b0 = *reinterpret_cast<const f16x8*>(Ks + KSWZ(r32, cb));
    f16x8 b1 = *reinterpret_cast<const f16x8*>(Ks + KSWZ(32 + r32, cb));
    p0 = __builtin_amdgcn_mfma_f32_32x32x16_f16(b0, qr[d0], p0, 0, 0, 0);
    p1 = __builtin_amdgcn_mfma_f32_32x32x16_f16(b1, qr[d0], p1, 0, 0, 0); }
}
__device__ __forceinline__ int v_st(int k, int c) { const int kk = (k & ~0xC) | ((k & 4) << 1) | ((k & 8) >> 1); return ((kk >> 3) * 4 + (c >> 5)) * 512 + ((kk & 7) * 32 + (c & 31)) * 2; }
__device__ __forceinline__ int v_rd_base(int lane) { return ((lane & 3) << 3) | (((lane >> 2) & 3) << 6) | (((lane >> 4) & 1) << 5) | (((lane >> 5) & 1) << 8); }
constexpr int v_rd_off(int d0, int ks, int half) { return d0 * 512 + ks * 4096 + half * 2048; }
template <int OFF> __device__ __forceinline__ s16x4 tr_read(int vb) {
  s16x4 r; asm volatile("ds_read_b64_tr_b16 %0, %1 offset:%2" : "=&v"(r) : "v"(vb), "i"(OFF) : "memory"); return r;
}
template <int D0> __device__ __forceinline__ void pv_one(f32x16& od, int vb, f16x8 pa0, f16x8 pa1, f16x8 pa2, f16x8 pa3) {
  const s16x4 l0 = tr_read<v_rd_off(D0, 0, 0)>(vb), h0 = tr_read<v_rd_off(D0, 0, 1)>(vb), l1 = tr_read<v_rd_off(D0, 1, 0)>(vb), h1 = tr_read<v_rd_off(D0, 1, 1)>(vb);
  const s16x4 l2 = tr_read<v_rd_off(D0, 2, 0)>(vb), h2 = tr_read<v_rd_off(D0, 2, 1)>(vb), l3 = tr_read<v_rd_off(D0, 3, 0)>(vb), h3 = tr_read<v_rd_off(D0, 3, 1)>(vb);
  asm volatile("s_waitcnt lgkmcnt(0)" ::: "memory"); SBAR();
  typedef short s16x8 __attribute__((ext_vector_type(8)));
#define PK(Lo, Hi) __builtin_bit_cast(f16x8, (s16x8){Lo[0], Lo[1], Lo[2], Lo[3], Hi[0], Hi[1], Hi[2], Hi[3]})
  od = __builtin_amdgcn_mfma_f32_32x32x16_f16(pa0, PK(l0, h0), od, 0, 0, 0);
  od = __builtin_amdgcn_mfma_f32_32x32x16_f16(pa1, PK(l1, h1), od, 0, 0, 0);
  od = __builtin_amdgcn_mfma_f32_32x32x16_f16(pa2, PK(l2, h2), od, 0, 0, 0);
  od = __builtin_amdgcn_mfma_f32_32x32x16_f16(pa3, PK(l3, h3), od, 0, 0, 0);
#undef PK
}
__device__ __forceinline__ void pv_d0(f32x16* o, int vb, f16x8 pa0, f16x8 pa1, f16x8 pa2, f16x8 pa3) {
  pv_one<0>(o[0], vb, pa0, pa1, pa2, pa3); pv_one<1>(o[1], vb, pa0, pa1, pa2, pa3); pv_one<2>(o[2], vb, pa0, pa1, pa2, pa3); pv_one<3>(o[3], vb, pa0, pa1, pa2, pa3);
}
__device__ __forceinline__ void attn_dense_body(const f16* __restrict__ Qb, const f16* __restrict__ Kh, const f16* __restrict__ Vh, f16* __restrict__ Ob, int seq, char* lds) {
  const int tid = ltid(), wid = tid >> 6, lane = tid & 63, r32 = lane & 31, hi = lane >> 5;
  char* V_lds = lds; char* K_lds = lds + 2 * SHM_V;
  float* ws = (float*)(lds + 2 * SHM_V + 2 * SHM_K) + wid * 64; float* li_l = ws; float* al_l = ws + 32;
  float m_reg = -1e30f, l_reg = 0; f32x16 o[4] = {}; f16x8 qr[8];
  const f16* Qw = Qb + (long)(wid * QBLK + r32) * LDQ + hi * 8;
#pragma unroll
  for (int d0 = 0; d0 < 8; ++d0) qr[d0] = *reinterpret_cast<const f16x8*>(Qw + d0 * 16);
  const int sr = tid >> 4, sc = (tid & 15) * 8, vst0 = v_st(sr, sc), vst1 = v_st(32 + sr, sc);
  const int vb0 = (int)(uintptr_t)V_lds + v_rd_base(lane);
  struct { f16x8 vs0, vs1, ks0, ks1; } sr_[2];
#define SLOAD(i, k0) do { sr_[i].vs0 = *(const f16x8*)(&Vh[(long)((k0) + sr) * LDV + sc]); sr_[i].vs1 = *(const f16x8*)(&Vh[(long)((k0) + 32 + sr) * LDV + sc]); \
    sr_[i].ks0 = *(const f16x8*)(&Kh[(long)((k0) + sr) * LDK + sc]); sr_[i].ks1 = *(const f16x8*)(&Kh[(long)((k0) + 32 + sr) * LDK + sc]); } while (0)
#define SWRITE(b, i) do { *(f16x8*)(V_lds + (b) * SHM_V + vst0) = sr_[i].vs0;          \
    *(f16x8*)(V_lds + (b) * SHM_V + vst1) = sr_[i].vs1; int kc = sc * 2;               \
    *(f16x8*)(K_lds + (b) * SHM_K + KSWZ(sr, kc)) = sr_[i].ks0;                       \
    *(f16x8*)(K_lds + (b) * SHM_K + KSWZ(32 + sr, kc)) = sr_[i].ks1; } while (0)
#define SWAIT() asm volatile("s_waitcnt vmcnt(4)" ::: "memory")
#define RESC(a) do { if (__any((a) < 1.f)) { if (hi == 0) al_l[r32] = (a); asm volatile("s_waitcnt lgkmcnt(0)" ::: "memory"); \
    _Pragma("unroll") for (int d = 0; d < 4; ++d) _Pragma("unroll") for (int r = 0; r < 16; ++r) o[d][r] *= al_l[crow(r, hi)]; } } while (0)
  f32x16 pA0, pA1, pB0, pB1; float mnA, mnB, alA, alB; f16x8 pa0, pa1, pa2, pa3; const int NTl = seq / KVBLK;
  constexpr int SE = 0, SO = 1;
  SLOAD(SE, 0); asm volatile("s_waitcnt vmcnt(0)" ::: "memory"); SWRITE(0, SE); __syncthreads();
  qkt(pA0, pA1, K_lds, qr, r32, hi); partialSM(pA0, pA1, m_reg, mnA, alA);
  SLOAD(SO, KVBLK); if (2 < NTl) SLOAD(SE, 2 * KVBLK);
  SWAIT(); SWRITE(1, SO); __syncthreads();
  for (int j = 1; j + 1 < NTl; j += 2) {
    SBAR(); qkt(pB0, pB1, K_lds + SHM_K, qr, r32, hi);
    finishSM(pA0, pA1, alA, l_reg, pa0, pa1, pa2, pa3); SBAR();
    SLOAD(SO, (j + 2) * KVBLK); SBAR();
    pv_d0(o, vb0, pa0, pa1, pa2, pa3); partialSM(pB0, pB1, m_reg, mnB, alB);
    __syncthreads(); SWAIT(); SWRITE(0, SE);
    RESC(alB); __syncthreads();
    SBAR(); qkt(pA0, pA1, K_lds, qr, r32, hi);
    finishSM(pB0, pB1, alB, l_reg, pa0, pa1, pa2, pa3); SBAR();
    if (j + 3 < NTl) SLOAD(SE, (j + 3) * KVBLK); SBAR();
    pv_d0(o, vb0 + (int)SHM_V, pa0, pa1, pa2, pa3); partialSM(pA0, pA1, m_reg, mnA, alA);
    __syncthreads(); SWAIT(); SWRITE(1, SO);
    RESC(alA); __syncthreads();
  }
  SBAR(); qkt(pB0, pB1, K_lds + SHM_K, qr, r32, hi);
  finishSM(pA0, pA1, alA, l_reg, pa0, pa1, pa2, pa3); SBAR();
  pv_d0(o, vb0, pa0, pa1, pa2, pa3); partialSM(pB0, pB1, m_reg, mnB, alB);
  __syncthreads(); RESC(alB);
  finishSM(pB0, pB1, alB, l_reg, pa0, pa1, pa2, pa3); SBAR();
  pv_d0(o, vb0 + (int)SHM_V, pa0, pa1, pa2, pa3);
  if (hi == 0) li_l[r32] = l_reg; asm volatile("s_waitcnt lgkmcnt(0)" ::: "memory");
  float rli[16];
#pragma unroll
  for (int r = 0; r < 16; ++r) rli[r] = __builtin_amdgcn_rcpf(li_l[crow(r, hi)]);
  f16* Ow = Ob + (long)(wid * QBLK) * LDO;
#pragma unroll
  for (int r = 0; r < 16; ++r) { int orow = crow(r, hi);
#pragma unroll
    for (int d0 = 0; d0 < 4; ++d0) Ow[(long)orow * LDO + d0 * 32 + r32] = (f16)(o[d0][r] * rli[r]); }
#undef SLOAD
#undef SWRITE
#undef SWAIT
#undef RESC
}
#undef KSWZ
#undef SBAR
__device__ __forceinline__ void attn_unit(const Args& a, int u, char* lds) {
  int b, hq, t0, seq;
  if (u < 256) { const int qb = u & 15, r = (u >> 4) & 3, g = (u >> 6) & 1; b = u >> 7; hq = g * 4 + r; t0 = NCTX + 256 * qb; seq = L; }
  else { const int v = u - 256; b = v >> 3; hq = v & 7; t0 = 0; seq = NCTX; }
  const size_t m0 = (size_t)b * L + t0, k0 = (size_t)b * L; const int g = hq >> 2;
  const f16* Kh = (const f16*)(a.ws + WS_KN) + k0 * 512 + g * 128;
  attn_dense_body((const f16*)(a.ws + WS_QN) + m0 * 1024 + hq * 128, Kh, Kh + 256, (f16*)(a.ws + WS_AO) + m0 * 1024 + hq * 128, seq, lds);
}
}

__device__ __forceinline__ void ph_post(const Args& a, int l, int part = 3, int b0 = 0, int nb = 0) {
  const int tid = ltid(), lane = tid & 63, wave = tid >> 6;
  if (nb == 0) nb = gridDim.x;
  const int gw = (lbid() - b0) * 8 + wave, NGW = nb * 8;
  const f16* P = (const f16*)(a.ws + WS_P); f16* Y = (f16*)(a.ws + WS_Y);
  const f16* YRW = (const f16*)(a.ws + WS_YRW); const f16* AO = (const f16*)(a.ws + WS_AO); const f16* HM = (const f16*)(a.ws + WS_HM);
  const unsigned char* SIp = a.ws + WS_SI; const float* RKD = (const float*)(a.ws + WS_RKD);
  f32x4 lw[4], lb[4];
  if (part & 1) {
#pragma unroll
    for (int g = 0; g < 4; ++g) { const int c = (4 * g + (lane >> 4)) * 64 + (lane & 15) * 4; lw[g] = *(const f32x4*)(a.in[16] + l * 1024 + c); lb[g] = *(const f32x4*)(a.in[17] + l * 1024 + c); } }
  f32x4 ng[4];
  if (part & 2) {
#pragma unroll
    for (int h = 0; h < 4; ++h) ng[h] = *(const f32x4*)(a.in[21] + l * 1024 + h * 256 + lane * 4); }
  for (int m = gw; m < M; m += NGW) {
    const int lane = ltid() & 63, hq = lane >> 4, c4 = (lane & 15) * 4;
    const int b = m / L, t = m % L; const f16* pr = P + (size_t)m * NP; f16* yr = Y + (size_t)m * 3072;
    if (part & 1) {
    f16x4 ya[4], yb[4]; f32x4 vv[4]; f16x4 ga[4]; float rk[4];
#pragma unroll
    for (int g = 0; g < 4; ++g) { const int h = 4 * g + hq, c = h * 64 + c4;
      ya[g] = *(const f16x4*)(YRW + (size_t)m * 1024 + c); yb[g] = *(const f16x4*)(YRW + (size_t)(M + m) * 1024 + c);
      { const f16x4 vh = *(const f16x4*)(SIp + ((size_t)(b * 16 + h) * L + t) * SIR + 256 + c4 * 2); vv[g] = (f32x4){(float)vh[0], (float)vh[1], (float)vh[2], (float)vh[3]}; } ga[g] = *(const f16x4*)(pr + C_RWG + c);
      rk[g] = RKD[(size_t)m * 16 + h]; }
#pragma unroll
    for (int g = 0; g < 4; ++g) { const int c = (4 * g + hq) * 64 + c4; const f32x4 y = (f32x4){(float)ya[g][0] + (float)yb[g][0], (float)ya[g][1] + (float)yb[g][1], (float)ya[g][2] + (float)yb[g][2], (float)ya[g][3] + (float)yb[g][3]};
      const float mu = red16(y.x + y.y + y.z + y.w) * (1.f / 64.f); const f32x4 dv = y - mu;
      const float var = red16(dv.x * dv.x + dv.y * dv.y + dv.z * dv.z + dv.w * dv.w) * (1.f / 64.f); const float rs = rsqrtf(var + 64e-5f);
      float o[4];
#pragma unroll
      for (int e = 0; e < 4; ++e) o[e] = (dv[e] * rs * lw[g][e] + lb[g][e] + rk[g] * vv[g][e]) * silu_f((float)ga[g][e]);
      uint2 w; w.x = pkh(o[0], o[1]); w.y = pkh(o[2], o[3]); *(uint2*)(yr + c) = w; }
    }
    if (part & 2) {
    f16x4 ao[4]; f16x4 gb[4];
#pragma unroll
    for (int j = 0; j < 4; ++j) { const int c = j * 256 + lane * 4; ao[j] = *(const f16x4*)(AO + (size_t)m * 1024 + c); gb[j] = *(const f16x4*)(pr + C_ATG + c); }
    f32x4 ha[4]; f16x4 hha[4], hhb[4], go[4], gg[4];
#pragma unroll
    for (int h = 0; h < 4; ++h) { const int c = h * 256 + lane * 4; hha[h] = *(const f16x4*)(HM + (size_t)m * 1024 + c); hhb[h] = *(const f16x4*)(HM + (size_t)(M + m) * 1024 + c);
      go[h] = *(const f16x4*)(pr + C_MLO + c); gg[h] = *(const f16x4*)(pr + C_MLG + c); }
#pragma unroll
    for (int j = 0; j < 4; ++j) { const int c = j * 256 + lane * 4; float o[4];
#pragma unroll
      for (int e = 0; e < 4; ++e) o[e] = (float)ao[j][e] * silu_f((float)gb[j][e]);
      uint2 w; w.x = pkh(o[0], o[1]); w.y = pkh(o[2], o[3]); *(uint2*)(yr + 1024 + c) = w; }
    float ss[4];
#pragma unroll
    for (int h = 0; h < 4; ++h) { ha[h] = (f32x4){(float)hha[h][0] + (float)hhb[h][0], (float)hha[h][1] + (float)hhb[h][1], (float)hha[h][2] + (float)hhb[h][2], (float)hha[h][3] + (float)hhb[h][3]}; ss[h] = ha[h].x * ha[h].x + ha[h].y * ha[h].y + ha[h].z * ha[h].z + ha[h].w * ha[h].w; }
#pragma unroll
    for (int o = 32; o >= 1; o >>= 1) {
#pragma unroll
      for (int h = 0; h < 4; ++h) ss[h] += __shfl_xor(ss[h], o); }
#pragma unroll
    for (int h = 0; h < 4; ++h) { const int c = h * 256 + lane * 4; const float rstd = rsqrtf(ss[h] * (1.f / 256.f) + 1e-6f); float o[4];
#pragma unroll
      for (int e = 0; e < 4; ++e) o[e] = sigm_f((float)go[h][e]) * (ha[h][e] * rstd * ng[h][e]) * silu_f((float)gg[h][e]);
      uint2 w; w.x = pkh(o[0], o[1]); w.y = pkh(o[2], o[3]); *(uint2*)(yr + 2048 + c) = w; }
    }
  }
}

__device__ __forceinline__ void ph_sum3(const Args& a) {
  const f16* G3 = (const f16*)(a.ws + WS_G3); const f16* G3b = (const f16*)(a.ws + WS_G3B); f16* MG = (f16*)(a.ws + WS_MRG);
  const size_t n8 = (size_t)M * D / 8;
  for (size_t i = (size_t)lbid() * NT + ltid(); i < n8; i += (size_t)gridDim.x * NT) {
    const f16x8 x = *(const f16x8*)(G3 + i * 8), y = *(const f16x8*)(G3b + i * 8), z = *(const f16x8*)(G3b + (size_t)M * D + i * 8);
    f16x8 o;
#pragma unroll
    for (int e = 0; e < 8; ++e) o[e] = (f16)((float)x[e] + (float)y[e] + (float)z[e]);
    *(f16x8*)(MG + i * 8) = o; }
}

__device__ __forceinline__ void ph_final(const Args& a) {
  const int tid = ltid(), lane = tid & 63, wave = tid >> 6;
  const int gw = lbid() * 8 + wave, NGW = gridDim.x * 8;
  const float* Z = (const float*)(a.ws + WS_Z); const float* fg = a.in[24];
  for (int r = gw; r < BATCH * SEQ; r += NGW) {
    const int b = r / SEQ, t = r % SEQ; const float* zr = Z + ((size_t)b * L + NCTX + t) * D; float* o = a.out + (size_t)r * D;
    f32x4 v[8]; float ss = 0.f;
#pragma unroll
    for (int j = 0; j < 8; ++j) { v[j] = *(const f32x4*)(zr + 4 * (lane + 64 * j)); ss += v[j].x * v[j].x + v[j].y * v[j].y + v[j].z * v[j].z + v[j].w * v[j].w; }
    const float rstd = rsqrtf(wave_sum(ss) * (1.f / D) + 1e-6f);
#pragma unroll
    for (int j = 0; j < 8; ++j) { const int k = 4 * (lane + 64 * j); *(f32x4*)(o + k) = v[j] * rstd * *(const f32x4*)(fg + k); }
  }
}


#define XLAS __attribute__((address_space(3)))
#define XB_TMO      128
#define XB_XCNT(j)  (256  + 64 * (j))
#define XB_XSUB(j)  (1280 + 64 * (j))
#define XB_XGEN(j)  (2304 + 64 * (j))
#define XB_TOP      3328
#define XB_TOPGEN   3392
#define XCD_BAR_WORDS 3456
#define XB_SPIN_CAP (1u << 18)
__device__ __forceinline__ unsigned xb_ld(unsigned* p)              { return __hip_atomic_load(p, __ATOMIC_RELAXED, __HIP_MEMORY_SCOPE_AGENT); }
__device__ __forceinline__ unsigned xb_add(unsigned* p, unsigned v) { return __hip_atomic_fetch_add(p, v, __ATOMIC_RELAXED, __HIP_MEMORY_SCOPE_AGENT); }
__device__ __forceinline__ unsigned xb_xcc_id() { return (unsigned)__builtin_amdgcn_s_getreg((3 << 11) | 20) & 0xFu; }
#define XB_SPIN(cond, bar) do { unsigned _sp = 0; while (cond) { __builtin_amdgcn_s_sleep(1); \
    if ((++_sp & 255u) == 0u) { if (xb_ld(&(bar)[XB_TMO])) break; if (_sp > XB_SPIN_CAP) { atomicAdd(&(bar)[XB_TMO], 1u); break; } } } } while (0)
struct XcdBarrier { unsigned* bar; unsigned x; volatile XLAS unsigned* st; };
__device__ __forceinline__ XcdBarrier xcd_barrier_post(unsigned* bar, volatile XLAS unsigned* st) {
    XcdBarrier b; b.bar = bar; b.x = xb_xcc_id(); b.st = st;
    if (threadIdx.x == 0) (void)xb_add(&bar[XB_XCNT(b.x)], 1u);
    return b;
}
__device__ __forceinline__ void xcd_barrier_complete(unsigned* bar, unsigned x, unsigned& nloc, unsigned& nx) {
    const unsigned G = gridDim.x * gridDim.y * gridDim.z;
    unsigned sum, cnt, mine, sp = 0u;
    for (;;) {
        sum = 0u; cnt = 0u; mine = 0u;
#pragma unroll
        for (unsigned j = 0; j < 16; ++j) { const unsigned c = xb_ld(&bar[XB_XCNT(j)]); sum += c; cnt += (c > 0u) ? 1u : 0u; mine = (j == x) ? c : mine; }
        if (sum == G) break;
        __builtin_amdgcn_s_sleep(1);
        if ((++sp & 255u) == 0u) { if (xb_ld(&bar[XB_TMO])) break; if (sp > XB_SPIN_CAP) { atomicAdd(&bar[XB_TMO], 1u); break; } }
    }
    nloc = mine > 0u ? mine : 1u; nx = cnt > 0u ? cnt : 1u;
}
__device__ __forceinline__ void xcd_barrier(const XcdBarrier& b) {
    asm volatile("s_waitcnt vmcnt(0)" ::: "memory");
    __syncthreads();
    if (threadIdx.x == 0) {
        unsigned* bar = b.bar;
        __builtin_amdgcn_s_waitcnt(0);
        unsigned nloc = b.st[0], nx = b.st[1];
        if (nloc == 0u) { xcd_barrier_complete(bar, b.x, nloc, nx); b.st[0] = nloc; b.st[1] = nx; }
        const unsigned old = xb_add(&bar[XB_XSUB(b.x)], 1u);
        const unsigned gen = old / nloc;
        if (old + 1u == (gen + 1u) * nloc) {
            __builtin_amdgcn_fence(__ATOMIC_RELEASE, "agent");
            asm volatile("s_waitcnt vmcnt(0)" ::: "memory");
            const unsigned og = xb_add(&bar[XB_TOP], 1u);
            const unsigned tg = og / nx;
            if (og + 1u == (tg + 1u) * nx) xb_add(&bar[XB_TOPGEN], 1u);
            else XB_SPIN(xb_ld(&bar[XB_TOPGEN]) == tg, bar);
            __builtin_amdgcn_fence(__ATOMIC_ACQUIRE, "agent");
            xb_add(&bar[XB_XGEN(b.x)], 1u);
            asm volatile("s_waitcnt vmcnt(0)" ::: "memory");
        } else {
            XB_SPIN(xb_ld(&bar[XB_XGEN(b.x)]) == gen, bar);
            __builtin_amdgcn_fence(__ATOMIC_ACQUIRE, "agent");
            asm volatile("s_waitcnt vmcnt(0)" ::: "memory");
        }
    }
    __syncthreads();
}


__device__ __forceinline__ void sub_barrier(unsigned* bar, volatile XLAS unsigned* st, unsigned G) {
    asm volatile("s_waitcnt vmcnt(0)" ::: "memory");
    __syncthreads();
    if (threadIdx.x == 0) {
        const unsigned x = xb_xcc_id();
        __builtin_amdgcn_s_waitcnt(0);
        unsigned nloc = st[0], nx = st[1];
        if (nloc == 0u) {
            unsigned sum, cnt, mine, sp = 0u;
            for (;;) { sum = 0u; cnt = 0u; mine = 0u;
#pragma unroll
                for (unsigned j = 0; j < 16; ++j) { const unsigned c = xb_ld(&bar[XB_XCNT(j)]); sum += c; cnt += (c > 0u) ? 1u : 0u; mine = (j == x) ? c : mine; }
                if (sum == G) break;
                __builtin_amdgcn_s_sleep(1);
                if ((++sp & 255u) == 0u) { if (xb_ld(&bar[XB_TMO])) break; if (sp > XB_SPIN_CAP) { atomicAdd(&bar[XB_TMO], 1u); break; } } }
            nloc = mine > 0u ? mine : 1u; nx = cnt > 0u ? cnt : 1u; st[0] = nloc; st[1] = nx; }
        const unsigned old = xb_add(&bar[XB_XSUB(x)], 1u);
        const unsigned gen = old / nloc;
        if (old + 1u == (gen + 1u) * nloc) {
            __builtin_amdgcn_fence(__ATOMIC_RELEASE, "agent");
            asm volatile("s_waitcnt vmcnt(0)" ::: "memory");
            const unsigned og = xb_add(&bar[XB_TOP], 1u);
            const unsigned tg = og / nx;
            if (og + 1u == (tg + 1u) * nx) xb_add(&bar[XB_TOPGEN], 1u);
            else XB_SPIN(xb_ld(&bar[XB_TOPGEN]) == tg, bar);
            __builtin_amdgcn_fence(__ATOMIC_ACQUIRE, "agent");
            xb_add(&bar[XB_XGEN(x)], 1u);
            asm volatile("s_waitcnt vmcnt(0)" ::: "memory");
        } else {
            XB_SPIN(xb_ld(&bar[XB_XGEN(x)]) == gen, bar);
            __builtin_amdgcn_fence(__ATOMIC_ACQUIRE, "agent");
            asm volatile("s_waitcnt vmcnt(0)" ::: "memory");
        }
    }
    __syncthreads();
}

__device__ __forceinline__ int mix_grab(unsigned* ctr, volatile unsigned* slot) {
  __syncthreads();
  if (ltid() == 0) *slot = __hip_atomic_fetch_add(ctr, 1u, __ATOMIC_RELAXED, __HIP_MEMORY_SCOPE_AGENT);
  __syncthreads();
  return (int)*slot;
}
constexpr int MFULL = 8192;
constexpr int NSCAN = 64;
constexpr int NT_RW = 13;
__device__ __forceinline__ void ph_mix(const Args& a, int l, unsigned char* lds) {
  const int bx = lbid();
  if (bx < NSCAN) {
    if (ltid() == 0) { unsigned* pd = (unsigned*)(a.ws + WS_CTL) + 1024 + 64 * l + 32; while (xb_ld(pd) < gridDim.x) __builtin_amdgcn_s_sleep(2); __builtin_amdgcn_fence(__ATOMIC_ACQUIRE, "agent"); }
    __syncthreads();
    rw::scan_unit(a, l, bx, lds); return; }
  const int NB = gridDim.x - NSCAN;
  unsigned* bar2 = (unsigned*)(a.ws + WS_CTL) + 8192 + l * XCD_BAR_WORDS;
  volatile XLAS unsigned* st2 = (volatile XLAS unsigned*)((XLAS unsigned char*)lds + (LDS_BYTES - 48));
  if (ltid() < 2) st2[ltid()] = 0u;
  __syncthreads();
  if (ltid() == 0) (void)xb_add(&bar2[XB_XCNT(xb_xcc_id())], 1u);
  { pg8::Gemm g{(const f16*)(a.ws + WS_H), (const f16*)(a.ws + WS_WIN) + (size_t)NT_RW * 256 * D, D, D, D, 1 << 20, 0}; pg8::StaticOrder So; So.init(M, NP - NT_RW * 256, NB, bx - NSCAN);
    pg8::gemm_phase((PG8_LAS unsigned char*)lds, g, So, pg8::EpiP{(f16*)(a.ws + WS_P), NT_RW * 256}); }
  sub_barrier(bar2, st2, (unsigned)NB);
  ph_prep(a, l, lds, 2, NSCAN, NB);
  sub_barrier(bar2, st2, (unsigned)NB);
  unsigned* ctr = (unsigned*)(a.ws + WS_CTL) + 64 * (1 + l);
  volatile unsigned* slot = (volatile unsigned*)(lds + LDS_BYTES - 64);
  int u = mix_grab(ctr, slot);
  while (u < 64) { ml::mlstm_unit(a, l, u, lds); u = mix_grab(ctr, slot); }
  while (u < 336) { att::attn_unit(a, u - 64, (char*)lds); u = mix_grab(ctr, slot); }
  sub_barrier(bar2, st2, (unsigned)NB);
  ph_post(a, l, 2, NSCAN, NB);
  sub_barrier(bar2, st2, (unsigned)NB);
  { pg8::Gemm g{(const f16*)(a.ws + WS_Y), (const f16*)(a.ws + WS_WBR), 3072, BR, BR, 8, 1024}; pg8::StaticOrder So; So.init(M, 2 * D, NB, bx - NSCAN, 8);
    pg8::gemm_phase((PG8_LAS unsigned char*)lds, g, So, pg8::EpiBr{(f16*)(a.ws + WS_G3), (f16*)(a.ws + WS_G3B), (const f16*)(a.ws + WS_P), nullptr}); }
  if (l + 1 < DEPTH) ph_convert(a, l + 1, lds, 1, NSCAN, NB);
}

__global__ void __launch_bounds__(NT) mega(Args a) {
  extern __shared__ __attribute__((aligned(16))) unsigned char lds[];
  { volatile XLAS unsigned* st0 = (volatile XLAS unsigned*)((XLAS unsigned char*)lds + (LDS_BYTES - 48)); if (threadIdx.x < 6) st0[threadIdx.x] = 0u; }
  __syncthreads();
  (void)xcd_barrier_post((unsigned*)(a.ws + WS_CTL) + 4096, (volatile XLAS unsigned*)((XLAS unsigned char*)lds + (LDS_BYTES - 32)));
#define GRID_SYNC() do { XcdBarrier xb_; xb_.bar = (unsigned*)(a.ws + WS_CTL) + 4096; xb_.x = xb_xcc_id(); xb_.st = (volatile XLAS unsigned*)((XLAS unsigned char*)lds + (LDS_BYTES - 32)); xcd_barrier(xb_); } while (0)
  const f16* P = (const f16*)(a.ws + WS_P);
  ph_modv(a, lds); __syncthreads(); ph_convert(a, 0, lds, 3);
  GRID_SYNC();
#pragma unroll 1
  for (int l = 0; l < DEPTH; ++l) {
    if (l > 0) { ph_convert(a, l, lds, 2); __syncthreads(); }
    ph_norm(a, l, lds);
    GRID_SYNC();
    { pg8::Gemm g{(const f16*)(a.ws + WS_H), (const f16*)(a.ws + WS_WIN), D, D, D, 1 << 20, 0}; pg8::StaticOrder So; So.init(M, NT_RW * 256, gridDim.x, lbid());
      pg8::gemm_phase((PG8_LAS unsigned char*)lds, g, So, pg8::EpiP{(f16*)(a.ws + WS_P), 0}); }
    GRID_SYNC();
    ph_prep(a, l, lds, 1);
    asm volatile("s_waitcnt vmcnt(0)" ::: "memory"); __syncthreads();
    if (ltid() == 0) { __builtin_amdgcn_fence(__ATOMIC_RELEASE, "agent"); (void)xb_add((unsigned*)(a.ws + WS_CTL) + 1024 + 64 * l + 32, 1u); }
    ph_mix(a, l, lds);
    GRID_SYNC();
    ph_post(a, l, 1);
    GRID_SYNC();
    { pg8::Gemm g{(const f16*)(a.ws + WS_Y), (const f16*)(a.ws + WS_WBR), 3072, BR, BR, 8, 1024}; pg8::StaticOrder So; So.init(MFULL, D, gridDim.x, lbid());
      pg8::gemm_phase((PG8_LAS unsigned char*)lds, g, So, pg8::EpiBr{(f16*)(a.ws + WS_G3), (f16*)(a.ws + WS_G3B), P, (f16*)(a.ws + WS_MRG)});
      tail_gemm((const f16*)(a.ws + WS_Y), 3072, (const f16*)(a.ws + WS_WBR), BR, MFULL, M - MFULL, D, BR, lds, EpiBranchMerge{(f16*)(a.ws + WS_MRG), (const f16*)(a.ws + WS_G3B), P}); }
    GRID_SYNC();
    { pg8::Gemm g{(const f16*)(a.ws + WS_MRG), (const f16*)(a.ws + WS_WOUT), D, D, D, 1 << 20, 0}; pg8::StaticOrder So; So.init(MFULL, D, gridDim.x, lbid());
      pg8::gemm_phase((PG8_LAS unsigned char*)lds, g, So, pg8::EpiZ{a, l});
      tail_gemm((const f16*)(a.ws + WS_MRG), D, (const f16*)(a.ws + WS_WOUT), D, MFULL, M - MFULL, D, D, lds, EpiOut{a, l}); }
    GRID_SYNC();
  }
  ph_final(a);
}

extern "C" void kernel_launch(void* const* d_in, const int* in_sizes, int n_in, void* d_out, int out_size, void* d_ws, size_t ws_size, hipStream_t stream) {
  static int grid_blocks = 0;
  if (grid_blocks == 0) {
    if (n_in != 25 || out_size != BATCH * SEQ * D || ws_size < WS_END) { fprintf(stderr, "kernel_launch: bad shapes n_in %d out %d ws %zu (need %zu)\n", n_in, out_size, ws_size, (size_t)WS_END); grid_blocks = -1; return; }
    if (hipFuncSetAttribute((const void*)mega, hipFuncAttributeMaxDynamicSharedMemorySize, LDS_BYTES) != hipSuccess) { fprintf(stderr, "kernel_launch: LDS attribute failed\n"); grid_blocks = -1; return; }
    int dev = 0, cus = 0, per_cu = 0;
    hipGetDevice(&dev); hipDeviceGetAttribute(&cus, hipDeviceAttributeMultiprocessorCount, dev);
    if (hipOccupancyMaxActiveBlocksPerMultiprocessor(&per_cu, (const void*)mega, NT, LDS_BYTES) != hipSuccess || per_cu < 1) { fprintf(stderr, "kernel_launch: occupancy query says %d\n", per_cu); (void)hipGetLastError(); per_cu = 1; }
    grid_blocks = cus * 1;
    fprintf(stderr, "kernel_launch: cus %d per_cu %d grid %d\n", cus, per_cu, grid_blocks);
  }
  if (grid_blocks < 0) return;
  (void)hipMemsetAsync((char*)d_ws + WS_CTL, 0, 65536, stream);
  Args a{};
  for (int i = 0; i < 25; ++i) a.in[i] = (const float*)d_in[i];
  a.out = (float*)d_out; a.ws = (unsigned char*)d_ws;
  hipLaunchKernelGGL(mega, dim3(grid_blocks), dim3(NT), LDS_BYTES, stream, a);
  const hipError_t e = hipPeekAtLastError();
  if (e != hipSuccess) fprintf(stderr, "launch failed: %s (grid %d)\n", hipGetErrorString(e), grid_blocks);
}
```

```cpp
#include <hip/hip_runtime.h>
#include <hip/hip_cooperative_groups.h>
#include <cstdio>
#include <cstdint>

constexpr int D = 2048, BATCH = 2, SEQ = 4096, NCTX = 256, L = NCTX + SEQ, M = BATCH * L, DEPTH = 2;
constexpr int NIN = 17168, NP = 17152;
constexpr int BR = 1024;
constexpr int C_R = 0, C_K = 1024, C_V = 2048, C_WD = 3072, C_AD = 3200, C_RWG = 3328, C_ATQ = 4352, C_ATK = 5376, C_ATV = 5632,
              C_ATG = 5888, C_MLQ = 6912, C_MLK = 7424, C_MLV = 7936, C_MLO = 8960, C_MLG = 9984, C_MRG = 11008;
constexpr int GATE_COL = 9984;
constexpr int SIV = 9 * 64;
constexpr int SIR = 912;

namespace cg = cooperative_groups;
typedef _Float16 f16;
typedef _Float16 f16x8 __attribute__((ext_vector_type(8)));
typedef _Float16 f16x4 __attribute__((ext_vector_type(4)));
typedef _Float16 f16x2 __attribute__((ext_vector_type(2)));
typedef float f32x4 __attribute__((ext_vector_type(4)));
typedef float f32x2 __attribute__((ext_vector_type(2)));
typedef unsigned u32x4 __attribute__((ext_vector_type(4)));

constexpr size_t MiB = 1u << 20;
constexpr size_t al(size_t x) { return (x + 255) / 256 * 256; }
constexpr size_t WS_CTL = 0;
constexpr size_t WS_MODV = 1 * MiB;
constexpr size_t WS_WIN = WS_MODV + al((size_t)2 * 3 * 6144 * 4);
constexpr size_t WS_WBR = WS_WIN + al((size_t)NP * D * 2);
constexpr size_t WS_WOUT = WS_WBR + al((size_t)3 * D * BR * 2);
constexpr size_t WS_H = WS_WOUT + al((size_t)D * D * 2);
constexpr size_t WS_QN = WS_H;
constexpr size_t WS_KN = WS_QN + al((size_t)M * 1024 * 2);
constexpr size_t WS_GPRE = WS_H + al((size_t)M * D * 2);
constexpr size_t WS_RKD = WS_GPRE + al((size_t)M * 16 * 4);
constexpr size_t WS_P = WS_RKD + al((size_t)M * 16 * 4);
constexpr size_t WS_SI = WS_P + al((size_t)M * NP * 2);
constexpr size_t WS_G3 = WS_SI;
constexpr size_t WS_MRG = WS_G3 + al((size_t)3 * M * D * 2);
constexpr size_t WS_YRW = WS_SI + al((size_t)BATCH * 16 * L * SIV * 4);
constexpr size_t WS_AO = WS_YRW + al((size_t)2 * M * 1024 * 4);
constexpr size_t WS_HM = WS_AO + al((size_t)M * 1024 * 4);
constexpr size_t WS_Y = WS_HM + al((size_t)2 * M * 1024 * 4);
constexpr size_t WS_Z = WS_Y + al((size_t)M * 3072 * 2);
constexpr size_t WS_G3B = WS_Z + al((size_t)M * D * 4);
constexpr size_t WS_END = WS_G3B + al((size_t)2 * M * D * 2);
static_assert(WS_MRG + (size_t)M * D * 2 <= WS_YRW, "G3|MERGED overlay fits in SI");
static_assert(WS_KN + (size_t)M * 512 * 2 <= WS_GPRE, "QN|KN overlay fits in H");

#ifndef PROBE_PHASE
#define PROBE_PHASE 0
#endif
constexpr int NT = 512;
constexpr int LDS_BYTES = 152 * 1024;

struct Args { const float* in[25]; float* out; unsigned char* ws; int ph_lo, ph_hi; };

__device__ __forceinline__ int ltid() { int t = threadIdx.x; asm volatile("" : "+v"(t)); return t; }
__device__ __forceinline__ int lbid() { int t = blockIdx.x; asm volatile("" : "+s"(t)); return t; }
__device__ __forceinline__ float wave_sum(float v) {
#pragma unroll
  for (int o = 32; o >= 1; o >>= 1) v += __shfl_xor(v, o);
  return v;
}
template <int CTRL> __device__ __forceinline__ float dppf(float x) { return __int_as_float(__builtin_amdgcn_update_dpp(0, __float_as_int(x), CTRL, 0xF, 0xF, true)); }
__device__ __forceinline__ float red16(float x) { x += dppf<0xB1>(x); x += dppf<0x4E>(x); x += dppf<0x141>(x); x += dppf<0x140>(x); return x; }
template <int CTRL> __device__ __forceinline__ float dppx(float x) { return __int_as_float(__builtin_amdgcn_update_dpp(0, __float_as_int(x), CTRL, 0xF, 0xF, true)); }
__device__ __forceinline__ float wsum_fast(float x) { x += dppx<0xB1>(x); x += dppx<0x4E>(x); x += dppx<0x141>(x); x += dppx<0x140>(x); x += __shfl_xor(x, 16); x += __shfl_xor(x, 32); return x; }

__device__ __forceinline__ float wave_max(float v) {
#pragma unroll
  for (int o = 32; o >= 1; o >>= 1) v = fmaxf(v, __shfl_xor(v, o));
  return v;
}
__device__ __forceinline__ float sigm_f(float x) { return __builtin_amdgcn_rcpf(1.f + __expf(-x)); }
__device__ __forceinline__ float silu_f(float x) { return x * sigm_f(x); }
__device__ __forceinline__ float tanh_f(float x) { const float t = __expf(-2.f * fabsf(x)); return copysignf((1.f - t) * __builtin_amdgcn_rcpf(1.f + t), x); }
__device__ __forceinline__ float softplus_f(float x) { return x > 20.f ? x : log1pf(expf(x)); }
__device__ __forceinline__ unsigned pkh(float lo, float hi) { f32x2 v = {lo, hi}; f16x2 h = __builtin_convertvector(v, f16x2); return __builtin_bit_cast(unsigned, h); }

__device__ __forceinline__ const float* zrow(const Args& a, int l, int m) {
  if (l > 0) return (const float*)(a.ws + WS_Z) + (size_t)m * D;
  const int b = m / L, t = m % L;
  return t < NCTX ? a.in[2] + ((size_t)b * NCTX + t) * D : a.in[0] + ((size_t)b * SEQ + (t - NCTX)) * D;
}

__device__ __forceinline__ void ph_modv(const Args& a, unsigned char* lds) {
  const int tid = ltid(), lane = tid & 63, wave = tid >> 6;
  float* sv = (float*)lds;
  float* red = sv + 3 * 2048;
  float* modv = (float*)(a.ws + WS_MODV);
  for (int i = tid; i < 3 * 2048; i += NT) { const int w = i / 2048, k = i % 2048; sv[i] = silu_f(w < 2 ? a.in[1][w * 2048 + k] : a.in[3][k]); }
  __syncthreads();
  for (int u = lbid(); u < 192; u += gridDim.x) {
    const int l = u / 96, j0 = (u % 96) * 64;
    const float* w = a.in[5] + (size_t)l * 2048 * 6144 + j0 + lane;
    float a0 = 0.f, a1 = 0.f, a2 = 0.f;
    for (int k = wave * 256; k < wave * 256 + 256; ++k) { const float wv = w[(size_t)k * 6144]; a0 += sv[k] * wv; a1 += sv[2048 + k] * wv; a2 += sv[4096 + k] * wv; }
    red[(wave * 3 + 0) * 64 + lane] = a0; red[(wave * 3 + 1) * 64 + lane] = a1; red[(wave * 3 + 2) * 64 + lane] = a2;
    __syncthreads();
    if (tid < 192) { const int i = tid >> 6; float s = a.in[6][l * 6144 + j0 + lane];
      for (int w8 = 0; w8 < 8; ++w8) s += red[(w8 * 3 + i) * 64 + lane];
      modv[(size_t)(l * 3 + i) * 6144 + j0 + lane] = s; }
    __syncthreads();
  }
}

__device__ __forceinline__ void transpose_item(const float* W, int ldw, int ncol0, int k0, f16* WT, int K, int row0, float* scr, int lane) {
#pragma unroll 8
  for (int i = 0; i < 32; ++i) { const int kk = 2 * i + (lane >> 5); scr[kk * 33 + (lane & 31)] = W[(size_t)(k0 + kk) * ldw + ncol0 + (lane & 31)]; }
  asm volatile("s_waitcnt lgkmcnt(0)" ::: "memory");
  const int c = lane & 7;
#pragma unroll
  for (int j = 0; j < 4; ++j) { const int n = (lane >> 3) + 8 * j; const float* s = scr + (8 * c) * 33 + n;
    u32x4 o; o.x = pkh(s[0 * 33], s[1 * 33]); o.y = pkh(s[2 * 33], s[3 * 33]); o.z = pkh(s[4 * 33], s[5 * 33]); o.w = pkh(s[6 * 33], s[7 * 33]);
    *(u32x4*)(WT + (size_t)(row0 + n) * K + k0 + 8 * c) = o; }
  asm volatile("s_waitcnt lgkmcnt(0)" ::: "memory");
}
__device__ __forceinline__ void ph_convert(const Args& a, int l, unsigned char* lds, int part = 3, int b0 = 0, int nb = 0) {
  const int tid = ltid(), lane = tid & 63, wave = tid >> 6;
  float* scr = (float*)lds + wave * (64 * 33);
  if (nb == 0) nb = gridDim.x;
  const int gw = (lbid() - b0) * 8 + wave, NGW = nb * 8;
  constexpr int I_IN = (D / 64) * (NP / 32), I_BR = (BR / 64) * (D / 32), I_OUT = (D / 64) * (D / 32);
  f16* WIN = (f16*)(a.ws + WS_WIN); f16* WBR = (f16*)(a.ws + WS_WBR); f16* WOUT = (f16*)(a.ws + WS_WOUT);
  for (int it = gw + ((part & 1) ? 0 : I_IN); it < ((part & 2) ? I_IN + 3 * I_BR + I_OUT : I_IN); it += NGW) {
    int r = it;
    if (r < I_IN) { const int nblk = NP / 32, kb = r / nblk, nb = r % nblk, n0 = nb * 32;
      transpose_item(a.in[7] + (size_t)l * D * NIN, NIN, n0 + (n0 >= GATE_COL ? 16 : 0), kb * 64, WIN, D, n0, scr, lane); continue; }
    r -= I_IN;
    if (r < 3 * I_BR) { const int br = r / I_BR, q = r % I_BR, nblk = D / 32, kb = q / nblk, nb = q % nblk;
      transpose_item(a.in[22] + ((size_t)l * 3 + br) * BR * D, D, nb * 32, kb * 64, WBR, BR, br * D + nb * 32, scr, lane); continue; }
    r -= 3 * I_BR;
    { const int nblk = D / 32, kb = r / nblk, nb = r % nblk;
      transpose_item(a.in[23] + (size_t)l * D * D, D, nb * 32, kb * 64, WOUT, D, nb * 32, scr, lane); }
  }
}

__device__ __forceinline__ void ph_norm(const Args& a, int l, unsigned char* lds) {
  const int tid = ltid(), lane = tid & 63, wave = tid >> 6;
  const int gw = lbid() * 8 + wave, NGW = gridDim.x * 8;
  float* wg = (float*)lds;
  { const float* w = a.in[7] + (size_t)l * D * NIN + GATE_COL;
    for (int i = tid; i < 2048 * 4; i += NT) { const int k = i >> 2, q = i & 3; const f32x4 v = *(const f32x4*)(w + (size_t)k * NIN + q * 4);
      wg[(q * 4 + 0) * 2048 + k] = v.x; wg[(q * 4 + 1) * 2048 + k] = v.y; wg[(q * 4 + 2) * 2048 + k] = v.z; wg[(q * 4 + 3) * 2048 + k] = v.w; } }
  __syncthreads();
  const float* modv = (const float*)(a.ws + WS_MODV) + (size_t)l * 3 * 6144;
  const float* ng = a.in[4] + l * D;
  f16* H = (f16*)(a.ws + WS_H); float* GP = (float*)(a.ws + WS_GPRE);
  f32x4 Gv[8], Sv[8]; int kcur = -1;
  for (int m = gw; m < M; m += NGW) {
    const int b = m / L, t = m % L; const float* zr = zrow(a, l, m);
    const int kind = __builtin_amdgcn_readfirstlane(t < NCTX ? 2 : b);
    if (kind != kcur) { kcur = kind; const float* mv = modv + (size_t)kind * 6144;
#pragma unroll
      for (int j = 0; j < 8; ++j) { const int k = 4 * (lane + 64 * j); Gv[j] = *(const f32x4*)(ng + k) * (1.f + *(const f32x4*)(mv + 2048 + k)); Sv[j] = *(const f32x4*)(mv + k); } }
    f32x4 v[8]; float ss = 0.f;
#pragma unroll
    for (int j = 0; j < 8; ++j) { v[j] = *(const f32x4*)(zr + 4 * (lane + 64 * j)); ss += v[j].x * v[j].x + v[j].y * v[j].y + v[j].z * v[j].z + v[j].w * v[j].w; }
    const float rstd = rsqrtf(wave_sum(ss) * (1.f / D) + 1e-6f);
#pragma unroll
    for (int j = 0; j < 8; ++j) { const int k = 4 * (lane + 64 * j);
      v[j] = (v[j] * rstd) * Gv[j] + Sv[j];
      uint2 o; o.x = pkh(v[j].x, v[j].y); o.y = pkh(v[j].z, v[j].w); *(uint2*)(H + (size_t)m * D + k) = o; }
    float p[16];
#pragma unroll
    for (int g = 0; g < 16; ++g) { float pp = 0.f;
#pragma unroll
      for (int j = 0; j < 8; ++j) { const f32x4 w = *(const f32x4*)(wg + g * 2048 + 4 * (lane + 64 * j)); pp += v[j].x * w.x + v[j].y * w.y + v[j].z * w.z + v[j].w * w.w; }
      p[g] = pp; if ((g & 1) == 1) __builtin_amdgcn_sched_barrier(0); }
    const bool b3 = lane & 8, b2 = lane & 4, b1 = lane & 2, b0 = lane & 1;
#define NRM_DPP(x_, ctrl_) __int_as_float(__builtin_amdgcn_update_dpp(0, __float_as_int(x_), ctrl_, 0xF, 0xF, true))
    float q8[8], q4[4], q2[2];
#pragma unroll
    for (int g = 0; g < 8; ++g) { const float keep = b3 ? p[g + 8] : p[g], send = b3 ? p[g] : p[g + 8]; q8[g] = keep + NRM_DPP(send, 0x128); }
#pragma unroll
    for (int g = 0; g < 4; ++g) { const float keep = b2 ? q8[g + 4] : q8[g], send = b2 ? q8[g] : q8[g + 4]; q4[g] = keep + NRM_DPP(send, 0x141); }
#pragma unroll
    for (int g = 0; g < 2; ++g) { const float keep = b1 ? q4[g + 2] : q4[g], send = b1 ? q4[g] : q4[g + 2]; q2[g] = keep + NRM_DPP(send, 0x4E); }
    float gsum = (b0 ? q2[1] : q2[0]) + NRM_DPP((b0 ? q2[0] : q2[1]), 0xB1);
#undef NRM_DPP
    gsum += __shfl_xor(gsum, 16); gsum += __shfl_xor(gsum, 32);
    if (lane < 16) GP[(size_t)m * 16 + lane] = gsum;
  }
}

template <class Epi>
__device__ __forceinline__ void tail_gemm(const f16* A, int lda, const f16* Bt, int ldb, int m0, int Mrows, int Ncols, int K, unsigned char* lds, const Epi& epi) {
  const int tid = ltid(), lane = tid & 63, wave = __builtin_amdgcn_readfirstlane(tid >> 6), fr = lane & 15, fq = lane >> 4;
  const int ntn = Ncols / 64, nun = (Mrows / 64) * ntn, KW = K / 8;
  float* part = (float*)lds;
  for (int u = lbid(); u < nun; u += (int)gridDim.x) {
    const int tm = u / ntn, tn = u % ntn;
    f32x4 acc[4][4];
#pragma unroll
    for (int i = 0; i < 4; ++i)
#pragma unroll
      for (int j = 0; j < 4; ++j) acc[i][j] = (f32x4){0.f, 0.f, 0.f, 0.f};
    const f16* ap = A + (size_t)(m0 + tm * 64 + fr) * lda + wave * KW + fq * 8; const f16* bp = Bt + (size_t)(tn * 64 + fr) * ldb + wave * KW + fq * 8;
    for (int k0 = 0; k0 < KW; k0 += 64) {
      f16x8 af[4], bf[4], an[4], bn[4];
#pragma unroll
      for (int i = 0; i < 4; ++i) { af[i] = *(const f16x8*)(ap + (size_t)i * 16 * lda + k0); bf[i] = *(const f16x8*)(bp + (size_t)i * 16 * ldb + k0);
                                    an[i] = *(const f16x8*)(ap + (size_t)i * 16 * lda + k0 + 32); bn[i] = *(const f16x8*)(bp + (size_t)i * 16 * ldb + k0 + 32); }
#pragma unroll
      for (int i = 0; i < 4; ++i)
#pragma unroll
        for (int j = 0; j < 4; ++j) { acc[i][j] = __builtin_amdgcn_mfma_f32_16x16x32_f16(af[i], bf[j], acc[i][j], 0, 0, 0); acc[i][j] = __builtin_amdgcn_mfma_f32_16x16x32_f16(an[i], bn[j], acc[i][j], 0, 0, 0); }
    }
    __syncthreads();
#pragma unroll
    for (int i = 0; i < 4; ++i)
#pragma unroll
      for (int j = 0; j < 4; ++j)
#pragma unroll
        for (int r = 0; r < 4; ++r) part[((wave * 16 + i * 4 + j) * 4 + r) * 64 + lane] = acc[i][j][r];
    __syncthreads();
#pragma unroll
    for (int q = 0; q < 2; ++q) { const int f = 2 * wave + q, i = f >> 2, j = f & 3;
#pragma unroll
      for (int r = 0; r < 4; ++r) { float v = 0.f;
#pragma unroll
        for (int w8 = 0; w8 < 8; ++w8) v += part[((w8 * 16 + f) * 4 + r) * 64 + lane];
        epi(m0 + tm * 64 + i * 16 + fq * 4 + r, tn * 64 + j * 16 + fr, v); } }
  }
}
struct EpiBranch { f16* O; const f16* P; int br; __device__ __forceinline__ void operator()(int m, int n, float v) const {
  const float g = sigm_f((float)P[(size_t)m * NP + C_MRG + br * D + n]); O[(size_t)m * D + n] = (f16)(g * v); } };
struct EpiBranchMerge { f16* MRG; const f16* G3b; const f16* P; __device__ __forceinline__ void operator()(int m, int n, float v) const {
  const float g = sigm_f((float)P[(size_t)m * NP + C_MRG + n]); MRG[(size_t)m * D + n] = (f16)(g * v + (float)G3b[(size_t)m * D + n] + (float)G3b[(size_t)M * D + (size_t)m * D + n]); } };
struct EpiOut { Args a; int l; __device__ __forceinline__ void operator()(int m, int n, float v) const {
  const int b = m / L, t = m % L; const float gt = ((const float*)(a.ws + WS_MODV))[(size_t)(l * 3 + (t < NCTX ? 2 : b)) * 6144 + 4096 + n];
  ((float*)(a.ws + WS_Z))[(size_t)m * D + n] = zrow(a, l, m)[n] + gt * v; } };


namespace pg8 {
#define PG8_LAS __attribute__((address_space(3)))
constexpr int BM = 256, BK = 64, HALF = 128, HTB = HALF * BK * 2  , STAGE_BYTES = 8 * HTB, NXCD = 8, WGM = 8;
__host__ __device__ __forceinline__ int lds_byte(int r, int c) { const int st = (r >> 4) * 2 + (c >> 5), rr = r & 15, cc = c & 31, ob = rr * 64 + cc * 2; return st * 1024 + (ob ^ (((ob >> 9) & 1) << 5)); }
__host__ __device__ __forceinline__ void stage_rc(int b, int& R, int& C) { const int st = b / 1024, sb = b % 1024, swz = sb ^ (((sb >> 9) & 1) << 5); R = (st >> 1) * 16 + swz / 64; C = (st & 1) * 32 + (swz % 64) / 2; }
__host__ __device__ __forceinline__ int perm32(int rho) { const int n = rho >> 4, i = rho & 15; return 8 * (i >> 2) + 4 * n + (i & 3); }
struct Unit { int pm, pn; };
struct Gemm { const f16* A; const f16* Bt; int lda, ldb, K, pn_grp, a_grp_cols; };
struct StaticOrder {
    int nM, nN, nwg, G, c, pn_off;
    __device__ void init(int M_, int N_, int G_, int c_, int pn_off_ = 0) { nM = M_ / BM; nN = N_ / BM; nwg = nM * nN; G = G_; c = c_; pn_off = pn_off_; }
    __device__ bool next(int i, Unit& u) const {
        const long Lx = (long)i * G + c; if (Lx >= nwg) return false;
        int wgid = (int)Lx; { const int q = nwg / NXCD, r = nwg % NXCD, xcd = wgid % NXCD, off = wgid / NXCD; wgid = (xcd < r ? xcd * (q + 1) : r * (q + 1) + (xcd - r) * q) + off; }
        const int nig = WGM * nN, gid = wgid / nig, fm = gid * WGM, gsz = (nM - fm) < WGM ? (nM - fm) : WGM;
        u.pm = fm + ((wgid % nig) % gsz); u.pn = pn_off + (wgid % nig) / gsz; return true;
    }
};
template <class Epi>
__device__ __forceinline__ void gemm_phase(PG8_LAS unsigned char* lds, const Gemm g, const StaticOrder& S, const Epi& E) {
    const int tid = ltid(), wid = __builtin_amdgcn_readfirstlane(tid >> 6), lane = tid & 63, wr = wid >> 2, wc = wid & 3, fr = lane & 15, fq = lane >> 4;
    const int K = g.K, nt = K / BK;
    unsigned voffA[2], voffB[2];
#pragma unroll
    for (int i = 0; i < 2; ++i) { int R, C; stage_rc(tid * 16 + i * 8192, R, C); const int Rb = Epi::PERM ? ((R & ~31) + perm32(R & 31)) : R;
        voffA[i] = (unsigned)(R * g.lda + C) * 2u; voffB[i] = (unsigned)(Rb * g.ldb + C) * 2u; }
    const size_t kstep = (size_t)(BK * 2);
    const size_t hstepA = (size_t)HALF * g.lda * 2, hstepB = (size_t)HALF * g.ldb * 2;
    const size_t tstepA = 2 * hstepA, tstepB = 2 * hstepB;
    const unsigned ldsw = (unsigned)wid * 1024u;
    const int aoff = lds_byte(wr * 64 + fr, fq * 8), boff = lds_byte(wc * 32 + fr, fq * 8);
#define PG8_SA(b, h) (((b) * 2 + (h)) * HTB)
#define PG8_SB(b, h) ((4 + (b) * 2 + (h)) * HTB)
#define PG8_STAGE(bufoff, gbase, voff) do { _Pragma("unroll") for (int _i = 0; _i < 2; ++_i) \
        __builtin_amdgcn_global_load_lds((const unsigned*)((const char*)(gbase) + (voff)[_i]), (PG8_LAS unsigned*)(lds + (bufoff) + ldsw + _i * 8192), 16, 0, 0); } while (0)
#define PG8_LDA(dst, b, h) do { _Pragma("unroll") for (int m = 0; m < 4; ++m) _Pragma("unroll") for (int k = 0; k < 2; ++k) dst[m][k] = *(const PG8_LAS f16x8*)(lds + PG8_SA(b, h) + aoff + m * 2048 + k * 1024); } while (0)
#define PG8_LDB(dst, b, h) do { _Pragma("unroll") for (int n = 0; n < 2; ++n) _Pragma("unroll") for (int k = 0; k < 2; ++k) dst[n][k] = *(const PG8_LAS f16x8*)(lds + PG8_SB(b, h) + boff + n * 2048 + k * 1024); } while (0)
#define PG8_MMA(ai, bj, At, Bt) do { __builtin_amdgcn_s_setprio(1); _Pragma("unroll") for (int m = 0; m < 4; ++m) _Pragma("unroll") for (int n = 0; n < 2; ++n) _Pragma("unroll") for (int k = 0; k < 2; ++k) \
        acc[ai][bj][m][n] = __builtin_amdgcn_mfma_f32_16x16x32_f16(Bt[n][k], At[m][k], acc[ai][bj][m][n], 0, 0, 0); __builtin_amdgcn_s_setprio(0); } while (0)
#define PG8_WAIT_V(n) asm volatile("s_waitcnt vmcnt(" #n ")" ::: "memory")
#define PG8_WAIT_L(n) asm volatile("s_waitcnt lgkmcnt(" #n ")" ::: "memory")
#define PG8_BAR __builtin_amdgcn_s_barrier()
#define PG8_SCHED __builtin_amdgcn_sched_barrier(0)
#define PG8_UA(u) ((const char*)g.A + (size_t)(u).pm * tstepA + (size_t)((u).pn / g.pn_grp) * g.a_grp_cols * 2)
#define PG8_UB(u) ((const char*)g.Bt + (size_t)(u).pn * tstepB)
    Unit cur, nxt; int ui = 0;
    if (!S.next(0, cur)) return;
    f32x4 acc[2][2][4][2];
#pragma unroll
    for (int a = 0; a < 2; ++a)
#pragma unroll
        for (int b = 0; b < 2; ++b)
#pragma unroll
            for (int m = 0; m < 4; ++m)
#pragma unroll
                for (int n = 0; n < 2; ++n) acc[a][b][m][n] = (f32x4){0.f, 0.f, 0.f, 0.f};
    f16x8 At[4][2], B0[2][2], B1[2][2];
    const char* cA = PG8_UA(cur); const char* cB = PG8_UB(cur);
    PG8_STAGE(PG8_SB(0, 0), cB, voffB); PG8_STAGE(PG8_SB(0, 1), cB + hstepB, voffB); PG8_STAGE(PG8_SA(0, 0), cA, voffA); PG8_STAGE(PG8_SA(0, 1), cA + hstepA, voffA);
    if (wr == 1) PG8_BAR;
    PG8_WAIT_V(2); PG8_BAR;
    PG8_STAGE(PG8_SB(1, 0), cB + kstep, voffB); PG8_STAGE(PG8_SA(1, 0), cA + kstep, voffA); PG8_STAGE(PG8_SB(1, 1), cB + hstepB + kstep, voffB);
    PG8_WAIT_V(6); PG8_BAR;
    for (;;) {
        const bool has_next = S.next(ui + 1, nxt);
        const char* nA = has_next ? PG8_UA(nxt) : cA; const char* nB = has_next ? PG8_UB(nxt) : cB;
        for (int t = 0; t < nt; t += 2) {
            const bool last = (t == nt - 2);
            const char* a1 = cA + (size_t)(t + 1) * kstep;
            const char* a2 = last ? nA : cA + (size_t)(t + 2) * kstep; const char* b2 = last ? nB : cB + (size_t)(t + 2) * kstep;
            const char* a3 = a2 + kstep; const char* b3 = b2 + kstep;
            PG8_LDB(B0, 0, 0); PG8_LDB(B1, 0, 1); PG8_SCHED; PG8_LDA(At, 0, 0); PG8_STAGE(PG8_SA(1, 1), a1 + hstepA, voffA);
            PG8_WAIT_V(8); PG8_WAIT_L(0); PG8_BAR; PG8_MMA(0, 0, At, B0); PG8_MMA(0, 1, At, B1); PG8_BAR; PG8_SCHED;
            PG8_LDA(At, 0, 1); PG8_STAGE(PG8_SB(0, 0), b2, voffB); PG8_STAGE(PG8_SB(0, 1), b2 + hstepB, voffB); PG8_STAGE(PG8_SA(0, 0), a2, voffA);
            PG8_WAIT_V(8); PG8_WAIT_L(0); PG8_BAR; PG8_MMA(1, 0, At, B0); PG8_MMA(1, 1, At, B1); PG8_BAR; PG8_SCHED;
            PG8_LDB(B0, 1, 0); PG8_LDB(B1, 1, 1); PG8_SCHED; PG8_LDA(At, 1, 0); PG8_STAGE(PG8_SA(0, 1), a2 + hstepA, voffA);
            PG8_WAIT_V(8); PG8_WAIT_L(0); PG8_BAR; PG8_MMA(0, 0, At, B0); PG8_MMA(0, 1, At, B1); PG8_BAR; PG8_SCHED;
            PG8_LDA(At, 1, 1); PG8_STAGE(PG8_SB(1, 0), b3, voffB); PG8_STAGE(PG8_SB(1, 1), b3 + hstepB, voffB); PG8_STAGE(PG8_SA(1, 0), a3, voffA);
            PG8_WAIT_V(8); PG8_WAIT_L(0); PG8_BAR; PG8_MMA(1, 0, At, B0); PG8_MMA(1, 1, At, B1); PG8_BAR; PG8_SCHED;
        }
        if (wr == 0) PG8_BAR;
        E(acc, cur, wr, wc, fr, fq);
        if (!has_next) break;
#pragma unroll
        for (int a = 0; a < 2; ++a)
#pragma unroll
            for (int b = 0; b < 2; ++b)
#pragma unroll
                for (int m = 0; m < 4; ++m)
#pragma unroll
                    for (int n = 0; n < 2; ++n) acc[a][b][m][n] = (f32x4){0.f, 0.f, 0.f, 0.f};
        cur = nxt; cA = nA; cB = nB; ++ui;
        if (wr == 1) PG8_BAR;
    }
    PG8_WAIT_V(0);
    PG8_BAR;
#undef PG8_SA
#undef PG8_SB
#undef PG8_STAGE
#undef PG8_LDA
#undef PG8_LDB
#undef PG8_MMA
#undef PG8_WAIT_V
#undef PG8_WAIT_L
#undef PG8_BAR
#undef PG8_SCHED
#undef PG8_UA
#undef PG8_UB
}
struct EpiP { static constexpr bool PERM = true; f16* O; int coff;
    __device__ __forceinline__ void operator()(const f32x4 (&acc)[2][2][4][2], const Unit& u, int wr, int wc, int fr, int fq) const {
        const int row0 = u.pm * BM + wr * 64 + fr, col0 = coff + u.pn * BM + wc * 32 + 8 * fq;
#pragma unroll
        for (int ai = 0; ai < 2; ++ai)
#pragma unroll
            for (int m = 0; m < 4; ++m) { f16* rowp = O + (size_t)(row0 + ai * HALF + m * 16) * NP + col0;
#pragma unroll
                for (int bj = 0; bj < 2; ++bj) { const f32x4 v0 = acc[ai][bj][m][0], v1 = acc[ai][bj][m][1];
                    u32x4 w; w.x = pkh(v0[0], v0[1]); w.y = pkh(v0[2], v0[3]); w.z = pkh(v1[0], v1[1]); w.w = pkh(v1[2], v1[3]);
                    *(u32x4*)(rowp + bj * HALF) = w; } }
    }
};
struct EpiBr { static constexpr bool PERM = true; f16* G3; f16* G3b; const f16* P; f16* MRG;
    __device__ __forceinline__ void operator()(const f32x4 (&acc)[2][2][4][2], const Unit& u, int wr, int wc, int fr, int fq) const {
        const int row0 = u.pm * BM + wr * 64 + fr, colg = u.pn * BM + wc * 32 + 8 * fq, br = u.pn >> 3, col0 = colg - br * D;
        f16* Ob = MRG ? MRG : G3b + (size_t)(br - 1) * M * D;
#pragma unroll
        for (int ai = 0; ai < 2; ++ai)
#pragma unroll
            for (int m = 0; m < 4; ++m) { const int row = row0 + ai * HALF + m * 16;
#pragma unroll
                for (int bj = 0; bj < 2; ++bj) { const f32x4 v0 = acc[ai][bj][m][0], v1 = acc[ai][bj][m][1];
                    const f16x8 gp = *(const f16x8*)(P + (size_t)row * NP + C_MRG + colg + bj * HALF);
                    float o[8];
#pragma unroll
                    for (int e = 0; e < 8; ++e) o[e] = (e < 4 ? v0[e] : v1[e - 4]) * __builtin_amdgcn_rcpf(1.f + __expf(-(float)gp[e]));
                    if (MRG) { const f16x8 x1 = *(const f16x8*)(G3b + (size_t)row * D + col0 + bj * HALF), x2 = *(const f16x8*)(G3b + (size_t)M * D + (size_t)row * D + col0 + bj * HALF);
#pragma unroll
                        for (int e = 0; e < 8; ++e) o[e] += (float)x1[e] + (float)x2[e]; }
                    u32x4 w; w.x = pkh(o[0], o[1]); w.y = pkh(o[2], o[3]); w.z = pkh(o[4], o[5]); w.w = pkh(o[6], o[7]);
                    *(u32x4*)(Ob + (size_t)row * D + col0 + bj * HALF) = w; } }
    }
};
struct EpiZ { static constexpr bool PERM = false; Args a; int l;
    __device__ __forceinline__ void operator()(const f32x4 (&acc)[2][2][4][2], const Unit& u, int wr, int wc, int fr, int fq) const {
        const int row0 = u.pm * BM + wr * 64 + fr, col0 = u.pn * BM + wc * 32 + 4 * fq;
        float* Z = (float*)(a.ws + WS_Z); const float* modv = (const float*)(a.ws + WS_MODV) + (size_t)l * 3 * 6144 + 4096;
#pragma unroll
        for (int ai = 0; ai < 2; ++ai)
#pragma unroll
            for (int m = 0; m < 4; ++m) { const int row = row0 + ai * HALF + m * 16; const int b = row / L, t = row % L;
                const float* zr = zrow(a, l, row); const float* gt = modv + (size_t)(t < NCTX ? 2 : b) * 6144;
#pragma unroll
                for (int bj = 0; bj < 2; ++bj)
#pragma unroll
                    for (int n = 0; n < 2; ++n) { const int c = col0 + bj * HALF + n * 16;
                        const f32x4 zo = *(const f32x4*)(zr + c), gv = *(const f32x4*)(gt + c);
                        *(f32x4*)(Z + (size_t)row * D + c) = zo + gv * acc[ai][bj][m][n]; } }
    }
};
}

__device__ __forceinline__ float shifted(const f16* P, const float* mu, int m, int col) {
  const int t = m % L; const float s = (float)P[(size_t)m * NP + col];
  const float pv = (t == 0 || t == NCTX) ? 0.f : (float)P[(size_t)(m - 1) * NP + col];
  const float nx = (t == L - 1 || t == NCTX - 1) ? 0.f : (float)P[(size_t)(m + 1) * NP + col];
  return s + mu[col] * (pv - s) + mu[3328 + col] * (nx - s);
}
namespace pp {
constexpr int WTP = 72, RAWP = 456, XAP = 72;
constexpr int OFF_WT = 0, OFF_RAW = OFF_WT + 4 * 64 * WTP * 2, OFF_XA = OFF_RAW + 34 * RAWP * 2, OFF_SH = OFF_XA + 4 * 32 * XAP * 2, OFF_NR = OFF_SH + 3 * 32 * 64 * 4, OFF_CST = OFF_NR + 256, OFF_END = OFF_CST + 1344 * 4;
static_assert(OFF_END <= LDS_BYTES, "prep LDS");
}
__device__ __forceinline__ void ph_prep(const Args& a, int l, unsigned char* lds, int part = 3, int b0 = 0, int nb = 0) {
  using namespace pp;
  const int tid = ltid(), lane = tid & 63, wave = __builtin_amdgcn_readfirstlane(tid >> 6), fr = lane & 15, fq = lane >> 4;
  const f16* P = (const f16*)(a.ws + WS_P);
  const float* mu = a.in[8] + (size_t)l * 2 * 3328;
  f16* WT = (f16*)(lds + OFF_WT); f16* RAW = (f16*)(lds + OFF_RAW); f16* XA = (f16*)(lds + OFF_XA); float* SH = (float*)(lds + OFF_SH); float* NRI = (float*)(lds + OFF_NR); float* CST = (float*)(lds + OFF_CST);
  float* RKD = (float*)(a.ws + WS_RKD);
  int cur_h = -1;
  const int NU = 272 * 16;
  f16x8 pre[4];
#define PREP_LOAD(u_) do { const int h_ = (u_) & 15, m0_ = ((u_) >> 4) * 32; \
    _Pragma("unroll") for (int i = 0; i < 4; ++i) { const int q = tid + NT * i; if (q < 34 * 56) { const int row = q / 56, cu = q % 56; int mm = m0_ - 1 + row; mm = mm < 0 ? 0 : (mm > M - 1 ? M - 1 : mm); \
      const int col = cu < 24 ? (cu >> 3) * 1024 + h_ * 64 + (cu & 7) * 8 : C_WD + (cu - 24) * 8; pre[i] = *(const f16x8*)(P + (size_t)mm * NP + col); } } } while (0)
  const int pg_ = lbid() >> 4, ph_ = lbid() & 15;
  const bool pbal = (gridDim.x == 256);
  const int pt0 = pbal ? pg_ * 17 : pg_, pcnt = pbal ? 17 : (272 - pg_ + (int)(gridDim.x >> 4) - 1) / (int)(gridDim.x >> 4), pstep = pbal ? 1 : (int)(gridDim.x >> 4);
  (void)NU;
  if ((part & 1) && pcnt > 0) PREP_LOAD((pt0 * 16 + ph_));
  if (part & 1)
  for (int pk = 0; pk < pcnt; ++pk) { const int u = (pt0 + pk * pstep) * 16 + ph_;
    const int tid = ltid(), lane = tid & 63, wave = __builtin_amdgcn_readfirstlane(tid >> 6), fr = lane & 15, fq = lane >> 4;
    const int h = u & 15, m0 = (u >> 4) * 32, b = m0 / L, t0 = m0 % L;
    __syncthreads();
    if (h != cur_h) { cur_h = h;
#pragma unroll 4
      for (int i = tid; i < 4 * 64 * 64; i += NT) { const int mt = i >> 12, j = (i >> 6) & 63, c = i & 63, d = mt >> 1;
        const float* src = (mt & 1) ? a.in[11] : a.in[9];
        WT[(mt * 64 + c) * WTP + j] = (f16)src[(((size_t)l * 2 + d) * 64 + j) * 1024 + h * 64 + c]; }
      for (int i = tid; i < 1344; i += NT) { float v;
        if (i < 512) v = mu[(i >> 8) * 3328 + C_WD + (i & 255)];
        else if (i < 896) { const int q = i - 512, w1 = q / 192, e = q % 192; v = mu[w1 * 3328 + (e >> 6) * 1024 + h * 64 + (e & 63)]; }
        else if (i < 960) v = a.in[13][l * 1024 + h * 64 + (i - 896)];
        else if (i < 1024) v = a.in[14][l * 1024 + h * 64 + (i - 960)];
        else if (i < 1088) v = a.in[15][l * 1024 + h * 64 + (i - 1024)];
        else if (i < 1216) { const int q = i - 1088; v = a.in[10][(l * 2 + (q >> 6)) * 1024 + h * 64 + (q & 63)]; }
        else { const int q = i - 1216; v = a.in[12][(l * 2 + (q >> 6)) * 1024 + h * 64 + (q & 63)]; }
        CST[i] = v; } }
#pragma unroll
    for (int i = 0; i < 4; ++i) { const int q = tid + NT * i; if (q < 34 * 56) { const int row = q / 56, cu = q % 56;
      *(f16x8*)(RAW + row * RAWP + (cu < 24 ? cu * 8 : 192 + (cu - 24) * 8)) = pre[i]; } }
    __syncthreads();
    if (pk + 1 < pcnt) PREP_LOAD((u + pstep * 16));
    { const int tok = tid >> 4, cg = tid & 15, t = t0 + tok; const bool zp = (t == 0 || t == NCTX), zn = (t == L - 1 || t == NCTX - 1);
      const f16* rp = RAW + tok * RAWP + 192 + 16 * cg;
      const int c0 = 16 * cg, mt = c0 < 128 ? 2 * (c0 >> 6) : 2 * ((c0 - 128) >> 6) + 1, j0 = c0 & 63;
#pragma unroll
      for (int hf = 0; hf < 2; ++hf) { const f16x8 pv = *(const f16x8*)(rp + hf * 8), cv = *(const f16x8*)(rp + RAWP + hf * 8), nv = *(const f16x8*)(rp + 2 * RAWP + hf * 8);
        const float* m0p = CST + c0 + hf * 8; f16x8 o;
#pragma unroll
        for (int e = 0; e < 8; ++e) { const float sv = (float)cv[e], p = zp ? 0.f : (float)pv[e], n = zn ? 0.f : (float)nv[e];
          float x = sv + m0p[e] * (p - sv) + m0p[256 + e] * (n - sv); if (!(mt & 1)) x = tanh_f(x); o[e] = (f16)x; }
        *(f16x8*)(XA + (mt * 32 + tok) * XAP + j0 + hf * 8) = o; } }
#pragma unroll
    for (int it = 0; it < 2; ++it) { const int q = tid + NT * it; if (q < 32 * 24) { const int tok = q / 24, g8 = q % 24, seg = g8 >> 3, ch = (g8 & 7) * 8, t = t0 + tok;
        const bool zp = (t == 0 || t == NCTX), zn = (t == L - 1 || t == NCTX - 1);
        const f16* rp = RAW + tok * RAWP + g8 * 8; const f16x8 pv = *(const f16x8*)rp, cv = *(const f16x8*)(rp + RAWP), nv = *(const f16x8*)(rp + 2 * RAWP);
        const float* m0p = CST + 512 + seg * 64 + ch; float o[8];
#pragma unroll
        for (int e = 0; e < 8; ++e) { const float sv = (float)cv[e], p = zp ? 0.f : (float)pv[e], n = zn ? 0.f : (float)nv[e]; o[e] = sv + m0p[e] * (p - sv) + m0p[192 + e] * (n - sv); }
        float* dst = SH + (seg * 32 + tok) * 64 + ch; *(f32x4*)dst = (f32x4){o[0], o[1], o[2], o[3]}; *(f32x4*)(dst + 4) = (f32x4){o[4], o[5], o[6], o[7]}; } }
    __syncthreads();
    const int ti = wave & 1, d = (wave >> 1) & 1, chalf = wave >> 2;
    f32x4 acc[2][2];
#pragma unroll
    for (int m2 = 0; m2 < 2; ++m2)
#pragma unroll
      for (int c2 = 0; c2 < 2; ++c2) { acc[m2][c2] = (f32x4){0.f, 0.f, 0.f, 0.f};
#pragma unroll
        for (int ks = 0; ks < 2; ++ks) acc[m2][c2] = __builtin_amdgcn_mfma_f32_16x16x32_f16(*(const f16x8*)(XA + ((2 * d + m2) * 32 + 16 * ti + fr) * XAP + ks * 32 + fq * 8),
                                                                                             *(const f16x8*)(WT + ((2 * d + m2) * 64 + 16 * (2 * chalf + c2) + fr) * WTP + ks * 32 + fq * 8), acc[m2][c2], 0, 0, 0); }
    __syncthreads();
    unsigned char* SR = lds + OFF_RAW;
    { const int tok = 4 * wave + (lane >> 4), c4 = (lane & 15) * 4;
      const f32x4 r4 = *(const f32x4*)(SH + (0 * 32 + tok) * 64 + c4), k4 = *(const f32x4*)(SH + (1 * 32 + tok) * 64 + c4), v4 = *(const f32x4*)(SH + (2 * 32 + tok) * 64 + c4);
      const f32x4 kkw = *(const f32x4*)(CST + 896 + c4), rkw = *(const f32x4*)(CST + 1024 + c4);
      const f32x4 kk = k4 * kkw, rkp = r4 * k4 * rkw;
      const float n2 = red16((kk.x * kk.x + kk.y * kk.y) + (kk.z * kk.z + kk.w * kk.w)), rk = red16((rkp.x + rkp.y) + (rkp.z + rkp.w));
      const float inv = 1.f / fmaxf(sqrtf(n2), 1e-12f);
      unsigned char* o = SR + tok * SIR + c4 * 2;
      uint2 w; w.x = pkh(r4.x, r4.y); w.y = pkh(r4.z, r4.w); *(uint2*)o = w;
      w.x = pkh(k4.x, k4.y); w.y = pkh(k4.z, k4.w); *(uint2*)(o + 128) = w;
      w.x = pkh(v4.x, v4.y); w.y = pkh(v4.z, v4.w); *(uint2*)(o + 256) = w;
      if ((lane & 15) == 0) { *(f32x4*)(SR + tok * SIR + 384) = (f32x4){inv, 0.f, 0.f, 0.f}; RKD[(size_t)(m0 + tok) * 16 + h] = rk; } }
#pragma unroll
    for (int c2 = 0; c2 < 2; ++c2) { const int ch = 16 * (2 * chalf + c2) + fr, c = h * 64 + ch;
      const float w0v = CST[1088 + d * 64 + ch], a0v = CST[1216 + d * 64 + ch];
#pragma unroll
      for (int r = 0; r < 4; ++r) { const int tok = 16 * ti + 4 * fq + r;
        const float wl = w0v + acc[0][c2][r]; const float dec = __expf(-0.6065306597126334f * sigm_f(wl));
        const float ag = sigm_f(a0v + acc[1][c2][r]);
        unsigned char* o = SR + tok * SIR + 400 + d * 256;
        ((f16*)o)[ch] = (f16)(1.f - dec); ((f16*)(o + 128))[ch] = (f16)ag; } }
    __syncthreads();
    { unsigned char* dstg = a.ws + WS_SI + ((size_t)(b * 16 + h) * L + t0) * SIR;
#pragma unroll
      for (int i = 0; i < 4; ++i) { const int q = tid + NT * i; if (q < 32 * SIR / 16) *(u32x4*)(dstg + (size_t)q * 16) = *(const u32x4*)(SR + q * 16); } }
  }
#undef PREP_LOAD
  __syncthreads();
  f16* QN = (f16*)(a.ws + WS_QN); f16* KN = (f16*)(a.ws + WS_KN);
  f32x2* cst = (f32x2*)lds;
  for (int i = tid; i < 64 * 32; i += NT) { const int pos = i >> 5, fi = i & 31; const float ang = (float)pos * powf(10000.f, -(float)(2 * fi) / 64.f); cst[i] = (f32x2){cosf(ang), sinf(ang)}; }
  __syncthreads();
  if (nb == 0) nb = gridDim.x;
  const int gw = (lbid() - b0) * 8 + wave, NGW = nb * 8;
  const int ax = lane >> 5, fi = lane & 31;
  if (part & 2)
  for (int m = gw; m < M; m += NGW) {
    const int t = m % L; const f16* pr = P + (size_t)m * NP;
    float x1[10], x2[10], ss[10];
#pragma unroll
    for (int hh = 0; hh < 10; ++hh) { const int src = hh < 8 ? C_ATQ + hh * 128 : C_ATK + (hh - 8) * 128; x1[hh] = (float)pr[src + ax * 64 + fi]; x2[hh] = (float)pr[src + ax * 64 + 32 + fi]; ss[hh] = x1[hh] * x1[hh] + x2[hh] * x2[hh]; }
    const f16x4 vc = *(const f16x4*)(pr + C_ATV + 4 * lane);
#pragma unroll
    for (int hh = 0; hh < 10; ++hh) ss[hh] = wave_sum(ss[hh]);
    f32x2 cs = {1.f, 0.f};
    if (t >= NCTX) { const int n = t - NCTX; cs = cst[(ax == 0 ? n / 64 : n % 64) * 32 + fi]; }
#pragma unroll
    for (int hh = 0; hh < 10; ++hh) { const float* g = (hh < 8 ? a.in[18] : a.in[19]) + l * 128; const float rstd = rsqrtf(ss[hh] * (1.f / 128.f) + 1e-6f);
      const float y1 = x1[hh] * rstd * g[ax * 64 + fi], y2 = x2[hh] * rstd * g[ax * 64 + 32 + fi];
      f16* dst = hh < 8 ? QN + (size_t)m * 1024 + hh * 128 : KN + (size_t)m * 512 + (hh - 8) * 128;
      dst[ax * 64 + fi] = (f16)(y1 * cs.x - y2 * cs.y); dst[ax * 64 + 32 + fi] = (f16)(y1 * cs.y + y2 * cs.x); }
    *(f16x4*)(KN + (size_t)m * 512 + 256 + 4 * lane) = vc;
  }
}

__device__ __forceinline__ int scan_tok(int dir, int i) { return dir == 0 ? i : (i < NCTX ? NCTX - 1 - i : L - 1 - (i - NCTX)); }

namespace rw {
constexpr int T = 16;
constexpr int STEPF = 6 * 64;
constexpr int BUFF = T * STEPF;
constexpr int YR_OFF = 2 * BUFF, YRING = T * 512;
template <int CTRL> __device__ __forceinline__ float dpp(float x) { return __int_as_float(__builtin_amdgcn_update_dpp(0, __float_as_int(x), CTRL, 0xF, 0xF, true)); }
__device__ __forceinline__ float red8(float x) { x += dpp<0xB1>(x); x += dpp<0x4E>(x); x += dpp<0x141>(x); return x; }
struct Ops { f32x4 r0, r1, k0, k1, w0, w1, b0, b1, d0, d1; f32x2 v; };
typedef __attribute__((address_space(3))) const float lcf;
__device__ __forceinline__ void ld_ops(Ops& o, lcf* st, lcf* vp) {
  o.r0 = *(const __attribute__((address_space(3))) f32x4*)(st); o.r1 = *(const __attribute__((address_space(3))) f32x4*)(st + 4);
  o.k0 = *(const __attribute__((address_space(3))) f32x4*)(st + 64); o.k1 = *(const __attribute__((address_space(3))) f32x4*)(st + 68);
  o.w0 = *(const __attribute__((address_space(3))) f32x4*)(st + 192); o.w1 = *(const __attribute__((address_space(3))) f32x4*)(st + 196);
  o.b0 = *(const __attribute__((address_space(3))) f32x4*)(st + 256); o.b1 = *(const __attribute__((address_space(3))) f32x4*)(st + 260);
  o.d0 = *(const __attribute__((address_space(3))) f32x4*)(st + 320); o.d1 = *(const __attribute__((address_space(3))) f32x4*)(st + 324);
  o.v = *(const __attribute__((address_space(3))) f32x2*)(vp);
}
#define RW_LO(v_) __builtin_shufflevector(v_, v_, 0, 1)
#define RW_HI(v_) __builtin_shufflevector(v_, v_, 2, 3)
#define RW_FMA(a_, b_, c_) __builtin_elementwise_fma(a_, b_, c_)
#define RW_DPP(r_, ctrl) "v_add_f32_dpp " r_ ", " r_ ", " r_ " " ctrl " row_mask:0xf bank_mask:0xf bound_ctrl:1\n\t"
__device__ __forceinline__ void step(f32x2 (&S0)[4], f32x2 (&S1)[4], const Ops& o, __attribute__((address_space(3))) f32x2* yw) {
  const f32x2 K[4] = {RW_LO(o.k0), RW_HI(o.k0), RW_LO(o.k1), RW_HI(o.k1)}, R[4] = {RW_LO(o.r0), RW_HI(o.r0), RW_LO(o.r1), RW_HI(o.r1)};
  const f32x2 W[4] = {RW_LO(o.w0), RW_HI(o.w0), RW_LO(o.w1), RW_HI(o.w1)}, Bv[4] = {RW_LO(o.b0), RW_HI(o.b0), RW_LO(o.b1), RW_HI(o.b1)};
  const f32x2 Dv[4] = {RW_LO(o.d0), RW_HI(o.d0), RW_LO(o.d1), RW_HI(o.d1)};
  f32x2 a0 = S0[0] * K[0], a1 = S1[0] * K[0];
#pragma unroll
  for (int j = 1; j < 4; ++j) { a0 = RW_FMA(S0[j], K[j], a0); a1 = RW_FMA(S1[j], K[j], a1); }
  float x0 = a0.x + a0.y, x1 = a1.x + a1.y;
  f32x2 m0, m1;
  asm("s_nop 1\n\t" RW_DPP("%0", "quad_perm:[1,0,3,2]") RW_DPP("%1", "quad_perm:[1,0,3,2]") "v_pk_mul_f32 %2, %4, %6\n\t"
      RW_DPP("%0", "quad_perm:[2,3,0,1]") RW_DPP("%1", "quad_perm:[2,3,0,1]") "v_pk_mul_f32 %3, %5, %6\n\t"
      RW_DPP("%0", "row_half_mirror") RW_DPP("%1", "row_half_mirror")
      : "+v"(x0), "+v"(x1), "=&v"(m0), "=&v"(m1) : "v"(S0[0]), "v"(S1[0]), "v"(W[0]));
  const f32x2 vx = {o.v.x, o.v.x}, vy = {o.v.y, o.v.y};
  f32x2 t0[4], t1[4];
  t0[0] = RW_FMA(vx, Dv[0], m0); t1[0] = RW_FMA(vy, Dv[0], m1);
#pragma unroll
  for (int j = 1; j < 4; ++j) { t0[j] = RW_FMA(vx, Dv[j], S0[j] * W[j]); t1[j] = RW_FMA(vy, Dv[j], S1[j] * W[j]); }
  const f32x2 n0 = {-x0, -x0}, n1 = {-x1, -x1};
#pragma unroll
  for (int j = 0; j < 4; ++j) { S0[j] = RW_FMA(n0, Bv[j], t0[j]); S1[j] = RW_FMA(n1, Bv[j], t1[j]); }
  f32x2 y0 = S0[0] * R[0], y1 = S1[0] * R[0];
#pragma unroll
  for (int j = 1; j < 4; ++j) { y0 = RW_FMA(S0[j], R[j], y0); y1 = RW_FMA(S1[j], R[j], y1); }
  float ya = y0.x + y0.y, yb = y1.x + y1.y; asm("" : "+v"(ya), "+v"(yb));
  *yw = (f32x2){ya, yb};
}
__device__ __forceinline__ void scan_unit(const Args& a, int l, int u, unsigned char* ldsb) {
  const int tid = ltid(), wave = tid >> 6;
  const int dir = u & 1, bh = u >> 1, b = bh >> 4, h = bh & 15;
  const unsigned char* SIb = a.ws + WS_SI + (size_t)bh * L * SIR;
  f16* Y = (f16*)(a.ws + WS_YRW) + (size_t)dir * M * 1024 + (size_t)b * L * 1024 + h * 64;
  float* sbuf = (float*)ldsb;
  constexpr int NC = L / T;
  if (wave >= 4) {
    const int lt = tid - 256;
    const int lpart = lt >> 7, ls = (lt >> 3) & 15, lg = lt & 7;
    float ckk[8], cka[8];
#pragma unroll
    for (int e = 0; e < 8; ++e) { ckk[e] = a.in[13][l * 1024 + h * 64 + lg * 8 + e]; cka[e] = a.in[14][l * 1024 + h * 64 + lg * 8 + e]; }
    u32x4 regs[3];
    auto issue = [&](int c) {
      const unsigned char* rec = SIb + (size_t)scan_tok(dir, c * T + ls) * SIR; const int dof = 400 + dir * 256 + lg * 16;
      regs[0] = *(const u32x4*)(rec + (lpart ? 128 : 0) + lg * 16);
      regs[1] = *(const u32x4*)(rec + (lpart ? dof + 128 : 256 + lg * 16));
      regs[2] = *(const u32x4*)(rec + (lpart ? 384 : dof));
    };
    auto commit = [&](int c) {
      float* d0 = sbuf + (c & 1) * BUFF + ls * STEPF + lg * 8;
      const f16x8 h0 = __builtin_bit_cast(f16x8, regs[0]), h1 = __builtin_bit_cast(f16x8, regs[1]);
      float o0[8], o1[8], o2[8];
      if (lpart == 0) { const f16x8 h2 = __builtin_bit_cast(f16x8, regs[2]);
#pragma unroll
        for (int e = 0; e < 8; ++e) { o0[e] = (float)h0[e]; o1[e] = (float)h1[e]; o2[e] = 1.f - (float)h2[e]; }
        *(f32x4*)(d0) = (f32x4){o0[0], o0[1], o0[2], o0[3]}; *(f32x4*)(d0 + 4) = (f32x4){o0[4], o0[5], o0[6], o0[7]};
        *(f32x4*)(d0 + 128) = (f32x4){o1[0], o1[1], o1[2], o1[3]}; *(f32x4*)(d0 + 132) = (f32x4){o1[4], o1[5], o1[6], o1[7]};
        *(f32x4*)(d0 + 192) = (f32x4){o2[0], o2[1], o2[2], o2[3]}; *(f32x4*)(d0 + 196) = (f32x4){o2[4], o2[5], o2[6], o2[7]}; }
      else { const float inv = __uint_as_float(regs[2].x);
#pragma unroll
        for (int e = 0; e < 8; ++e) { const float k = (float)h0[e], ag = (float)h1[e]; o0[e] = k * ckk[e] * inv; o1[e] = o0[e] * ag; o2[e] = k * (1.f + (ag - 1.f) * cka[e]); }
        *(f32x4*)(d0 + 64) = (f32x4){o0[0], o0[1], o0[2], o0[3]}; *(f32x4*)(d0 + 68) = (f32x4){o0[4], o0[5], o0[6], o0[7]};
        *(f32x4*)(d0 + 256) = (f32x4){o1[0], o1[1], o1[2], o1[3]}; *(f32x4*)(d0 + 260) = (f32x4){o1[4], o1[5], o1[6], o1[7]};
        *(f32x4*)(d0 + 320) = (f32x4){o2[0], o2[1], o2[2], o2[3]}; *(f32x4*)(d0 + 324) = (f32x4){o2[4], o2[5], o2[6], o2[7]}; }
    };
    auto yred = [&](int c) {
      const float* ring = sbuf + YR_OFF + (c & 1) * YRING;
#pragma unroll
      for (int i = 0; i < (T * 32) / 256; ++i) { const int it = lt + 256 * i, s = it >> 5, p = it & 31;
        const f32x4* src = (const f32x4*)(ring + s * 512 + p * 16);
        const f32x4 q = (src[0] + src[1]) + (src[2] + src[3]);
        *(unsigned*)(Y + (size_t)scan_tok(dir, c * T + s) * 1024 + 2 * p) = pkh(q.x + q.z, q.y + q.w); }
    };
    issue(0); commit(0);
    __syncthreads();
    for (int c = 0; c < NC; ++c) {
      if (c + 1 < NC) issue(c + 1);
      if (c > 0) yred(c - 1);
      if (c + 1 < NC) commit(c + 1);
      __syncthreads();
    }
    yred(NC - 1);
  } else {
    const int p = tid >> 3, ks = tid & 7;
    __builtin_amdgcn_s_setprio(2);
    f32x2 S0[4], S1[4];
#pragma unroll
    for (int k = 0; k < 4; ++k) { S0[k] = (f32x2){0.f, 0.f}; S1[k] = (f32x2){0.f, 0.f}; }
    typedef __attribute__((address_space(3))) f32x2 lf2;
    __syncthreads();
    for (int c = 0; c < NC; ++c) {
      lcf* buf = (lcf*)(sbuf + (c & 1) * BUFF) + ks * 8; lcf* vb = (lcf*)(sbuf + (c & 1) * BUFF) + 128 + 2 * p;
      lf2* yw = (lf2*)(sbuf + YR_OFF + (c & 1) * YRING) + tid;
      Ops A, B;
      ld_ops(A, buf, vb);
#pragma unroll 1
      for (int s = 0; s < T; s += 2) {
        ld_ops(B, buf + (s + 1) * STEPF, vb + (s + 1) * STEPF);
        step(S0, S1, A, yw + s * 256);
        __builtin_amdgcn_sched_barrier(0);
        ld_ops(A, buf + (s + 2) * STEPF, vb + (s + 2) * STEPF);
        step(S0, S1, B, yw + (s + 1) * 256);
        __builtin_amdgcn_sched_barrier(0);
      }
      __syncthreads();
    }
    __builtin_amdgcn_s_setprio(0);
  }
}
}


namespace ml {
constexpr int PT = 136;
constexpr int OFF_Q = 0, OFF_K = 128 * PT * 2, OFF_KT = 2 * 128 * PT * 2, OFF_VT = 3 * 128 * PT * 2, OFF_CT = OFF_VT + 80 * PT * 2, OFF_SC = OFF_CT + 80 * PT * 2;
constexpr int LDS_NEED = OFF_SC + 6 * 512 + 256 + 64;
static_assert(LDS_NEED <= LDS_BYTES, "mLSTM LDS");
constexpr int NCH = L / 128;
#define MFMA16(a_, b_, c_) __builtin_amdgcn_mfma_f32_16x16x32_f16(a_, b_, c_, 0, 0, 0)
__device__ __forceinline__ void mlstm_unit(const Args& a, int l, int u, unsigned char* lds) {
  const int tid = ltid(), lane = tid & 63, w = __builtin_amdgcn_readfirstlane(tid >> 6), fr = lane & 15, fq = lane >> 4;
  const int dir = u & 1, vs = (u >> 1) & 3, bh = u >> 3, b = bh >> 2, h = bh & 3;
  const f16* P = (const f16*)(a.ws + WS_P) + (size_t)b * L * NP; const float* GP = (const float*)(a.ws + WS_GPRE) + (size_t)b * L * 16; const float* gb = a.in[20] + l * 16;
  f16* HM = (f16*)(a.ws + WS_HM) + (size_t)dir * M * 1024 + (size_t)b * L * 1024 + h * 256 + vs * 64;
  f16* Qs = (f16*)(lds + OFF_Q); f16* Ks = (f16*)(lds + OFF_K); f16* KTs = (f16*)(lds + OFF_KT); f16* VTs = (f16*)(lds + OFF_VT); f16* CTs = (f16*)(lds + OFF_CT);
  float* sc = (float*)(lds + OFF_SC); float* li = sc; float* bcs = sc + 128; float* uu = sc + 256; float* Mx = sc + 384; float* wint = sc + 512; float* emt = sc + 640; f16* wah = (f16*)(sc + 768);
  const float bi = gb[dir * 4 + h], bfg = gb[(2 + dir) * 4 + h];
  __syncthreads();
  for (int i = tid; i < 16 * PT; i += NT) VTs[64 * PT + i] = (f16)(i < PT ? 1.f : 0.f);
  for (int i = tid; i < 80 * PT; i += NT) CTs[i] = (f16)0.f;
  f32x4 CT[5];
#pragma unroll
  for (int n = 0; n < 5; ++n) CT[n] = (f32x4){0.f, 0.f, 0.f, 0.f};
  float mcar = 0.f;
  const int sgn = dir ? -1 : 1;
  f16x8 pq[4], pk[4], pv[2];
#define ML_LOAD(c) do { const int tb_ = scan_tok(dir, 128 * (c)); \
    _Pragma("unroll") for (int i = 0; i < 4; ++i) { const int un = tid + NT * i, j = un >> 4, d8 = un & 15; const f16* rp = P + (size_t)(tb_ + sgn * j) * NP; \
      pq[i] = *(const f16x8*)(rp + C_MLQ + h * 128 + d8 * 8); pk[i] = *(const f16x8*)(rp + C_MLK + h * 128 + d8 * 8); } \
    _Pragma("unroll") for (int i = 0; i < 2; ++i) { const int un = tid + NT * i, j = un >> 3, v8 = un & 7; \
      pv[i] = *(const f16x8*)(P + (size_t)(tb_ + sgn * j) * NP + C_MLV + h * 256 + vs * 64 + v8 * 8); } } while (0)
  ML_LOAD(0);
  for (int c = 0; c < NCH; ++c) {
    const int tb = scan_tok(dir, 128 * c);
    __syncthreads();
#pragma unroll
    for (int i = 0; i < 4; ++i) { const int un = tid + NT * i, j = un >> 4, d8 = un & 15;
      f16x8 qv;
#pragma unroll
      for (int e = 0; e < 8; ++e) qv[e] = (f16)((float)pq[i][e] * 0.08838834764831845f);
      *(f16x8*)(Qs + j * PT + d8 * 8) = qv; *(f16x8*)(Ks + j * PT + d8 * 8) = pk[i];
#pragma unroll
      for (int e = 0; e < 8; ++e) KTs[(d8 * 8 + e) * PT + (j ^ (d8 * 8))] = pk[i][e]; }
#pragma unroll
    for (int i = 0; i < 2; ++i) { const int un = tid + NT * i, j = un >> 3, v8 = un & 7;
#pragma unroll
      for (int e = 0; e < 8; ++e) VTs[(v8 * 8 + e) * PT + (j ^ (v8 * 8))] = pv[i][e]; }
    if (tid < 128) { const float* gp = GP + (size_t)(tb + sgn * tid) * 16;
      const float pi = gp[dir * 4 + h] + bi, pf = gp[(2 + dir) * 4 + h] + bfg;
      li[tid] = 15.f * tanhf(pi * (1.f / 15.f)); bcs[tid] = -softplus_f(-15.f * tanhf(pf * (1.f / 15.f))); }
    if (c + 1 < NCH) ML_LOAD(c + 1);
    __syncthreads();
    if (w == 0) {
      const float x0 = bcs[2 * lane], x1 = bcs[2 * lane + 1]; const float ps = x0 + x1; float inc = ps;
#pragma unroll
      for (int o = 1; o < 64; o <<= 1) { const float t = __shfl_up(inc, o); if (lane >= o) inc += t; }
      const float b0 = inc - ps + x0, b1 = b0 + x1;
      const float u0 = li[2 * lane] - b0, u1 = li[2 * lane + 1] - b1;
      float incm = fmaxf(u0, u1);
#pragma unroll
      for (int o = 1; o < 64; o <<= 1) { const float t = __shfl_up(incm, o); if (lane >= o) incm = fmaxf(incm, t); }
      float exm = __shfl_up(incm, 1); if (lane == 0) exm = -INFINITY;
      const float pm0 = fmaxf(exm, u0), pm1 = incm;
      const float M0 = fmaxf(mcar, pm0), M1 = fmaxf(mcar, pm1); const float Ml = __shfl(M1, 63);
      bcs[2 * lane] = b0; bcs[2 * lane + 1] = b1; uu[2 * lane] = u0; uu[2 * lane + 1] = u1; Mx[2 * lane] = M0; Mx[2 * lane + 1] = M1;
      wint[2 * lane] = expf(mcar - M0); wint[2 * lane + 1] = expf(mcar - M1); emt[2 * lane] = expf(-(b0 + M0)); emt[2 * lane + 1] = expf(-(b1 + M1));
      wah[2 * lane] = (f16)expf(u0 - Ml); wah[2 * lane + 1] = (f16)expf(u1 - Ml);
    }
    f16x8 af[4];
#pragma unroll
    for (int ks = 0; ks < 4; ++ks) af[ks] = *(const f16x8*)(Qs + (16 * w + fr) * PT + ks * 32 + fq * 8);
    f32x4 acc[8];
#pragma unroll
    for (int n = 0; n < 8; ++n) { acc[n] = (f32x4){0.f, 0.f, 0.f, 0.f};
#pragma unroll
      for (int ks = 0; ks < 4; ++ks) acc[n] = MFMA16(af[ks], *(const f16x8*)(Ks + (16 * n + fr) * PT + ks * 32 + fq * 8), acc[n]); }
    __syncthreads();
    const float Mlast = Mx[127], gsum = bcs[127]; const float cs = expf(mcar - Mlast);
    f16* Ss = Ks;
    { float Mt[4];
#pragma unroll
      for (int r = 0; r < 4; ++r) Mt[r] = Mx[16 * w + 4 * fq + r];
#pragma unroll
      for (int n = 0; n < 8; ++n) { const int s = 16 * n + fr; const float us = uu[s];
#pragma unroll
        for (int r = 0; r < 4; ++r) { const int t = 16 * w + 4 * fq + r; const float v = (s <= t) ? acc[n][r] * __expf(us - Mt[r]) : 0.f; Ss[t * PT + s] = (f16)v; } } }
    f32x4 QC[5], SV[5];
#pragma unroll
    for (int n = 0; n < 5; ++n) { QC[n] = (f32x4){0.f, 0.f, 0.f, 0.f}; SV[n] = (f32x4){0.f, 0.f, 0.f, 0.f};
#pragma unroll
      for (int ks = 0; ks < 4; ++ks) QC[n] = MFMA16(af[ks], *(const f16x8*)(CTs + (16 * n + fr) * PT + ks * 32 + fq * 8), QC[n]); }
#pragma unroll
    for (int ks = 0; ks < 4; ++ks) if (32 * ks <= 16 * w + 15) { const f16x8 sf = *(const f16x8*)(Ss + (16 * w + fr) * PT + ks * 32 + fq * 8);
#pragma unroll
      for (int n = 0; n < 5; ++n) SV[n] = MFMA16(sf, *(const f16x8*)(VTs + (16 * n + fr) * PT + ((ks * 32 + fq * 8) ^ ((((16 * n + fr) >> 3) & 7) * 8))), SV[n]); }
#pragma unroll
    for (int r = 0; r < 4; ++r) { const int t = 16 * w + 4 * fq + r; const float wi = wint[t];
      const float den = __shfl(wi * QC[4][r] + SV[4][r], lane & 48); const float inv = 1.f / fmaxf(fabsf(den), emt[t]);
      f16* hp = HM + (size_t)(tb + sgn * t) * 1024 + fr;
#pragma unroll
      for (int n = 0; n < 4; ++n) hp[16 * n] = (f16)((wi * QC[n][r] + SV[n][r]) * inv); }
#pragma unroll
    for (int n = 0; n < 5; ++n) CT[n] = CT[n] * cs;
#pragma unroll
    for (int ks = 0; ks < 4; ++ks) { const f16x8 bfr = *(const f16x8*)(KTs + (16 * w + fr) * PT + ((ks * 32 + fq * 8) ^ ((((16 * w + fr) >> 3) & 15) * 8))) * *(const f16x8*)(wah + ks * 32 + fq * 8);
#pragma unroll
      for (int n = 0; n < 5; ++n) CT[n] = MFMA16(*(const f16x8*)(VTs + (16 * n + fr) * PT + ((ks * 32 + fq * 8) ^ ((((16 * n + fr) >> 3) & 7) * 8))), bfr, CT[n]); }
    __syncthreads();
#pragma unroll
    for (int n = 0; n < 5; ++n)
#pragma unroll
      for (int r = 0; r < 4; ++r) CTs[(16 * n + 4 * fq + r) * PT + 16 * w + fr] = (f16)CT[n][r];
    mcar = gsum + Mlast;
  }
#undef ML_LOAD
}
#undef MFMA16
}

namespace att {
constexpr int AD = 128, NW = 8, QBLK = 32, KVBLK = 64;
constexpr float SCALE = 0.088388347648318440f;
constexpr float THR = 8.f;
constexpr int LDQ = 1024, LDK = 512, LDV = 512, LDO = 1024;
constexpr size_t SHM_V = KVBLK * AD * 2, SHM_K = KVBLK * AD * 2, SHM_ATTN = 2 * SHM_V + 2 * SHM_K + NW * 64 * 4;
using s16x4 = __attribute__((ext_vector_type(4))) short;
using f32x16 = __attribute__((ext_vector_type(16))) float;
#define KSWZ(row, colB) ((row) * 256 + ((colB) ^ (((row) & 7) << 4)))
#define SBAR() __builtin_amdgcn_sched_barrier(0)
__device__ __forceinline__ int crow(int r, int hi) { return (r & 3) + 8 * (r >> 2) + 4 * hi; }
__device__ __forceinline__ unsigned cvtpk(float lo, float hi) { unsigned r; asm volatile("v_cvt_pk_f16_f32 %0, %1, %2" : "=v"(r) : "v"(lo), "v"(hi)); return r; }
__device__ __forceinline__ void partialSM(f32x16& p0, f32x16& p1, float& m_reg, float& mn, float& alpha) {
  constexpr float C = SCALE * 1.4426950408889634f;
  float pmax = p0[0];
#pragma unroll
  for (int r = 1; r < 16; ++r) pmax = fmaxf(pmax, p0[r]);
#pragma unroll
  for (int r = 0; r < 16; ++r) pmax = fmaxf(pmax, p1[r]);
  { auto rr = __builtin_amdgcn_permlane32_swap(__float_as_uint(pmax), __float_as_uint(pmax), false, false);
    pmax = fmaxf(__uint_as_float(rr[0]), __uint_as_float(rr[1])); }
  if (__builtin_expect(__all(pmax - m_reg <= THR / SCALE), 1)) { mn = m_reg; alpha = 1.f; }
  else { mn = fmaxf(m_reg, pmax); alpha = __builtin_amdgcn_exp2f((m_reg - mn) * C); m_reg = mn; }
  float mnC = -mn * C;
#pragma unroll
  for (int r = 0; r < 16; ++r) p0[r] = fmaf(p0[r], C, mnC);
#pragma unroll
  for (int r = 0; r < 16; ++r) p1[r] = fmaf(p1[r], C, mnC);
#pragma unroll
  for (int r = 0; r < 16; ++r) p0[r] = __builtin_amdgcn_exp2f(p0[r]);
}
__device__ __forceinline__ void finishSM(f32x16& p0, f32x16& p1, float alpha, float& l_reg, f16x8& pa0, f16x8& pa1, f16x8& pa2, f16x8& pa3) {
#pragma unroll
  for (int r = 0; r < 16; ++r) p1[r] = __builtin_amdgcn_exp2f(p1[r]);
  float ps = 0;
#pragma unroll
  for (int r = 0; r < 16; ++r) ps += p0[r];
#pragma unroll
  for (int r = 0; r < 16; ++r) ps += p1[r];
  { auto rr = __builtin_amdgcn_permlane32_swap(__float_as_uint(ps), __float_as_uint(ps), false, false);
    ps = __uint_as_float(rr[0]) + __uint_as_float(rr[1]); }
  l_reg = l_reg * alpha + ps;
#define PK4(P, BASE, OUT) do { unsigned a0 = cvtpk(P[BASE + 0], P[BASE + 1]), a1 = cvtpk(P[BASE + 2], P[BASE + 3]);   \
    unsigned b0 = cvtpk(P[BASE + 4], P[BASE + 5]), b1 = cvtpk(P[BASE + 6], P[BASE + 7]);                              \
    auto r0 = __builtin_amdgcn_permlane32_swap(a0, b0, false, false); auto r1 = __builtin_amdgcn_permlane32_swap(a1, b1, false, false); \
    u32x4 w = {r0[0], r1[0], r0[1], r1[1]}; OUT = __builtin_bit_cast(f16x8, w); } while (0)
  PK4(p0, 0, pa0); PK4(p0, 8, pa1); PK4(p1, 0, pa2); PK4(p1, 8, pa3);
#undef PK4
}
__device__ __forceinline__ void qkt(f32x16& p0, f32x16& p1, const char* Ks, const f16x8* qr, int r32, int hi) {
  p0 = f32x16{}; p1 = f32x16{};
#pragma unroll
  for (int d0 = 0; d0 < 8; ++d0) { int cb = (d0 * 16 + hi * 8) * 2;
    f16x8 b0 = *reinterpret_cast<const f16x8*>(Ks + KSWZ(r32, cb));
    f16x8 b1 = *reinterpret_cast<const f16x8*>(Ks + KSWZ(32 + r32, cb));
    p0 = __builtin_amdgcn_mfma_f32_32x32x16_f16(b0, qr[d0], p0, 0, 0, 0);
    p1 = __builtin_amdgcn_mfma_f32_32x32x16_f16(b1, qr[d0], p1, 0, 0, 0); }
}
__device__ __forceinline__ int v_st(int k, int c) { const int kk = (k & ~0xC) | ((k & 4) << 1) | ((k & 8) >> 1); return ((kk >> 3) * 4 + (c >> 5)) * 512 + ((kk & 7) * 32 + (c & 31)) * 2; }
__device__ __forceinline__ int v_rd_base(int lane) { return ((lane & 3) << 3) | (((lane >> 2) & 3) << 6) | (((lane >> 4) & 1) << 5) | (((lane >> 5) & 1) << 8); }
constexpr int v_rd_off(int d0, int ks, int half) { return d0 * 512 + ks * 4096 + half * 2048; }
template <int OFF> __device__ __forceinline__ s16x4 tr_read(int vb) {
  s16x4 r; asm volatile("ds_read_b64_tr_b16 %0, %1 offset:%2" : "=&v"(r) : "v"(vb), "i"(OFF) : "memory"); return r;
}
template <int D0> __device__ __forceinline__ void pv_one(f32x16& od, int vb, f16x8 pa0, f16x8 pa1, f16x8 pa2, f16x8 pa3) {
  const s16x4 l0 = tr_read<v_rd_off(D0, 0, 0)>(vb), h0 = tr_read<v_rd_off(D0, 0, 1)>(vb), l1 = tr_read<v_rd_off(D0, 1, 0)>(vb), h1 = tr_read<v_rd_off(D0, 1, 1)>(vb);
  const s16x4 l2 = tr_read<v_rd_off(D0, 2, 0)>(vb), h2 = tr_read<v_rd_off(D0, 2, 1)>(vb), l3 = tr_read<v_rd_off(D0, 3, 0)>(vb), h3 = tr_read<v_rd_off(D0, 3, 1)>(vb);
  asm volatile("s_waitcnt lgkmcnt(0)" ::: "memory"); SBAR();
  typedef short s16x8 __attribute__((ext_vector_type(8)));
#define PK(Lo, Hi) __builtin_bit_cast(f16x8, (s16x8){Lo[0], Lo[1], Lo[2], Lo[3], Hi[0], Hi[1], Hi[2], Hi[3]})
  od = __builtin_amdgcn_mfma_f32_32x32x16_f16(pa0, PK(l0, h0), od, 0, 0, 0);
  od = __builtin_amdgcn_mfma_f32_32x32x16_f16(pa1, PK(l1, h1), od, 0, 0, 0);
  od = __builtin_amdgcn_mfma_f32_32x32x16_f16(pa2, PK(l2, h2), od, 0, 0, 0);
  od = __builtin_amdgcn_mfma_f32_32x32x16_f16(pa3, PK(l3, h3), od, 0, 0, 0);
#undef PK
}
__device__ __forceinline__ void pv_d0(f32x16* o, int vb, f16x8 pa0, f16x8 pa1, f16x8 pa2, f16x8 pa3) {
  pv_one<0>(o[0], vb, pa0, pa1, pa2, pa3); pv_one<1>(o[1], vb, pa0, pa1, pa2, pa3); pv_one<2>(o[2], vb, pa0, pa1, pa2, pa3); pv_one<3>(o[3], vb, pa0, pa1, pa2, pa3);
}
__device__ __forceinline__ void attn_dense_body(const f16* __restrict__ Qb, const f16* __restrict__ Kh, const f16* __restrict__ Vh, f16* __restrict__ Ob, int seq, char* lds) {
  const int tid = ltid(), wid = tid >> 6, lane = tid & 63, r32 = lane & 31, hi = lane >> 5;
  char* V_lds = lds; char* K_lds = lds + 2 * SHM_V;
  float* ws = (float*)(lds + 2 * SHM_V + 2 * SHM_K) + wid * 64; float* li_l = ws; float* al_l = ws + 32;
  float m_reg = -1e30f, l_reg = 0; f32x16 o[4] = {}; f16x8 qr[8];
  const f16* Qw = Qb + (long)(wid * QBLK + r32) * LDQ + hi * 8;
#pragma unroll
  for (int d0 = 0; d0 < 8; ++d0) qr[d0] = *reinterpret_cast<const f16x8*>(Qw + d0 * 16);
  const int sr = tid >> 4, sc = (tid & 15) * 8, vst0 = v_st(sr, sc), vst1 = v_st(32 + sr, sc);
  const int vb0 = (int)(uintptr_t)V_lds + v_rd_base(lane);
  struct { f16x8 vs0, vs1, ks0, ks1; } sr_[2];
#define SLOAD(i, k0) do { sr_[i].vs0 = *(const f16x8*)(&Vh[(long)((k0) + sr) * LDV + sc]); sr_[i].vs1 = *(const f16x8*)(&Vh[(long)((k0) + 32 + sr) * LDV + sc]); \
    sr_[i].ks0 = *(const f16x8*)(&Kh[(long)((k0) + sr) * LDK + sc]); sr_[i].ks1 = *(const f16x8*)(&Kh[(long)((k0) + 32 + sr) * LDK + sc]); } while (0)
#define SWRITE(b, i) do { *(f16x8*)(V_lds + (b) * SHM_V + vst0) = sr_[i].vs0;          \
    *(f16x8*)(V_lds + (b) * SHM_V + vst1) = sr_[i].vs1; int kc = sc * 2;               \
    *(f16x8*)(K_lds + (b) * SHM_K + KSWZ(sr, kc)) = sr_[i].ks0;                       \
    *(f16x8*)(K_lds + (b) * SHM_K + KSWZ(32 + sr, kc)) = sr_[i].ks1; } while (0)
#define SWAIT() asm volatile("s_waitcnt vmcnt(4)" ::: "memory")
#define RESC(a) do { if (__any((a) < 1.f)) { if (hi == 0) al_l[r32] = (a); asm volatile("s_waitcnt lgkmcnt(0)" ::: "memory"); \
    _Pragma("unroll") for (int d = 0; d < 4; ++d) _Pragma("unroll") for (int r = 0; r < 16; ++r) o[d][r] *= al_l[crow(r, hi)]; } } while (0)
  f32x16 pA0, pA1, pB0, pB1; float mnA, mnB, alA, alB; f16x8 pa0, pa1, pa2, pa3; const int NTl = seq / KVBLK;
  constexpr int SE = 0, SO = 1;
  SLOAD(SE, 0); asm volatile("s_waitcnt vmcnt(0)" ::: "memory"); SWRITE(0, SE); __syncthreads();
  qkt(pA0, pA1, K_lds, qr, r32, hi); partialSM(pA0, pA1, m_reg, mnA, alA);
  SLOAD(SO, KVBLK); if (2 < NTl) SLOAD(SE, 2 * KVBLK);
  SWAIT(); SWRITE(1, SO); __syncthreads();
  for (int j = 1; j + 1 < NTl; j += 2) {
    SBAR(); qkt(pB0, pB1, K_lds + SHM_K, qr, r32, hi);
    finishSM(pA0, pA1, alA, l_reg, pa0, pa1, pa2, pa3); SBAR();
    SLOAD(SO, (j + 2) * KVBLK); SBAR();
    pv_d0(o, vb0, pa0, pa1, pa2, pa3); partialSM(pB0, pB1, m_reg, mnB, alB);
    __syncthreads(); SWAIT(); SWRITE(0, SE);
    RESC(alB); __syncthreads();
    SBAR(); qkt(pA0, pA1, K_lds, qr, r32, hi);
    finishSM(pB0, pB1, alB, l_reg, pa0, pa1, pa2, pa3); SBAR();
    if (j + 3 < NTl) SLOAD(SE, (j + 3) * KVBLK); SBAR();
    pv_d0(o, vb0 + (int)SHM_V, pa0, pa1, pa2, pa3); partialSM(pA0, pA1, m_reg, mnA, alA);
    __syncthreads(); SWAIT(); SWRITE(1, SO);
    RESC(alA); __syncthreads();
  }
  SBAR(); qkt(pB0, pB1, K_lds + SHM_K, qr, r32, hi);
  finishSM(pA0, pA1, alA, l_reg, pa0, pa1, pa2, pa3); SBAR();
  pv_d0(o, vb0, pa0, pa1, pa2, pa3); partialSM(pB0, pB1, m_reg, mnB, alB);
  __syncthreads(); RESC(alB);
  finishSM(pB0, pB1, alB, l_reg, pa0, pa1, pa2, pa3); SBAR();
  pv_d0(o, vb0 + (int)SHM_V, pa0, pa1, pa2, pa3);
  if (hi == 0) li_l[r32] = l_reg; asm volatile("s_waitcnt lgkmcnt(0)" ::: "memory");
  float rli[16];
#pragma unroll
  for (int r = 0; r < 16; ++r) rli[r] = __builtin_amdgcn_rcpf(li_l[crow(r, hi)]);
  f16* Ow = Ob + (long)(wid * QBLK) * LDO;
#pragma unroll
  for (int r = 0; r < 16; ++r) { int orow = crow(r, hi);
#pragma unroll
    for (int d0 = 0; d0 < 4; ++d0) Ow[(long)orow * LDO + d0 * 32 + r32] = (f16)(o[d0][r] * rli[r]); }
#undef SLOAD
#undef SWRITE
#undef SWAIT
#undef RESC
}
#undef KSWZ
#undef SBAR
__device__ __forceinline__ void attn_unit(const Args& a, int u, char* lds) {
  int b, hq, t0, seq;
  if (u < 256) { const int qb = u & 15, r = (u >> 4) & 3, g = (u >> 6) & 1; b = u >> 7; hq = g * 4 + r; t0 = NCTX + 256 * qb; seq = L; }
  else { const int v = u - 256; b = v >> 3; hq = v & 7; t0 = 0; seq = NCTX; }
  const size_t m0 = (size_t)b * L + t0, k0 = (size_t)b * L; const int g = hq >> 2;
  const f16* Kh = (const f16*)(a.ws + WS_KN) + k0 * 512 + g * 128;
  attn_dense_body((const f16*)(a.ws + WS_QN) + m0 * 1024 + hq * 128, Kh, Kh + 256, (f16*)(a.ws + WS_AO) + m0 * 1024 + hq * 128, seq, lds);
}
}

__device__ __forceinline__ void ph_post(const Args& a, int l, int part = 3, int b0 = 0, int nb = 0) {
  const int tid = ltid(), lane = tid & 63, wave = tid >> 6;
  if (nb == 0) nb = gridDim.x;
  const int gw = (lbid() - b0) * 8 + wave, NGW = nb * 8;
  const f16* P = (const f16*)(a.ws + WS_P); f16* Y = (f16*)(a.ws + WS_Y);
  const f16* YRW = (const f16*)(a.ws + WS_YRW); const f16* AO = (const f16*)(a.ws + WS_AO); const f16* HM = (const f16*)(a.ws + WS_HM);
  const unsigned char* SIp = a.ws + WS_SI; const float* RKD = (const float*)(a.ws + WS_RKD);
  f32x4 lw[4], lb[4];
  if (part & 1) {
#pragma unroll
    for (int g = 0; g < 4; ++g) { const int c = (4 * g + (lane >> 4)) * 64 + (lane & 15) * 4; lw[g] = *(const f32x4*)(a.in[16] + l * 1024 + c); lb[g] = *(const f32x4*)(a.in[17] + l * 1024 + c); } }
  f32x4 ng[4];
  if (part & 2) {
#pragma unroll
    for (int h = 0; h < 4; ++h) ng[h] = *(const f32x4*)(a.in[21] + l * 1024 + h * 256 + lane * 4); }
  for (int m = gw; m < M; m += NGW) {
    const int lane = ltid() & 63, hq = lane >> 4, c4 = (lane & 15) * 4;
    const int b = m / L, t = m % L; const f16* pr = P + (size_t)m * NP; f16* yr = Y + (size_t)m * 3072;
    if (part & 1) {
    f16x4 ya[4], yb[4]; f32x4 vv[4]; f16x4 ga[4]; float rk[4];
#pragma unroll
    for (int g = 0; g < 4; ++g) { const int h = 4 * g + hq, c = h * 64 + c4;
      ya[g] = *(const f16x4*)(YRW + (size_t)m * 1024 + c); yb[g] = *(const f16x4*)(YRW + (size_t)(M + m) * 1024 + c);
      { const f16x4 vh = *(const f16x4*)(SIp + ((size_t)(b * 16 + h) * L + t) * SIR + 256 + c4 * 2); vv[g] = (f32x4){(float)vh[0], (float)vh[1], (float)vh[2], (float)vh[3]}; } ga[g] = *(const f16x4*)(pr + C_RWG + c);
      rk[g] = RKD[(size_t)m * 16 + h]; }
#pragma unroll
    for (int g = 0; g < 4; ++g) { const int c = (4 * g + hq) * 64 + c4; const f32x4 y = (f32x4){(float)ya[g][0] + (float)yb[g][0], (float)ya[g][1] + (float)yb[g][1], (float)ya[g][2] + (float)yb[g][2], (float)ya[g][3] + (float)yb[g][3]};
      const float mu = red16(y.x + y.y + y.z + y.w) * (1.f / 64.f); const f32x4 dv = y - mu;
      const float var = red16(dv.x * dv.x + dv.y * dv.y + dv.z * dv.z + dv.w * dv.w) * (1.f / 64.f); const float rs = rsqrtf(var + 64e-5f);
      float o[4];
#pragma unroll
      for (int e = 0; e < 4; ++e) o[e] = (dv[e] * rs * lw[g][e] + lb[g][e] + rk[g] * vv[g][e]) * silu_f((float)ga[g][e]);
      uint2 w; w.x = pkh(o[0], o[1]); w.y = pkh(o[2], o[3]); *(uint2*)(yr + c) = w; }
    }
    if (part & 2) {
    f16x4 ao[4]; f16x4 gb[4];
#pragma unroll
    for (int j = 0; j < 4; ++j) { const int c = j * 256 + lane * 4; ao[j] = *(const f16x4*)(AO + (size_t)m * 1024 + c); gb[j] = *(const f16x4*)(pr + C_ATG + c); }
    f32x4 ha[4]; f16x4 hha[4], hhb[4], go[4], gg[4];
#pragma unroll
    for (int h = 0; h < 4; ++h) { const int c = h * 256 + lane * 4; hha[h] = *(const f16x4*)(HM + (size_t)m * 1024 + c); hhb[h] = *(const f16x4*)(HM + (size_t)(M + m) * 1024 + c);
      go[h] = *(const f16x4*)(pr + C_MLO + c); gg[h] = *(const f16x4*)(pr + C_MLG + c); }
#pragma unroll
    for (int j = 0; j < 4; ++j) { const int c = j * 256 + lane * 4; float o[4];
#pragma unroll
      for (int e = 0; e < 4; ++e) o[e] = (float)ao[j][e] * silu_f((float)gb[j][e]);
      uint2 w; w.x = pkh(o[0], o[1]); w.y = pkh(o[2], o[3]); *(uint2*)(yr + 1024 + c) = w; }
    float ss[4];
#pragma unroll
    for (int h = 0; h < 4; ++h) { ha[h] = (f32x4){(float)hha[h][0] + (float)hhb[h][0], (float)hha[h][1] + (float)hhb[h][1], (float)hha[h][2] + (float)hhb[h][2], (float)hha[h][3] + (float)hhb[h][3]}; ss[h] = ha[h].x * ha[h].x + ha[h].y * ha[h].y + ha[h].z * ha[h].z + ha[h].w * ha[h].w; }
#pragma unroll
    for (int o = 32; o >= 1; o >>= 1) {
#pragma unroll
      for (int h = 0; h < 4; ++h) ss[h] += __shfl_xor(ss[h], o); }
#pragma unroll
    for (int h = 0; h < 4; ++h) { const int c = h * 256 + lane * 4; const float rstd = rsqrtf(ss[h] * (1.f / 256.f) + 1e-6f); float o[4];
#pragma unroll
      for (int e = 0; e < 4; ++e) o[e] = sigm_f((float)go[h][e]) * (ha[h][e] * rstd * ng[h][e]) * silu_f((float)gg[h][e]);
      uint2 w; w.x = pkh(o[0], o[1]); w.y = pkh(o[2], o[3]); *(uint2*)(yr + 2048 + c) = w; }
    }
  }
}

__device__ __forceinline__ void ph_sum3(const Args& a) {
  const f16* G3 = (const f16*)(a.ws + WS_G3); const f16* G3b = (const f16*)(a.ws + WS_G3B); f16* MG = (f16*)(a.ws + WS_MRG);
  const size_t n8 = (size_t)M * D / 8;
  for (size_t i = (size_t)lbid() * NT + ltid(); i < n8; i += (size_t)gridDim.x * NT) {
    const f16x8 x = *(const f16x8*)(G3 + i * 8), y = *(const f16x8*)(G3b + i * 8), z = *(const f16x8*)(G3b + (size_t)M * D + i * 8);
    f16x8 o;
#pragma unroll
    for (int e = 0; e < 8; ++e) o[e] = (f16)((float)x[e] + (float)y[e] + (float)z[e]);
    *(f16x8*)(MG + i * 8) = o; }
}

__device__ __forceinline__ void ph_final(const Args& a) {
  const int tid = ltid(), lane = tid & 63, wave = tid >> 6;
  const int gw = lbid() * 8 + wave, NGW = gridDim.x * 8;
  const float* Z = (const float*)(a.ws + WS_Z); const float* fg = a.in[24];
  for (int r = gw; r < BATCH * SEQ; r += NGW) {
    const int b = r / SEQ, t = r % SEQ; const float* zr = Z + ((size_t)b * L + NCTX + t) * D; float* o = a.out + (size_t)r * D;
    f32x4 v[8]; float ss = 0.f;
#pragma unroll
    for (int j = 0; j < 8; ++j) { v[j] = *(const f32x4*)(zr + 4 * (lane + 64 * j)); ss += v[j].x * v[j].x + v[j].y * v[j].y + v[j].z * v[j].z + v[j].w * v[j].w; }
    const float rstd = rsqrtf(wave_sum(ss) * (1.f / D) + 1e-6f);
#pragma unroll
    for (int j = 0; j < 8; ++j) { const int k = 4 * (lane + 64 * j); *(f32x4*)(o + k) = v[j] * rstd * *(const f32x4*)(fg + k); }
  }
}


#define XLAS __attribute__((address_space(3)))
#define XB_TMO      128
#define XB_XCNT(j)  (256  + 64 * (j))
#define XB_XSUB(j)  (1280 + 64 * (j))
#define XB_XGEN(j)  (2304 + 64 * (j))
#define XB_TOP      3328
#define XB_TOPGEN   3392
#define XCD_BAR_WORDS 3456
#define XB_SPIN_CAP (1u << 18)
__device__ __forceinline__ unsigned xb_ld(unsigned* p)              { return __hip_atomic_load(p, __ATOMIC_RELAXED, __HIP_MEMORY_SCOPE_AGENT); }
__device__ __forceinline__ unsigned xb_add(unsigned* p, unsigned v) { return __hip_atomic_fetch_add(p, v, __ATOMIC_RELAXED, __HIP_MEMORY_SCOPE_AGENT); }
__device__ __forceinline__ unsigned xb_xcc_id() { return (unsigned)__builtin_amdgcn_s_getreg((3 << 11) | 20) & 0xFu; }
#define XB_SPIN(cond, bar) do { unsigned _sp = 0; while (cond) { __builtin_amdgcn_s_sleep(1); \
    if ((++_sp & 255u) == 0u) { if (xb_ld(&(bar)[XB_TMO])) break; if (_sp > XB_SPIN_CAP) { atomicAdd(&(bar)[XB_TMO], 1u); break; } } } } while (0)
struct XcdBarrier { unsigned* bar; unsigned x; volatile XLAS unsigned* st; };
__device__ __forceinline__ XcdBarrier xcd_barrier_post(unsigned* bar, volatile XLAS unsigned* st) {
    XcdBarrier b; b.bar = bar; b.x = xb_xcc_id(); b.st = st;
    if (threadIdx.x == 0) (void)xb_add(&bar[XB_XCNT(b.x)], 1u);
    return b;
}
__device__ __forceinline__ void xcd_barrier_complete(unsigned* bar, unsigned x, unsigned& nloc, unsigned& nx) {
    const unsigned G = gridDim.x * gridDim.y * gridDim.z;
    unsigned sum, cnt, mine, sp = 0u;
    for (;;) {
        sum = 0u; cnt = 0u; mine = 0u;
#pragma unroll
        for (unsigned j = 0; j < 16; ++j) { const unsigned c = xb_ld(&bar[XB_XCNT(j)]); sum += c; cnt += (c > 0u) ? 1u : 0u; mine = (j == x) ? c : mine; }
        if (sum == G) break;
        __builtin_amdgcn_s_sleep(1);
        if ((++sp & 255u) == 0u) { if (xb_ld(&bar[XB_TMO])) break; if (sp > XB_SPIN_CAP) { atomicAdd(&bar[XB_TMO], 1u); break; } }
    }
    nloc = mine > 0u ? mine : 1u; nx = cnt > 0u ? cnt : 1u;
}
__device__ __forceinline__ void xcd_barrier(const XcdBarrier& b) {
    asm volatile("s_waitcnt vmcnt(0)" ::: "memory");
    __syncthreads();
    if (threadIdx.x == 0) {
        unsigned* bar = b.bar;
        __builtin_amdgcn_s_waitcnt(0);
        unsigned nloc = b.st[0], nx = b.st[1];
        if (nloc == 0u) { xcd_barrier_complete(bar, b.x, nloc, nx); b.st[0] = nloc; b.st[1] = nx; }
        const unsigned old = xb_add(&bar[XB_XSUB(b.x)], 1u);
        const unsigned gen = old / nloc;
        if (old + 1u == (gen + 1u) * nloc) {
            __builtin_amdgcn_fence(__ATOMIC_RELEASE, "agent");
            asm volatile("s_waitcnt vmcnt(0)" ::: "memory");
            const unsigned og = xb_add(&bar[XB_TOP], 1u);
            const unsigned tg = og / nx;
            if (og + 1u == (tg + 1u) * nx) xb_add(&bar[XB_TOPGEN], 1u);
            else XB_SPIN(xb_ld(&bar[XB_TOPGEN]) == tg, bar);
            __builtin_amdgcn_fence(__ATOMIC_ACQUIRE, "agent");
            xb_add(&bar[XB_XGEN(b.x)], 1u);
            asm volatile("s_waitcnt vmcnt(0)" ::: "memory");
        } else {
            XB_SPIN(xb_ld(&bar[XB_XGEN(b.x)]) == gen, bar);
            __builtin_amdgcn_fence(__ATOMIC_ACQUIRE, "agent");
            asm volatile("s_waitcnt vmcnt(0)" ::: "memory");
        }
    }
    __syncthreads();
}


__device__ __forceinline__ void sub_barrier(unsigned* bar, volatile XLAS unsigned* st, unsigned G) {
    asm volatile("s_waitcnt vmcnt(0)" ::: "memory");
    __syncthreads();
    if (threadIdx.x == 0) {
        const unsigned x = xb_xcc_id();
        __builtin_amdgcn_s_waitcnt(0);
        unsigned nloc = st[0], nx = st[1];
        if (nloc == 0u) {
            unsigned sum, cnt, mine, sp = 0u;
            for (;;) { sum = 0u; cnt = 0u; mine = 0u;
#pragma unroll
                for (unsigned j = 0; j < 16; ++j) { const unsigned c = xb_ld(&bar[XB_XCNT(j)]); sum += c; cnt += (c > 0u) ? 1u : 0u; mine = (j == x) ? c : mine; }
                if (sum == G) break;
                __builtin_amdgcn_s_sleep(1);
                if ((++sp & 255u) == 0u) { if (xb_ld(&bar[XB_TMO])) break; if (sp > XB_SPIN_CAP) { atomicAdd(&bar[XB_TMO], 1u); break; } } }
            nloc = mine > 0u ? mine : 1u; nx = cnt > 0u ? cnt : 1u; st[0] = nloc; st[1] = nx; }
        const unsigned old = xb_add(&bar[XB_XSUB(x)], 1u);
        const unsigned gen = old / nloc;
        if (old + 1u == (gen + 1u) * nloc) {
            __builtin_amdgcn_fence(__ATOMIC_RELEASE, "agent");
            asm volatile("s_waitcnt vmcnt(0)" ::: "memory");
            const unsigned og = xb_add(&bar[XB_TOP], 1u);
            const unsigned tg = og / nx;
            if (og + 1u == (tg + 1u) * nx) xb_add(&bar[XB_TOPGEN], 1u);
            else XB_SPIN(xb_ld(&bar[XB_TOPGEN]) == tg, bar);
            __builtin_amdgcn_fence(__ATOMIC_ACQUIRE, "agent");
            xb_add(&bar[XB_XGEN(x)], 1u);
            asm volatile("s_waitcnt vmcnt(0)" ::: "memory");
        } else {
            XB_SPIN(xb_ld(&bar[XB_XGEN(x)]) == gen, bar);
            __builtin_amdgcn_fence(__ATOMIC_ACQUIRE, "agent");
            asm volatile("s_waitcnt vmcnt(0)" ::: "memory");
        }
    }
    __syncthreads();
}

__device__ __forceinline__ int mix_grab(unsigned* ctr, volatile unsigned* slot) {
  __syncthreads();
  if (ltid() == 0) *slot = __hip_atomic_fetch_add(ctr, 1u, __ATOMIC_RELAXED, __HIP_MEMORY_SCOPE_AGENT);
  __syncthreads();
  return (int)*slot;
}
constexpr int MFULL = 8192;
constexpr int NSCAN = 64;
constexpr int NT_RW = 13;
__device__ __forceinline__ void ph_mix(const Args& a, int l, unsigned char* lds) {
  const int bx = lbid();
  if (bx < NSCAN) {
    if (ltid() == 0) { unsigned* pd = (unsigned*)(a.ws + WS_CTL) + 1024 + 64 * l + 32; while (xb_ld(pd) < gridDim.x) __builtin_amdgcn_s_sleep(2); __builtin_amdgcn_fence(__ATOMIC_ACQUIRE, "agent"); }
    __syncthreads();
    rw::scan_unit(a, l, bx, lds); return; }
  const int NB = gridDim.x - NSCAN;
  unsigned* bar2 = (unsigned*)(a.ws + WS_CTL) + 8192 + l * XCD_BAR_WORDS;
  volatile XLAS unsigned* st2 = (volatile XLAS unsigned*)((XLAS unsigned char*)lds + (LDS_BYTES - 48));
  if (ltid() < 2) st2[ltid()] = 0u;
  __syncthreads();
  if (ltid() == 0) (void)xb_add(&bar2[XB_XCNT(xb_xcc_id())], 1u);
  { pg8::Gemm g{(const f16*)(a.ws + WS_H), (const f16*)(a.ws + WS_WIN) + (size_t)NT_RW * 256 * D, D, D, D, 1 << 20, 0}; pg8::StaticOrder So; So.init(M, NP - NT_RW * 256, NB, bx - NSCAN);
    pg8::gemm_phase((PG8_LAS unsigned char*)lds, g, So, pg8::EpiP{(f16*)(a.ws + WS_P), NT_RW * 256}); }
  sub_barrier(bar2, st2, (unsigned)NB);
  ph_prep(a, l, lds, 2, NSCAN, NB);
  sub_barrier(bar2, st2, (unsigned)NB);
  unsigned* ctr = (unsigned*)(a.ws + WS_CTL) + 64 * (1 + l);
  volatile unsigned* slot = (volatile unsigned*)(lds + LDS_BYTES - 64);
  int u = mix_grab(ctr, slot);
  while (u < 64) { ml::mlstm_unit(a, l, u, lds); u = mix_grab(ctr, slot); }
  while (u < 336) { att::attn_unit(a, u - 64, (char*)lds); u = mix_grab(ctr, slot); }
  sub_barrier(bar2, st2, (unsigned)NB);
  ph_post(a, l, 2, NSCAN, NB);
  sub_barrier(bar2, st2, (unsigned)NB);
  { pg8::Gemm g{(const f16*)(a.ws + WS_Y), (const f16*)(a.ws + WS_WBR), 3072, BR, BR, 8, 1024}; pg8::StaticOrder So; So.init(M, 2 * D, NB, bx - NSCAN, 8);
    pg8::gemm_phase((PG8_LAS unsigned char*)lds, g, So, pg8::EpiBr{(f16*)(a.ws + WS_G3), (f16*)(a.ws + WS_G3B), (const f16*)(a.ws + WS_P), nullptr}); }
  if (l + 1 < DEPTH) ph_convert(a, l + 1, lds, 1, NSCAN, NB);
}

__global__ void __launch_bounds__(NT) mega(Args a) {
  extern __shared__ __attribute__((aligned(16))) unsigned char lds[];
  { volatile XLAS unsigned* st0 = (volatile XLAS unsigned*)((XLAS unsigned char*)lds + (LDS_BYTES - 48)); if (threadIdx.x < 6) st0[threadIdx.x] = 0u; }
  __syncthreads();
  (void)xcd_barrier_post((unsigned*)(a.ws + WS_CTL) + 4096, (volatile XLAS unsigned*)((XLAS unsigned char*)lds + (LDS_BYTES - 32)));
#define GRID_SYNC() do { XcdBarrier xb_; xb_.bar = (unsigned*)(a.ws + WS_CTL) + 4096; xb_.x = xb_xcc_id(); xb_.st = (volatile XLAS unsigned*)((XLAS unsigned char*)lds + (LDS_BYTES - 32)); xcd_barrier(xb_); } while (0)
  const f16* P = (const f16*)(a.ws + WS_P);
  ph_modv(a, lds); __syncthreads(); ph_convert(a, 0, lds, 3);
  GRID_SYNC();
#pragma unroll 1
  for (int l = 0; l < DEPTH; ++l) {
    if (l > 0) { ph_convert(a, l, lds, 2); __syncthreads(); }
    ph_norm(a, l, lds);
    GRID_SYNC();
    { pg8::Gemm g{(const f16*)(a.ws + WS_H), (const f16*)(a.ws + WS_WIN), D, D, D, 1 << 20, 0}; pg8::StaticOrder So; So.init(M, NT_RW * 256, gridDim.x, lbid());
      pg8::gemm_phase((PG8_LAS unsigned char*)lds, g, So, pg8::EpiP{(f16*)(a.ws + WS_P), 0}); }
    GRID_SYNC();
    ph_prep(a, l, lds, 1);
    asm volatile("s_waitcnt vmcnt(0)" ::: "memory"); __syncthreads();
    if (ltid() == 0) { __builtin_amdgcn_fence(__ATOMIC_RELEASE, "agent"); (void)xb_add((unsigned*)(a.ws + WS_CTL) + 1024 + 64 * l + 32, 1u); }
    ph_mix(a, l, lds);
    GRID_SYNC();
    ph_post(a, l, 1);
    GRID_SYNC();
    { pg8::Gemm g{(const f16*)(a.ws + WS_Y), (const f16*)(a.ws + WS_WBR), 3072, BR, BR, 8, 1024}; pg8::StaticOrder So; So.init(MFULL, D, gridDim.x, lbid());
      pg8::gemm_phase((PG8_LAS unsigned char*)lds, g, So, pg8::EpiBr{(f16*)(a.ws + WS_G3), (f16*)(a.ws + WS_G3B), P, (f16*)(a.ws + WS_MRG)});
      tail_gemm((const f16*)(a.ws + WS_Y), 3072, (const f16*)(a.ws + WS_WBR), BR, MFULL, M - MFULL, D, BR, lds, EpiBranchMerge{(f16*)(a.ws + WS_MRG), (const f16*)(a.ws + WS_G3B), P}); }
    GRID_SYNC();
    { pg8::Gemm g{(const f16*)(a.ws + WS_MRG), (const f16*)(a.ws + WS_WOUT), D, D, D, 1 << 20, 0}; pg8::StaticOrder So; So.init(MFULL, D, gridDim.x, lbid());
      pg8::gemm_phase((PG8_LAS unsigned char*)lds, g, So, pg8::EpiZ{a, l});
      tail_gemm((const f16*)(a.ws + WS_MRG), D, (const f16*)(a.ws + WS_WOUT), D, MFULL, M - MFULL, D, D, lds, EpiOut{a, l}); }
    GRID_SYNC();
  }
  ph_final(a);
}

extern "C" void kernel_launch(void* const* d_in, const int* in_sizes, int n_in, void* d_out, int out_size, void* d_ws, size_t ws_size, hipStream_t stream) {
  static int grid_blocks = 0;
  if (grid_blocks == 0) {
    if (n_in != 25 || out_size != BATCH * SEQ * D || ws_size < WS_END) { fprintf(stderr, "kernel_launch: bad shapes n_in %d out %d ws %zu (need %zu)\n", n_in, out_size, ws_size, (size_t)WS_END); grid_blocks = -1; return; }
    if (hipFuncSetAttribute((const void*)mega, hipFuncAttributeMaxDynamicSharedMemorySize, LDS_BYTES) != hipSuccess) { fprintf(stderr, "kernel_launch: LDS attribute failed\n"); grid_blocks = -1; return; }
    int dev = 0, cus = 0, per_cu = 0;
    hipGetDevice(&dev); hipDeviceGetAttribute(&cus, hipDeviceAttributeMultiprocessorCount, dev);
    if (hipOccupancyMaxActiveBlocksPerMultiprocessor(&per_cu, (const void*)mega, NT, LDS_BYTES) != hipSuccess || per_cu < 1) { fprintf(stderr, "kernel_launch: occupancy query says %d\n", per_cu); (void)hipGetLastError(); per_cu = 1; }
    grid_blocks = cus * 1;
    fprintf(stderr, "kernel_launch: cus %d per_cu %d grid %d\n", cus, per_cu, grid_blocks);
  }
  if (grid_blocks < 0) return;
  (void)hipMemsetAsync((char*)d_ws + WS_CTL, 0, 65536, stream);
  Args a{};
  for (int i = 0; i < 25; ++i) a.in[i] = (const float*)d_in[i];
  a.out = (float*)d_out; a.ws = (unsigned char*)d_ws;
  hipLaunchKernelGGL(mega, dim3(grid_blocks), dim3(NT), LDS_BYTES, stream, a);
  const hipError_t e = hipPeekAtLastError();
  if (e != hipSuccess) fprintf(stderr, "launch failed: %s (grid %d)\n", hipGetErrorString(e), grid_blocks);
}
```

```cpp
#include <hip/hip_runtime.h>
#include <hip/hip_cooperative_groups.h>
#include <cstdio>
#include <cstdint>

constexpr int D = 2048, BATCH = 2, SEQ = 4096, NCTX = 256, L = NCTX + SEQ, M = BATCH * L, DEPTH = 2;
constexpr int NIN = 17168, NP = 17152;
constexpr int BR = 1024;
constexpr int C_R = 0, C_K = 1024, C_V = 2048, C_WD = 3072, C_AD = 3200, C_RWG = 3328, C_ATQ = 4352, C_ATK = 5376, C_ATV = 5632,
              C_ATG = 5888, C_MLQ = 6912, C_MLK = 7424, C_MLV = 7936, C_MLO = 8960, C_MLG = 9984, C_MRG = 11008;
constexpr int GATE_COL = 9984;
constexpr int SIV = 9 * 64;
constexpr int SIR = 912;

namespace cg = cooperative_groups;
typedef _Float16 f16;
typedef _Float16 f16x8 __attribute__((ext_vector_type(8)));
typedef _Float16 f16x4 __attribute__((ext_vector_type(4)));
typedef _Float16 f16x2 __attribute__((ext_vector_type(2)));
typedef float f32x4 __attribute__((ext_vector_type(4)));
typedef float f32x2 __attribute__((ext_vector_type(2)));
typedef unsigned u32x4 __attribute__((ext_vector_type(4)));

constexpr size_t MiB = 1u << 20;
constexpr size_t al(size_t x) { return (x + 255) / 256 * 256; }
constexpr size_t WS_CTL = 0;
constexpr size_t WS_MODV = 1 * MiB;
constexpr size_t WS_WIN = WS_MODV + al((size_t)2 * 3 * 6144 * 4);
constexpr size_t WS_WBR = WS_WIN + al((size_t)NP * D * 2);
constexpr size_t WS_WOUT = WS_WBR + al((size_t)3 * D * BR * 2);
constexpr size_t WS_H = WS_WOUT + al((size_t)D * D * 2);
constexpr size_t WS_QN = WS_H;
constexpr size_t WS_KN = WS_QN + al((size_t)M * 1024 * 2);
constexpr size_t WS_GPRE = WS_H + al((size_t)M * D * 2);
constexpr size_t WS_RKD = WS_GPRE + al((size_t)M * 16 * 4);
constexpr size_t WS_P = WS_RKD + al((size_t)M * 16 * 4);
constexpr size_t WS_SI = WS_P + al((size_t)M * NP * 2);
constexpr size_t WS_G3 = WS_SI;
constexpr size_t WS_MRG = WS_G3 + al((size_t)3 * M * D * 2);
constexpr size_t WS_YRW = WS_SI + al((size_t)BATCH * 16 * L * SIV * 4);
constexpr size_t WS_AO = WS_YRW + al((size_t)2 * M * 1024 * 4);
constexpr size_t WS_HM = WS_AO + al((size_t)M * 1024 * 4);
constexpr size_t WS_Y = WS_HM + al((size_t)2 * M * 1024 * 4);
constexpr size_t WS_Z = WS_Y + al((size_t)M * 3072 * 2);
constexpr size_t WS_G3B = WS_Z + al((size_t)M * D * 4);
constexpr size_t WS_END = WS_G3B + al((size_t)2 * M * D * 2);
static_assert(WS_MRG + (size_t)M * D * 2 <= WS_YRW, "G3|MERGED overlay fits in SI");
static_assert(WS_KN + (size_t)M * 512 * 2 <= WS_GPRE, "QN|KN overlay fits in H");

#ifndef PROBE_PHASE
#define PROBE_PHASE 0
#endif
constexpr int NT = 512;
constexpr int LDS_BYTES = 152 * 1024;

struct Args { const float* in[25]; float* out; unsigned char* ws; int ph_lo, ph_hi; };

__device__ __forceinline__ int ltid() { int t = threadIdx.x; asm volatile("" : "+v"(t)); return t; }
__device__ __forceinline__ int lbid() { int t = blockIdx.x; asm volatile("" : "+s"(t)); return t; }
__device__ __forceinline__ float wave_sum(float v) {
#pragma unroll
  for (int o = 32; o >= 1; o >>= 1) v += __shfl_xor(v, o);
  return v;
}
template <int CTRL> __device__ __forceinline__ float dppf(float x) { return __int_as_float(__builtin_amdgcn_update_dpp(0, __float_as_int(x), CTRL, 0xF, 0xF, true)); }
__device__ __forceinline__ float red16(float x) { x += dppf<0xB1>(x); x += dppf<0x4E>(x); x += dppf<0x141>(x); x += dppf<0x140>(x); return x; }
template <int CTRL> __device__ __forceinline__ float dppx(float x) { return __int_as_float(__builtin_amdgcn_update_dpp(0, __float_as_int(x), CTRL, 0xF, 0xF, true)); }
__device__ __forceinline__ float wsum_fast(float x) { x += dppx<0xB1>(x); x += dppx<0x4E>(x); x += dppx<0x141>(x); x += dppx<0x140>(x); x += __shfl_xor(x, 16); x += __shfl_xor(x, 32); return x; }

__device__ __forceinline__ float wave_max(float v) {
#pragma unroll
  for (int o = 32; o >= 1; o >>= 1) v = fmaxf(v, __shfl_xor(v, o));
  return v;
}
__device__ __forceinline__ float sigm_f(float x) { return __builtin_amdgcn_rcpf(1.f + __expf(-x)); }
__device__ __forceinline__ float silu_f(float x) { return x * sigm_f(x); }
__device__ __forceinline__ float tanh_f(float x) { const float t = __expf(-2.f * fabsf(x)); return copysignf((1.f - t) * __builtin_amdgcn_rcpf(1.f + t), x); }
__device__ __forceinline__ float softplus_f(float x) { return x > 20.f ? x : log1pf(expf(x)); }
__device__ __forceinline__ unsigned pkh(float lo, float hi) { f32x2 v = {lo, hi}; f16x2 h = __builtin_convertvector(v, f16x2); return __builtin_bit_cast(unsigned, h); }

__device__ __forceinline__ const float* zrow(const Args& a, int l, int m) {
  if (l > 0) return (const float*)(a.ws + WS_Z) + (size_t)m * D;
  const int b = m / L, t = m % L;
  return t < NCTX ? a.in[2] + ((size_t)b * NCTX + t) * D : a.in[0] + ((size_t)b * SEQ + (t - NCTX)) * D;
}

__device__ __forceinline__ void ph_modv(const Args& a, unsigned char* lds) {
  const int tid = ltid(), lane = tid & 63, wave = tid >> 6;
  float* sv = (float*)lds;
  float* red = sv + 3 * 2048;
  float* modv = (float*)(a.ws + WS_MODV);
  for (int i = tid; i < 3 * 2048; i += NT) { const int w = i / 2048, k = i % 2048; sv[i] = silu_f(w < 2 ? a.in[1][w * 2048 + k] : a.in[3][k]); }
  __syncthreads();
  for (int u = lbid(); u < 192; u += gridDim.x) {
    const int l = u / 96, j0 = (u % 96) * 64;
    const float* w = a.in[5] + (size_t)l * 2048 * 6144 + j0 + lane;
    float a0 = 0.f, a1 = 0.f, a2 = 0.f;
    for (int k = wave * 256; k < wave * 256 + 256; ++k) { const float wv = w[(size_t)k * 6144]; a0 += sv[k] * wv; a1 += sv[2048 + k] * wv; a2 += sv[4096 + k] * wv; }
    red[(wave * 3 + 0) * 64 + lane] = a0; red[(wave * 3 + 1) * 64 + lane] = a1; red[(wave * 3 + 2) * 64 + lane] = a2;
    __syncthreads();
    if (tid < 192) { const int i = tid >> 6; float s = a.in[6][l * 6144 + j0 + lane];
      for (int w8 = 0; w8 < 8; ++w8) s += red[(w8 * 3 + i) * 64 + lane];
      modv[(size_t)(l * 3 + i) * 6144 + j0 + lane] = s; }
    __syncthreads();
  }
}

__device__ __forceinline__ void transpose_item(const float* W, int ldw, int ncol0, int k0, f16* WT, int K, int row0, float* scr, int lane) {
#pragma unroll 8
  for (int i = 0; i < 32; ++i) { const int kk = 2 * i + (lane >> 5); scr[kk * 33 + (lane & 31)] = W[(size_t)(k0 + kk) * ldw + ncol0 + (lane & 31)]; }
  asm volatile("s_waitcnt lgkmcnt(0)" ::: "memory");
  const int c = lane & 7;
#pragma unroll
  for (int j = 0; j < 4; ++j) { const int n = (lane >> 3) + 8 * j; const float* s = scr + (8 * c) * 33 + n;
    u32x4 o; o.x = pkh(s[0 * 33], s[1 * 33]); o.y = pkh(s[2 * 33], s[3 * 33]); o.z = pkh(s[4 * 33], s[5 * 33]); o.w = pkh(s[6 * 33], s[7 * 33]);
    *(u32x4*)(WT + (size_t)(row0 + n) * K + k0 + 8 * c) = o; }
  asm volatile("s_waitcnt lgkmcnt(0)" ::: "memory");
}
__device__ __forceinline__ void ph_convert(const Args& a, int l, unsigned char* lds, int part = 3, int b0 = 0, int nb = 0) {
  const int tid = ltid(), lane = tid & 63, wave = tid >> 6;
  float* scr = (float*)lds + wave * (64 * 33);
  if (nb == 0) nb = gridDim.x;
  const int gw = (lbid() - b0) * 8 + wave, NGW = nb * 8;
  constexpr int I_IN = (D / 64) * (NP / 32), I_BR = (BR / 64) * (D / 32), I_OUT = (D / 64) * (D / 32);
  f16* WIN = (f16*)(a.ws + WS_WIN); f16* WBR = (f16*)(a.ws + WS_WBR); f16* WOUT = (f16*)(a.ws + WS_WOUT);
  for (int it = gw + ((part & 1) ? 0 : I_IN); it < ((part & 2) ? I_IN + 3 * I_BR + I_OUT : I_IN); it += NGW) {
    int r = it;
    if (r < I_IN) { const int nblk = NP / 32, kb = r / nblk, nb = r % nblk, n0 = nb * 32;
      transpose_item(a.in[7] + (size_t)l * D * NIN, NIN, n0 + (n0 >= GATE_COL ? 16 : 0), kb * 64, WIN, D, n0, scr, lane); continue; }
    r -= I_IN;
    if (r < 3 * I_BR) { const int br = r / I_BR, q = r % I_BR, nblk = D / 32, kb = q / nblk, nb = q % nblk;
      transpose_item(a.in[22] + ((size_t)l * 3 + br) * BR * D, D, nb * 32, kb * 64, WBR, BR, br * D + nb * 32, scr, lane); continue; }
    r -= 3 * I_BR;
    { const int nblk = D / 32, kb = r / nblk, nb = r % nblk;
      transpose_item(a.in[23] + (size_t)l * D * D, D, nb * 32, kb * 64, WOUT, D, nb * 32, scr, lane); }
  }
}

__device__ __forceinline__ void ph_norm(const Args& a, int l, unsigned char* lds) {
  const int tid = ltid(), lane = tid & 63, wave = tid >> 6;
  const int gw = lbid() * 8 + wave, NGW = gridDim.x * 8;
  float* wg = (float*)lds;
  { const float* w = a.in[7] + (size_t)l * D * NIN + GATE_COL;
    for (int i = tid; i < 2048 * 4; i += NT) { const int k = i >> 2, q = i & 3; const f32x4 v = *(const f32x4*)(w + (size_t)k * NIN + q * 4);
      wg[(q * 4 + 0) * 2048 + k] = v.x; wg[(q * 4 + 1) * 2048 + k] = v.y; wg[(q * 4 + 2) * 2048 + k] = v.z; wg[(q * 4 + 3) * 2048 + k] = v.w; } }
  __syncthreads();
  const float* modv = (const float*)(a.ws + WS_MODV) + (size_t)l * 3 * 6144;
  const float* ng = a.in[4] + l * D;
  f16* H = (f16*)(a.ws + WS_H); float* GP = (float*)(a.ws + WS_GPRE);
  f32x4 Gv[8], Sv[8]; int kcur = -1;
  for (int m = gw; m < M; m += NGW) {
    const int b = m / L, t = m % L; const float* zr = zrow(a, l, m);
    const int kind = __builtin_amdgcn_readfirstlane(t < NCTX ? 2 : b);
    if (kind != kcur) { kcur = kind; const float* mv = modv + (size_t)kind * 6144;
#pragma unroll
      for (int j = 0; j < 8; ++j) { const int k = 4 * (lane + 64 * j); Gv[j] = *(const f32x4*)(ng + k) * (1.f + *(const f32x4*)(mv + 2048 + k)); Sv[j] = *(const f32x4*)(mv + k); } }
    f32x4 v[8]; float ss = 0.f;
#pragma unroll
    for (int j = 0; j < 8; ++j) { v[j] = *(const f32x4*)(zr + 4 * (lane + 64 * j)); ss += v[j].x * v[j].x + v[j].y * v[j].y + v[j].z * v[j].z + v[j].w * v[j].w; }
    const float rstd = rsqrtf(wave_sum(ss) * (1.f / D) + 1e-6f);
#pragma unroll
    for (int j = 0; j < 8; ++j) { const int k = 4 * (lane + 64 * j);
      v[j] = (v[j] * rstd) * Gv[j] + Sv[j];
      uint2 o; o.x = pkh(v[j].x, v[j].y); o.y = pkh(v[j].z, v[j].w); *(uint2*)(H + (size_t)m * D + k) = o; }
    float p[16];
#pragma unroll
    for (int g = 0; g < 16; ++g) { float pp = 0.f;
#pragma unroll
      for (int j = 0; j < 8; ++j) { const f32x4 w = *(const f32x4*)(wg + g * 2048 + 4 * (lane + 64 * j)); pp += v[j].x * w.x + v[j].y * w.y + v[j].z * w.z + v[j].w * w.w; }
      p[g] = pp; if ((g & 1) == 1) __builtin_amdgcn_sched_barrier(0); }
    const bool b3 = lane & 8, b2 = lane & 4, b1 = lane & 2, b0 = lane & 1;
#define NRM_DPP(x_, ctrl_) __int_as_float(__builtin_amdgcn_update_dpp(0, __float_as_int(x_), ctrl_, 0xF, 0xF, true))
    float q8[8], q4[4], q2[2];
#pragma unroll
    for (int g = 0; g < 8; ++g) { const float keep = b3 ? p[g + 8] : p[g], send = b3 ? p[g] : p[g + 8]; q8[g] = keep + NRM_DPP(send, 0x128); }
#pragma unroll
    for (int g = 0; g < 4; ++g) { const float keep = b2 ? q8[g + 4] : q8[g], send = b2 ? q8[g] : q8[g + 4]; q4[g] = keep + NRM_DPP(send, 0x141); }
#pragma unroll
    for (int g = 0; g < 2; ++g) { const float keep = b1 ? q4[g + 2] : q4[g], send = b1 ? q4[g] : q4[g + 2]; q2[g] = keep + NRM_DPP(send, 0x4E); }
    float gsum = (b0 ? q2[1] : q2[0]) + NRM_DPP((b0 ? q2[0] : q2[1]), 0xB1);
#undef NRM_DPP
    gsum += __shfl_xor(gsum, 16); gsum += __shfl_xor(gsum, 32);
    if (lane < 16) GP[(size_t)m * 16 + lane] = gsum;
  }
}

template <class Epi>
__device__ __forceinline__ void tail_gemm(const f16* A, int lda, const f16* Bt, int ldb, int m0, int Mrows, int Ncols, int K, unsigned char* lds, const Epi& epi) {
  const int tid = ltid(), lane = tid & 63, wave = __builtin_amdgcn_readfirstlane(tid >> 6), fr = lane & 15, fq = lane >> 4;
  const int ntn = Ncols / 64, nun = (Mrows / 64) * ntn, KW = K / 8;
  float* part = (float*)lds;
  for (int u = lbid(); u < nun; u += (int)gridDim.x) {
    const int tm = u / ntn, tn = u % ntn;
    f32x4 acc[4][4];
#pragma unroll
    for (int i = 0; i < 4; ++i)
#pragma unroll
      for (int j = 0; j < 4; ++j) acc[i][j] = (f32x4){0.f, 0.f, 0.f, 0.f};
    const f16* ap = A + (size_t)(m0 + tm * 64 + fr) * lda + wave * KW + fq * 8; const f16* bp = Bt + (size_t)(tn * 64 + fr) * ldb + wave * KW + fq * 8;
    for (int k0 = 0; k0 < KW; k0 += 64) {
      f16x8 af[4], bf[4], an[4], bn[4];
#pragma unroll
      for (int i = 0; i < 4; ++i) { af[i] = *(const f16x8*)(ap + (size_t)i * 16 * lda + k0); bf[i] = *(const f16x8*)(bp + (size_t)i * 16 * ldb + k0);
                                    an[i] = *(const f16x8*)(ap + (size_t)i * 16 * lda + k0 + 32); bn[i] = *(const f16x8*)(bp + (size_t)i * 16 * ldb + k0 + 32); }
#pragma unroll
      for (int i = 0; i < 4; ++i)
#pragma unroll
        for (int j = 0; j < 4; ++j) { acc[i][j] = __builtin_amdgcn_mfma_f32_16x16x32_f16(af[i], bf[j], acc[i][j], 0, 0, 0); acc[i][j] = __builtin_amdgcn_mfma_f32_16x16x32_f16(an[i], bn[j], acc[i][j], 0, 0, 0); }
    }
    __syncthreads();
#pragma unroll
    for (int i = 0; i < 4; ++i)
#pragma unroll
      for (int j = 0; j < 4; ++j)
#pragma unroll
        for (int r = 0; r < 4; ++r) part[((wave * 16 + i * 4 + j) * 4 + r) * 64 + lane] = acc[i][j][r];
    __syncthreads();
#pragma unroll
    for (int q = 0; q < 2; ++q) { const int f = 2 * wave + q, i = f >> 2, j = f & 3;
#pragma unroll
      for (int r = 0; r < 4; ++r) { float v = 0.f;
#pragma unroll
        for (int w8 = 0; w8 < 8; ++w8) v += part[((w8 * 16 + f) * 4 + r) * 64 + lane];
        epi(m0 + tm * 64 + i * 16 + fq * 4 + r, tn * 64 + j * 16 + fr, v); } }
  }
}
struct EpiBranch { f16* O; const f16* P; int br; __device__ __forceinline__ void operator()(int m, int n, float v) const {
  const float g = sigm_f((float)P[(size_t)m * NP + C_MRG + br * D + n]); O[(size_t)m * D + n] = (f16)(g * v); } };
struct EpiBranchMerge { f16* MRG; const f16* G3b; const f16* P; __device__ __forceinline__ void operator()(int m, int n, float v) const {
  const float g = sigm_f((float)P[(size_t)m * NP + C_MRG + n]); MRG[(size_t)m * D + n] = (f16)(g * v + (float)G3b[(size_t)m * D + n] + (float)G3b[(size_t)M * D + (size_t)m * D + n]); } };
struct EpiOut { Args a; int l; __device__ __forceinline__ void operator()(int m, int n, float v) const {
  const int b = m / L, t = m % L; const float gt = ((const float*)(a.ws + WS_MODV))[(size_t)(l * 3 + (t < NCTX ? 2 : b)) * 6144 + 4096 + n];
  ((float*)(a.ws + WS_Z))[(size_t)m * D + n] = zrow(a, l, m)[n] + gt * v; } };


namespace pg8 {
#define PG8_LAS __attribute__((address_space(3)))
constexpr int BM = 256, BK = 64, HALF = 128, HTB = HALF * BK * 2  , STAGE_BYTES = 8 * HTB, NXCD = 8, WGM = 8;
__host__ __device__ __forceinline__ int lds_byte(int r, int c) { const int st = (r >> 4) * 2 + (c >> 5), rr = r & 15, cc = c & 31, ob = rr * 64 + cc * 2; return st * 1024 + (ob ^ (((ob >> 9) & 1) << 5)); }
__host__ __device__ __forceinline__ void stage_rc(int b, int& R, int& C) { const int st = b / 1024, sb = b % 1024, swz = sb ^ (((sb >> 9) & 1) << 5); R = (st >> 1) * 16 + swz / 64; C = (st & 1) * 32 + (swz % 64) / 2; }
__host__ __device__ __forceinline__ int perm32(int rho) { const int n = rho >> 4, i = rho & 15; return 8 * (i >> 2) + 4 * n + (i & 3); }
struct Unit { int pm, pn; };
struct Gemm { const f16* A; const f16* Bt; int lda, ldb, K, pn_grp, a_grp_cols; };
struct StaticOrder {
    int nM, nN, nwg, G, c, pn_off;
    __device__ void init(int M_, int N_, int G_, int c_, int pn_off_ = 0) { nM = M_ / BM; nN = N_ / BM; nwg = nM * nN; G = G_; c = c_; pn_off = pn_off_; }
    __device__ bool next(int i, Unit& u) const {
        const long Lx = (long)i * G + c; if (Lx >= nwg) return false;
        int wgid = (int)Lx; { const int q = nwg / NXCD, r = nwg % NXCD, xcd = wgid % NXCD, off = wgid / NXCD; wgid = (xcd < r ? xcd * (q + 1) : r * (q + 1) + (xcd - r) * q) + off; }
        const int nig = WGM * nN, gid = wgid / nig, fm = gid * WGM, gsz = (nM - fm) < WGM ? (nM - fm) : WGM;
        u.pm = fm + ((wgid % nig) % gsz); u.pn = pn_off + (wgid % nig) / gsz; return true;
    }
};
template <class Epi>
__device__ __forceinline__ void gemm_phase(PG8_LAS unsigned char* lds, const Gemm g, const StaticOrder& S, const Epi& E) {
    const int tid = ltid(), wid = __builtin_amdgcn_readfirstlane(tid >> 6), lane = tid & 63, wr = wid >> 2, wc = wid & 3, fr = lane & 15, fq = lane >> 4;
    const int K = g.K, nt = K / BK;
    unsigned voffA[2], voffB[2];
#pragma unroll
    for (int i = 0; i < 2; ++i) { int R, C; stage_rc(tid * 16 + i * 8192, R, C); const int Rb = Epi::PERM ? ((R & ~31) + perm32(R & 31)) : R;
        voffA[i] = (unsigned)(R * g.lda + C) * 2u; voffB[i] = (unsigned)(Rb * g.ldb + C) * 2u; }
    const size_t kstep = (size_t)(BK * 2);
    const size_t hstepA = (size_t)HALF * g.lda * 2, hstepB = (size_t)HALF * g.ldb * 2;
    const size_t tstepA = 2 * hstepA, tstepB = 2 * hstepB;
    const unsigned ldsw = (unsigned)wid * 1024u;
    const int aoff = lds_byte(wr * 64 + fr, fq * 8), boff = lds_byte(wc * 32 + fr, fq * 8);
#define PG8_SA(b, h) (((b) * 2 + (h)) * HTB)
#define PG8_SB(b, h) ((4 + (b) * 2 + (h)) * HTB)
#define PG8_STAGE(bufoff, gbase, voff) do { _Pragma("unroll") for (int _i = 0; _i < 2; ++_i) \
        __builtin_amdgcn_global_load_lds((const unsigned*)((const char*)(gbase) + (voff)[_i]), (PG8_LAS unsigned*)(lds + (bufoff) + ldsw + _i * 8192), 16, 0, 0); } while (0)
#define PG8_LDA(dst, b, h) do { _Pragma("unroll") for (int m = 0; m < 4; ++m) _Pragma("unroll") for (int k = 0; k < 2; ++k) dst[m][k] = *(const PG8_LAS f16x8*)(lds + PG8_SA(b, h) + aoff + m * 2048 + k * 1024); } while (0)
#define PG8_LDB(dst, b, h) do { _Pragma("unroll") for (int n = 0; n < 2; ++n) _Pragma("unroll") for (int k = 0; k < 2; ++k) dst[n][k] = *(const PG8_LAS f16x8*)(lds + PG8_SB(b, h) + boff + n * 2048 + k * 1024); } while (0)
#define PG8_MMA(ai, bj, At, Bt) do { __builtin_amdgcn_s_setprio(1); _Pragma("unroll") for (int m = 0; m < 4; ++m) _Pragma("unroll") for (int n = 0; n < 2; ++n) _Pragma("unroll") for (int k = 0; k < 2; ++k) \
        acc[ai][bj][m][n] = __builtin_amdgcn_mfma_f32_16x16x32_f16(Bt[n][k], At[m][k], acc[ai][bj][m][n], 0, 0, 0); __builtin_amdgcn_s_setprio(0); } while (0)
#define PG8_WAIT_V(n) asm volatile("s_waitcnt vmcnt(" #n ")" ::: "memory")
#define PG8_WAIT_L(n) asm volatile("s_waitcnt lgkmcnt(" #n ")" ::: "memory")
#define PG8_BAR __builtin_amdgcn_s_barrier()
#define PG8_SCHED __builtin_amdgcn_sched_barrier(0)
#define PG8_UA(u) ((const char*)g.A + (size_t)(u).pm * tstepA + (size_t)((u).pn / g.pn_grp) * g.a_grp_cols * 2)
#define PG8_UB(u) ((const char*)g.Bt + (size_t)(u).pn * tstepB)
    Unit cur, nxt; int ui = 0;
    if (!S.next(0, cur)) return;
    f32x4 acc[2][2][4][2];
#pragma unroll
    for (int a = 0; a < 2; ++a)
#pragma unroll
        for (int b = 0; b < 2; ++b)
#pragma unroll
            for (int m = 0; m < 4; ++m)
#pragma unroll
                for (int n = 0; n < 2; ++n) acc[a][b][m][n] = (f32x4){0.f, 0.f, 0.f, 0.f};
    f16x8 At[4][2], B0[2][2], B1[2][2];
    const char* cA = PG8_UA(cur); const char* cB = PG8_UB(cur);
    PG8_STAGE(PG8_SB(0, 0), cB, voffB); PG8_STAGE(PG8_SB(0, 1), cB + hstepB, voffB); PG8_STAGE(PG8_SA(0, 0), cA, voffA); PG8_STAGE(PG8_SA(0, 1), cA + hstepA, voffA);
    if (wr == 1) PG8_BAR;
    PG8_WAIT_V(2); PG8_BAR;
    PG8_STAGE(PG8_SB(1, 0), cB + kstep, voffB); PG8_STAGE(PG8_SA(1, 0), cA + kstep, voffA); PG8_STAGE(PG8_SB(1, 1), cB + hstepB + kstep, voffB);
    PG8_WAIT_V(6); PG8_BAR;
    for (;;) {
        const bool has_next = S.next(ui + 1, nxt);
        const char* nA = has_next ? PG8_UA(nxt) : cA; const char* nB = has_next ? PG8_UB(nxt) : cB;
        for (int t = 0; t < nt; t += 2) {
            const bool last = (t == nt - 2);
            const char* a1 = cA + (size_t)(t + 1) * kstep;
            const char* a2 = last ? nA : cA + (size_t)(t + 2) * kstep; const char* b2 = last ? nB : cB + (size_t)(t + 2) * kstep;
            const char* a3 = a2 + kstep; const char* b3 = b2 + kstep;
            PG8_LDB(B0, 0, 0); PG8_LDB(B1, 0, 1); PG8_SCHED; PG8_LDA(At, 0, 0); PG8_STAGE(PG8_SA(1, 1), a1 + hstepA, voffA);
            PG8_WAIT_V(8); PG8_WAIT_L(0); PG8_BAR; PG8_MMA(0, 0, At, B0); PG8_MMA(0, 1, At, B1); PG8_BAR; PG8_SCHED;
            PG8_LDA(At, 0, 1); PG8_STAGE(PG8_SB(0, 0), b2, voffB); PG8_STAGE(PG8_SB(0, 1), b2 + hstepB, voffB); PG8_STAGE(PG8_SA(0, 0), a2, voffA);
            PG8_WAIT_V(8); PG8_WAIT_L(0); PG8_BAR; PG8_MMA(1, 0, At, B0); PG8_MMA(1, 1, At, B1); PG8_BAR; PG8_SCHED;
            PG8_LDB(B0, 1, 0); PG8_LDB(B1, 1, 1); PG8_SCHED; PG8_LDA(At, 1, 0); PG8_STAGE(PG8_SA(0, 1), a2 + hstepA, voffA);
            PG8_WAIT_V(8); PG8_WAIT_L(0); PG8_BAR; PG8_MMA(0, 0, At, B0); PG8_MMA(0, 1, At, B1); PG8_BAR; PG8_SCHED;
            PG8_LDA(At, 1, 1); PG8_STAGE(PG8_SB(1, 0), b3, voffB); PG8_STAGE(PG8_SB(1, 1), b3 + hstepB, voffB); PG8_STAGE(PG8_SA(1, 0), a3, voffA);
            PG8_WAIT_V(8); PG8_WAIT_L(0); PG8_BAR; PG8_MMA(1, 0, At, B0); PG8_MMA(1, 1, At, B1); PG8_BAR; PG8_SCHED;
        }
        if (wr == 0) PG8_BAR;
        E(acc, cur, wr, wc, fr, fq);
        if (!has_next) break;
#pragma unroll
        for (int a = 0; a < 2; ++a)
#pragma unroll
            for (int b = 0; b < 2; ++b)
#pragma unroll
                for (int m = 0; m < 4; ++m)
#pragma unroll
                    for (int n = 0; n < 2; ++n) acc[a][b][m][n] = (f32x4){0.f, 0.f, 0.f, 0.f};
        cur = nxt; cA = nA; cB = nB; ++ui;
        if (wr == 1) PG8_BAR;
    }
    PG8_WAIT_V(0);
    PG8_BAR;
#undef PG8_SA
#undef PG8_SB
#undef PG8_STAGE
#undef PG8_LDA
#undef PG8_LDB
#undef PG8_MMA
#undef PG8_WAIT_V
#undef PG8_WAIT_L
#undef PG8_BAR
#undef PG8_SCHED
#undef PG8_UA
#undef PG8_UB
}
struct EpiP { static constexpr bool PERM = true; f16* O; int coff;
    __device__ __forceinline__ void operator()(const f32x4 (&acc)[2][2][4][2], const Unit& u, int wr, int wc, int fr, int fq) const {
        const int row0 = u.pm * BM + wr * 64 + fr, col0 = coff + u.pn * BM + wc * 32 + 8 * fq;
#pragma unroll
        for (int ai = 0; ai < 2; ++ai)
#pragma unroll
            for (int m = 0; m < 4; ++m) { f16* rowp = O + (size_t)(row0 + ai * HALF + m * 16) * NP + col0;
#pragma unroll
                for (int bj = 0; bj < 2; ++bj) { const f32x4 v0 = acc[ai][bj][m][0], v1 = acc[ai][bj][m][1];
                    u32x4 w; w.x = pkh(v0[0], v0[1]); w.y = pkh(v0[2], v0[3]); w.z = pkh(v1[0], v1[1]); w.w = pkh(v1[2], v1[3]);
                    *(u32x4*)(rowp + bj * HALF) = w; } }
    }
};
struct EpiBr { static constexpr bool PERM = true; f16* G3; f16* G3b; const f16* P; f16* MRG;
    __device__ __forceinline__ void operator()(const f32x4 (&acc)[2][2][4][2], const Unit& u, int wr, int wc, int fr, int fq) const {
        const int row0 = u.pm * BM + wr * 64 + fr, colg = u.pn * BM + wc * 32 + 8 * fq, br = u.pn >> 3, col0 = colg - br * D;
        f16* Ob = MRG ? MRG : G3b + (size_t)(br - 1) * M * D;
#pragma unroll
        for (int ai = 0; ai < 2; ++ai)
#pragma unroll
            for (int m = 0; m < 4; ++m) { const int row = row0 + ai * HALF + m * 16;
#pragma unroll
                for (int bj = 0; bj < 2; ++bj) { const f32x4 v0 = acc[ai][bj][m][0], v1 = acc[ai][bj][m][1];
                    const f16x8 gp = *(const f16x8*)(P + (size_t)row * NP + C_MRG + colg + bj * HALF);
                    float o[8];
#pragma unroll
                    for (int e = 0; e < 8; ++e) o[e] = (e < 4 ? v0[e] : v1[e - 4]) * __builtin_amdgcn_rcpf(1.f + __expf(-(float)gp[e]));
                    if (MRG) { const f16x8 x1 = *(const f16x8*)(G3b + (size_t)row * D + col0 + bj * HALF), x2 = *(const f16x8*)(G3b + (size_t)M * D + (size_t)row * D + col0 + bj * HALF);
#pragma unroll
                        for (int e = 0; e < 8; ++e) o[e] += (float)x1[e] + (float)x2[e]; }
                    u32x4 w; w.x = pkh(o[0], o[1]); w.y = pkh(o[2], o[3]); w.z = pkh(o[4], o[5]); w.w = pkh(o[6], o[7]);
                    *(u32x4*)(Ob + (size_t)row * D + col0 + bj * HALF) = w; } }
    }
};
struct EpiZ { static constexpr bool PERM = false; Args a; int l;
    __device__ __forceinline__ void operator()(const f32x4 (&acc)[2][2][4][2], const Unit& u, int wr, int wc, int fr, int fq) const {
        const int row0 = u.pm * BM + wr * 64 + fr, col0 = u.pn * BM + wc * 32 + 4 * fq;
        float* Z = (float*)(a.ws + WS_Z); const float* modv = (const float*)(a.ws + WS_MODV) + (size_t)l * 3 * 6144 + 4096;
        const int tb = (u.pm * BM) / L, tt = (u.pm * BM) % L; const float* gt = modv + (size_t)(tt < NCTX ? 2 : tb) * 6144;
        f32x4 gv[2][2];
#pragma unroll
        for (int bj = 0; bj < 2; ++bj)
#pragma unroll
            for (int n = 0; n < 2; ++n) gv[bj][n] = *(const f32x4*)(gt + col0 + bj * HALF + n * 16);
#pragma unroll
        for (int ai = 0; ai < 2; ++ai)
#pragma unroll
            for (int m = 0; m < 4; ++m) { const int row = row0 + ai * HALF + m * 16;
                const float* zr = zrow(a, l, row);
#pragma unroll
                for (int bj = 0; bj < 2; ++bj)
#pragma unroll
                    for (int n = 0; n < 2; ++n) { const int c = col0 + bj * HALF + n * 16;
                        const f32x4 zo = *(const f32x4*)(zr + c);
                        *(f32x4*)(Z + (size_t)row * D + c) = zo + gv[bj][n] * acc[ai][bj][m][n]; } }
    }
};
}

__device__ __forceinline__ float shifted(const f16* P, const float* mu, int m, int col) {
  const int t = m % L; const float s = (float)P[(size_t)m * NP + col];
  const float pv = (t == 0 || t == NCTX) ? 0.f : (float)P[(size_t)(m - 1) * NP + col];
  const float nx = (t == L - 1 || t == NCTX - 1) ? 0.f : (float)P[(size_t)(m + 1) * NP + col];
  return s + mu[col] * (pv - s) + mu[3328 + col] * (nx - s);
}
namespace pp {
constexpr int WTP = 72, RAWP = 456, XAP = 72;
constexpr int OFF_WT = 0, OFF_RAW = OFF_WT + 4 * 64 * WTP * 2, OFF_XA = OFF_RAW + 34 * RAWP * 2, OFF_SH = OFF_XA + 4 * 32 * XAP * 2, OFF_NR = OFF_SH + 3 * 32 * 64 * 4, OFF_CST = OFF_NR + 256, OFF_END = OFF_CST + 1344 * 4;
static_assert(OFF_END <= LDS_BYTES, "prep LDS");
}
__device__ __forceinline__ void ph_prep(const Args& a, int l, unsigned char* lds, int part = 3, int b0 = 0, int nb = 0) {
  using namespace pp;
  const int tid = ltid(), lane = tid & 63, wave = __builtin_amdgcn_readfirstlane(tid >> 6), fr = lane & 15, fq = lane >> 4;
  const f16* P = (const f16*)(a.ws + WS_P);
  const float* mu = a.in[8] + (size_t)l * 2 * 3328;
  f16* WT = (f16*)(lds + OFF_WT); f16* RAW = (f16*)(lds + OFF_RAW); f16* XA = (f16*)(lds + OFF_XA); float* SH = (float*)(lds + OFF_SH); float* NRI = (float*)(lds + OFF_NR); float* CST = (float*)(lds + OFF_CST);
  float* RKD = (float*)(a.ws + WS_RKD);
  int cur_h = -1;
  const int NU = 272 * 16;
  f16x8 pre[4];
#define PREP_LOAD(u_) do { const int h_ = (u_) & 15, m0_ = ((u_) >> 4) * 32; \
    _Pragma("unroll") for (int i = 0; i < 4; ++i) { const int q = tid + NT * i; if (q < 34 * 56) { const int row = q / 56, cu = q % 56; int mm = m0_ - 1 + row; mm = mm < 0 ? 0 : (mm > M - 1 ? M - 1 : mm); \
      const int col = cu < 24 ? (cu >> 3) * 1024 + h_ * 64 + (cu & 7) * 8 : C_WD + (cu - 24) * 8; pre[i] = *(const f16x8*)(P + (size_t)mm * NP + col); } } } while (0)
  const int pg_ = lbid() >> 4, ph_ = lbid() & 15;
  const bool pbal = (gridDim.x == 256);
  const int pt0 = pbal ? pg_ * 17 : pg_, pcnt = pbal ? 17 : (272 - pg_ + (int)(gridDim.x >> 4) - 1) / (int)(gridDim.x >> 4), pstep = pbal ? 1 : (int)(gridDim.x >> 4);
  (void)NU;
  if ((part & 1) && pcnt > 0) PREP_LOAD((pt0 * 16 + ph_));
  if (part & 1)
  for (int pk = 0; pk < pcnt; ++pk) { const int u = (pt0 + pk * pstep) * 16 + ph_;
    const int tid = ltid(), lane = tid & 63, wave = __builtin_amdgcn_readfirstlane(tid >> 6), fr = lane & 15, fq = lane >> 4;
    const int h = u & 15, m0 = (u >> 4) * 32, b = m0 / L, t0 = m0 % L;
    __syncthreads();
    if (h != cur_h) { cur_h = h;
#pragma unroll 4
      for (int i = tid; i < 4 * 64 * 64; i += NT) { const int mt = i >> 12, j = (i >> 6) & 63, c = i & 63, d = mt >> 1;
        const float* src = (mt & 1) ? a.in[11] : a.in[9];
        WT[(mt * 64 + c) * WTP + j] = (f16)src[(((size_t)l * 2 + d) * 64 + j) * 1024 + h * 64 + c]; }
      for (int i = tid; i < 1344; i += NT) { float v;
        if (i < 512) v = mu[(i >> 8) * 3328 + C_WD + (i & 255)];
        else if (i < 896) { const int q = i - 512, w1 = q / 192, e = q % 192; v = mu[w1 * 3328 + (e >> 6) * 1024 + h * 64 + (e & 63)]; }
        else if (i < 960) v = a.in[13][l * 1024 + h * 64 + (i - 896)];
        else if (i < 1024) v = a.in[14][l * 1024 + h * 64 + (i - 960)];
        else if (i < 1088) v = a.in[15][l * 1024 + h * 64 + (i - 1024)];
        else if (i < 1216) { const int q = i - 1088; v = a.in[10][(l * 2 + (q >> 6)) * 1024 + h * 64 + (q & 63)]; }
        else { const int q = i - 1216; v = a.in[12][(l * 2 + (q >> 6)) * 1024 + h * 64 + (q & 63)]; }
        CST[i] = v; } }
#pragma unroll
    for (int i = 0; i < 4; ++i) { const int q = tid + NT * i; if (q < 34 * 56) { const int row = q / 56, cu = q % 56;
      *(f16x8*)(RAW + row * RAWP + (cu < 24 ? cu * 8 : 192 + (cu - 24) * 8)) = pre[i]; } }
    __syncthreads();
    if (pk + 1 < pcnt) PREP_LOAD((u + pstep * 16));
    { const int tok = tid >> 4, cg = tid & 15, t = t0 + tok; const bool zp = (t == 0 || t == NCTX), zn = (t == L - 1 || t == NCTX - 1);
      const f16* rp = RAW + tok * RAWP + 192 + 16 * cg;
      const int c0 = 16 * cg, mt = c0 < 128 ? 2 * (c0 >> 6) : 2 * ((c0 - 128) >> 6) + 1, j0 = c0 & 63;
#pragma unroll
      for (int hf = 0; hf < 2; ++hf) { const f16x8 pv = *(const f16x8*)(rp + hf * 8), cv = *(const f16x8*)(rp + RAWP + hf * 8), nv = *(const f16x8*)(rp + 2 * RAWP + hf * 8);
        const float* m0p = CST + c0 + hf * 8; f16x8 o;
#pragma unroll
        for (int e = 0; e < 8; ++e) { const float sv = (float)cv[e], p = zp ? 0.f : (float)pv[e], n = zn ? 0.f : (float)nv[e];
          float x = sv + m0p[e] * (p - sv) + m0p[256 + e] * (n - sv); if (!(mt & 1)) x = tanh_f(x); o[e] = (f16)x; }
        *(f16x8*)(XA + (mt * 32 + tok) * XAP + j0 + hf * 8) = o; } }
#pragma unroll
    for (int it = 0; it < 2; ++it) { const int q = tid + NT * it; if (q < 32 * 24) { const int tok = q / 24, g8 = q % 24, seg = g8 >> 3, ch = (g8 & 7) * 8, t = t0 + tok;
        const bool zp = (t == 0 || t == NCTX), zn = (t == L - 1 || t == NCTX - 1);
        const f16* rp = RAW + tok * RAWP + g8 * 8; const f16x8 pv = *(const f16x8*)rp, cv = *(const f16x8*)(rp + RAWP), nv = *(const f16x8*)(rp + 2 * RAWP);
        const float* m0p = CST + 512 + seg * 64 + ch; float o[8];
#pragma unroll
        for (int e = 0; e < 8; ++e) { const float sv = (float)cv[e], p = zp ? 0.f : (float)pv[e], n = zn ? 0.f : (float)nv[e]; o[e] = sv + m0p[e] * (p - sv) + m0p[192 + e] * (n - sv); }
        float* dst = SH + (seg * 32 + tok) * 64 + ch; *(f32x4*)dst = (f32x4){o[0], o[1], o[2], o[3]}; *(f32x4*)(dst + 4) = (f32x4){o[4], o[5], o[6], o[7]}; } }
    __syncthreads();
    const int ti = wave & 1, d = (wave >> 1) & 1, chalf = wave >> 2;
    f32x4 acc[2][2];
#pragma unroll
    for (int m2 = 0; m2 < 2; ++m2)
#pragma unroll
      for (int c2 = 0; c2 < 2; ++c2) { acc[m2][c2] = (f32x4){0.f, 0.f, 0.f, 0.f};
#pragma unroll
        for (int ks = 0; ks < 2; ++ks) acc[m2][c2] = __builtin_amdgcn_mfma_f32_16x16x32_f16(*(const f16x8*)(XA + ((2 * d + m2) * 32 + 16 * ti + fr) * XAP + ks * 32 + fq * 8),
                                                                                             *(const f16x8*)(WT + ((2 * d + m2) * 64 + 16 * (2 * chalf + c2) + fr) * WTP + ks * 32 + fq * 8), acc[m2][c2], 0, 0, 0); }
    __syncthreads();
    unsigned char* SR = lds + OFF_RAW;
    { const int tok = 4 * wave + (lane >> 4), c4 = (lane & 15) * 4;
      const f32x4 r4 = *(const f32x4*)(SH + (0 * 32 + tok) * 64 + c4), k4 = *(const f32x4*)(SH + (1 * 32 + tok) * 64 + c4), v4 = *(const f32x4*)(SH + (2 * 32 + tok) * 64 + c4);
      const f32x4 kkw = *(const f32x4*)(CST + 896 + c4), rkw = *(const f32x4*)(CST + 1024 + c4);
      const f32x4 kk = k4 * kkw, rkp = r4 * k4 * rkw;
      const float n2 = red16((kk.x * kk.x + kk.y * kk.y) + (kk.z * kk.z + kk.w * kk.w)), rk = red16((rkp.x + rkp.y) + (rkp.z + rkp.w));
      const float inv = 1.f / fmaxf(sqrtf(n2), 1e-12f);
      unsigned char* o = SR + tok * SIR + c4 * 2;
      uint2 w; w.x = pkh(r4.x, r4.y); w.y = pkh(r4.z, r4.w); *(uint2*)o = w;
      w.x = pkh(k4.x, k4.y); w.y = pkh(k4.z, k4.w); *(uint2*)(o + 128) = w;
      w.x = pkh(v4.x, v4.y); w.y = pkh(v4.z, v4.w); *(uint2*)(o + 256) = w;
      if ((lane & 15) == 0) { *(f32x4*)(SR + tok * SIR + 384) = (f32x4){inv, 0.f, 0.f, 0.f}; RKD[(size_t)(m0 + tok) * 16 + h] = rk; } }
#pragma unroll
    for (int c2 = 0; c2 < 2; ++c2) { const int ch = 16 * (2 * chalf + c2) + fr, c = h * 64 + ch;
      const float w0v = CST[1088 + d * 64 + ch], a0v = CST[1216 + d * 64 + ch];
#pragma unroll
      for (int r = 0; r < 4; ++r) { const int tok = 16 * ti + 4 * fq + r;
        const float wl = w0v + acc[0][c2][r]; const float dec = __expf(-0.6065306597126334f * sigm_f(wl));
        const float ag = sigm_f(a0v + acc[1][c2][r]);
        unsigned char* o = SR + tok * SIR + 400 + d * 256;
        ((f16*)o)[ch] = (f16)(1.f - dec); ((f16*)(o + 128))[ch] = (f16)ag; } }
    __syncthreads();
    { unsigned char* dstg = a.ws + WS_SI + ((size_t)(b * 16 + h) * L + t0) * SIR;
#pragma unroll
      for (int i = 0; i < 4; ++i) { const int q = tid + NT * i; if (q < 32 * SIR / 16) *(u32x4*)(dstg + (size_t)q * 16) = *(const u32x4*)(SR + q * 16); } }
  }
#undef PREP_LOAD
  __syncthreads();
  f16* QN = (f16*)(a.ws + WS_QN); f16* KN = (f16*)(a.ws + WS_KN);
  f32x2* cst = (f32x2*)lds;
  for (int i = tid; i < 64 * 32; i += NT) { const int pos = i >> 5, fi = i & 31; const float ang = (float)pos * powf(10000.f, -(float)(2 * fi) / 64.f); cst[i] = (f32x2){cosf(ang), sinf(ang)}; }
  __syncthreads();
  if (nb == 0) nb = gridDim.x;
  const int gw = (lbid() - b0) * 8 + wave, NGW = nb * 8;
  const int ax = lane >> 5, fi = lane & 31;
  if (part & 2)
  for (int m = gw; m < M; m += NGW) {
    const int t = m % L; const f16* pr = P + (size_t)m * NP;
    float x1[10], x2[10], ss[10];
#pragma unroll
    for (int hh = 0; hh < 10; ++hh) { const int src = hh < 8 ? C_ATQ + hh * 128 : C_ATK + (hh - 8) * 128; x1[hh] = (float)pr[src + ax * 64 + fi]; x2[hh] = (float)pr[src + ax * 64 + 32 + fi]; ss[hh] = x1[hh] * x1[hh] + x2[hh] * x2[hh]; }
    const f16x4 vc = *(const f16x4*)(pr + C_ATV + 4 * lane);
#pragma unroll
    for (int hh = 0; hh < 10; ++hh) ss[hh] = wave_sum(ss[hh]);
    f32x2 cs = {1.f, 0.f};
    if (t >= NCTX) { const int n = t - NCTX; cs = cst[(ax == 0 ? n / 64 : n % 64) * 32 + fi]; }
#pragma unroll
    for (int hh = 0; hh < 10; ++hh) { const float* g = (hh < 8 ? a.in[18] : a.in[19]) + l * 128; const float rstd = rsqrtf(ss[hh] * (1.f / 128.f) + 1e-6f);
      const float y1 = x1[hh] * rstd * g[ax * 64 + fi], y2 = x2[hh] * rstd * g[ax * 64 + 32 + fi];
      f16* dst = hh < 8 ? QN + (size_t)m * 1024 + hh * 128 : KN + (size_t)m * 512 + (hh - 8) * 128;
      dst[ax * 64 + fi] = (f16)(y1 * cs.x - y2 * cs.y); dst[ax * 64 + 32 + fi] = (f16)(y1 * cs.y + y2 * cs.x); }
    *(f16x4*)(KN + (size_t)m * 512 + 256 + 4 * lane) = vc;
  }
}

__device__ __forceinline__ int scan_tok(int dir, int i) { return dir == 0 ? i : (i < NCTX ? NCTX - 1 - i : L - 1 - (i - NCTX)); }

namespace rw {
constexpr int T = 16;
constexpr int STEPF = 6 * 64;
constexpr int BUFF = T * STEPF;
constexpr int YR_OFF = 2 * BUFF, YRING = T * 512;
template <int CTRL> __device__ __forceinline__ float dpp(float x) { return __int_as_float(__builtin_amdgcn_update_dpp(0, __float_as_int(x), CTRL, 0xF, 0xF, true)); }
__device__ __forceinline__ float red8(float x) { x += dpp<0xB1>(x); x += dpp<0x4E>(x); x += dpp<0x141>(x); return x; }
struct Ops { f32x4 r0, r1, k0, k1, w0, w1, b0, b1, d0, d1; f32x2 v; };
typedef __attribute__((address_space(3))) const float lcf;
__device__ __forceinline__ void ld_ops(Ops& o, lcf* st, lcf* vp) {
  o.r0 = *(const __attribute__((address_space(3))) f32x4*)(st); o.r1 = *(const __attribute__((address_space(3))) f32x4*)(st + 4);
  o.k0 = *(const __attribute__((address_space(3))) f32x4*)(st + 64); o.k1 = *(const __attribute__((address_space(3))) f32x4*)(st + 68);
  o.w0 = *(const __attribute__((address_space(3))) f32x4*)(st + 192); o.w1 = *(const __attribute__((address_space(3))) f32x4*)(st + 196);
  o.b0 = *(const __attribute__((address_space(3))) f32x4*)(st + 256); o.b1 = *(const __attribute__((address_space(3))) f32x4*)(st + 260);
  o.d0 = *(const __attribute__((address_space(3))) f32x4*)(st + 320); o.d1 = *(const __attribute__((address_space(3))) f32x4*)(st + 324);
  o.v = *(const __attribute__((address_space(3))) f32x2*)(vp);
}
#define RW_LO(v_) __builtin_shufflevector(v_, v_, 0, 1)
#define RW_HI(v_) __builtin_shufflevector(v_, v_, 2, 3)
#define RW_FMA(a_, b_, c_) __builtin_elementwise_fma(a_, b_, c_)
#define RW_DPP(r_, ctrl) "v_add_f32_dpp " r_ ", " r_ ", " r_ " " ctrl " row_mask:0xf bank_mask:0xf bound_ctrl:1\n\t"
__device__ __forceinline__ void step(f32x2 (&S0)[4], f32x2 (&S1)[4], const Ops& o, __attribute__((address_space(3))) f32x2* yw) {
  const f32x2 K[4] = {RW_LO(o.k0), RW_HI(o.k0), RW_LO(o.k1), RW_HI(o.k1)}, R[4] = {RW_LO(o.r0), RW_HI(o.r0), RW_LO(o.r1), RW_HI(o.r1)};
  const f32x2 W[4] = {RW_LO(o.w0), RW_HI(o.w0), RW_LO(o.w1), RW_HI(o.w1)}, Bv[4] = {RW_LO(o.b0), RW_HI(o.b0), RW_LO(o.b1), RW_HI(o.b1)};
  const f32x2 Dv[4] = {RW_LO(o.d0), RW_HI(o.d0), RW_LO(o.d1), RW_HI(o.d1)};
  f32x2 a0 = S0[0] * K[0], a1 = S1[0] * K[0];
#pragma unroll
  for (int j = 1; j < 4; ++j) { a0 = RW_FMA(S0[j], K[j], a0); a1 = RW_FMA(S1[j], K[j], a1); }
  float x0 = a0.x + a0.y, x1 = a1.x + a1.y;
  f32x2 m0, m1;
  asm("s_nop 1\n\t" RW_DPP("%0", "quad_perm:[1,0,3,2]") RW_DPP("%1", "quad_perm:[1,0,3,2]") "v_pk_mul_f32 %2, %4, %6\n\t"
      RW_DPP("%0", "quad_perm:[2,3,0,1]") RW_DPP("%1", "quad_perm:[2,3,0,1]") "v_pk_mul_f32 %3, %5, %6\n\t"
      RW_DPP("%0", "row_half_mirror") RW_DPP("%1", "row_half_mirror")
      : "+v"(x0), "+v"(x1), "=&v"(m0), "=&v"(m1) : "v"(S0[0]), "v"(S1[0]), "v"(W[0]));
  const f32x2 vx = {o.v.x, o.v.x}, vy = {o.v.y, o.v.y};
  f32x2 t0[4], t1[4];
  t0[0] = RW_FMA(vx, Dv[0], m0); t1[0] = RW_FMA(vy, Dv[0], m1);
#pragma unroll
  for (int j = 1; j < 4; ++j) { t0[j] = RW_FMA(vx, Dv[j], S0[j] * W[j]); t1[j] = RW_FMA(vy, Dv[j], S1[j] * W[j]); }
  const f32x2 n0 = {-x0, -x0}, n1 = {-x1, -x1};
#pragma unroll
  for (int j = 0; j < 4; ++j) { S0[j] = RW_FMA(n0, Bv[j], t0[j]); S1[j] = RW_FMA(n1, Bv[j], t1[j]); }
  f32x2 y0 = S0[0] * R[0], y1 = S1[0] * R[0];
#pragma unroll
  for (int j = 1; j < 4; ++j) { y0 = RW_FMA(S0[j], R[j], y0); y1 = RW_FMA(S1[j], R[j], y1); }
  float ya = y0.x + y0.y, yb = y1.x + y1.y; asm("" : "+v"(ya), "+v"(yb));
  *yw = (f32x2){ya, yb};
}
__device__ __forceinline__ void scan_unit(const Args& a, int l, int u, unsigned char* ldsb) {
  const int tid = ltid(), wave = tid >> 6;
  const int dir = u & 1, bh = u >> 1, b = bh >> 4, h = bh & 15;
  const unsigned char* SIb = a.ws + WS_SI + (size_t)bh * L * SIR;
  f16* Y = (f16*)(a.ws + WS_YRW) + (size_t)dir * M * 1024 + (size_t)b * L * 1024 + h * 64;
  float* sbuf = (float*)ldsb;
  constexpr int NC = L / T;
  if (wave >= 4) {
    const int lt = tid - 256;
    const int lpart = lt >> 7, ls = (lt >> 3) & 15, lg = lt & 7;
    float ckk[8], cka[8];
#pragma unroll
    for (int e = 0; e < 8; ++e) { ckk[e] = a.in[13][l * 1024 + h * 64 + lg * 8 + e]; cka[e] = a.in[14][l * 1024 + h * 64 + lg * 8 + e]; }
    u32x4 regs[3];
    auto issue = [&](int c) {
      const unsigned char* rec = SIb + (size_t)scan_tok(dir, c * T + ls) * SIR; const int dof = 400 + dir * 256 + lg * 16;
      regs[0] = *(const u32x4*)(rec + (lpart ? 128 : 0) + lg * 16);
      regs[1] = *(const u32x4*)(rec + (lpart ? dof + 128 : 256 + lg * 16));
      regs[2] = *(const u32x4*)(rec + (lpart ? 384 : dof));
    };
    auto commit = [&](int c) {
      float* d0 = sbuf + (c & 1) * BUFF + ls * STEPF + lg * 8;
      const f16x8 h0 = __builtin_bit_cast(f16x8, regs[0]), h1 = __builtin_bit_cast(f16x8, regs[1]);
      float o0[8], o1[8], o2[8];
      if (lpart == 0) { const f16x8 h2 = __builtin_bit_cast(f16x8, regs[2]);
#pragma unroll
        for (int e = 0; e < 8; ++e) { o0[e] = (float)h0[e]; o1[e] = (float)h1[e]; o2[e] = 1.f - (float)h2[e]; }
        *(f32x4*)(d0) = (f32x4){o0[0], o0[1], o0[2], o0[3]}; *(f32x4*)(d0 + 4) = (f32x4){o0[4], o0[5], o0[6], o0[7]};
        *(f32x4*)(d0 + 128) = (f32x4){o1[0], o1[1], o1[2], o1[3]}; *(f32x4*)(d0 + 132) = (f32x4){o1[4], o1[5], o1[6], o1[7]};
        *(f32x4*)(d0 + 192) = (f32x4){o2[0], o2[1], o2[2], o2[3]}; *(f32x4*)(d0 + 196) = (f32x4){o2[4], o2[5], o2[6], o2[7]}; }
      else { const float inv = __uint_as_float(regs[2].x);
#pragma unroll
        for (int e = 0; e < 8; ++e) { const float k = (float)h0[e], ag = (float)h1[e]; o0[e] = k * ckk[e] * inv; o1[e] = o0[e] * ag; o2[e] = k * (1.f + (ag - 1.f) * cka[e]); }
        *(f32x4*)(d0 + 64) = (f32x4){o0[0], o0[1], o0[2], o0[3]}; *(f32x4*)(d0 + 68) = (f32x4){o0[4], o0[5], o0[6], o0[7]};
        *(f32x4*)(d0 + 256) = (f32x4){o1[0], o1[1], o1[2], o1[3]}; *(f32x4*)(d0 + 260) = (f32x4){o1[4], o1[5], o1[6], o1[7]};
        *(f32x4*)(d0 + 320) = (f32x4){o2[0], o2[1], o2[2], o2[3]}; *(f32x4*)(d0 + 324) = (f32x4){o2[4], o2[5], o2[6], o2[7]}; }
    };
    auto yred = [&](int c) {
      const float* ring = sbuf + YR_OFF + (c & 1) * YRING;
#pragma unroll
      for (int i = 0; i < (T * 32) / 256; ++i) { const int it = lt + 256 * i, s = it >> 5, p = it & 31;
        const f32x4* src = (const f32x4*)(ring + s * 512 + p * 16);
        const f32x4 q = (src[0] + src[1]) + (src[2] + src[3]);
        *(unsigned*)(Y + (size_t)scan_tok(dir, c * T + s) * 1024 + 2 * p) = pkh(q.x + q.z, q.y + q.w); }
    };
    issue(0); commit(0);
    __syncthreads();
    for (int c = 0; c < NC; ++c) {
      if (c + 1 < NC) issue(c + 1);
      if (c > 0) yred(c - 1);
      if (c + 1 < NC) commit(c + 1);
      __syncthreads();
    }
    yred(NC - 1);
  } else {
    const int p = tid >> 3, ks = tid & 7;
    __builtin_amdgcn_s_setprio(2);
    f32x2 S0[4], S1[4];
#pragma unroll
    for (int k = 0; k < 4; ++k) { S0[k] = (f32x2){0.f, 0.f}; S1[k] = (f32x2){0.f, 0.f}; }
    typedef __attribute__((address_space(3))) f32x2 lf2;
    __syncthreads();
    for (int c = 0; c < NC; ++c) {
      lcf* buf = (lcf*)(sbuf + (c & 1) * BUFF) + ks * 8; lcf* vb = (lcf*)(sbuf + (c & 1) * BUFF) + 128 + 2 * p;
      lf2* yw = (lf2*)(sbuf + YR_OFF + (c & 1) * YRING) + tid;
      Ops A, B;
      ld_ops(A, buf, vb);
#pragma unroll 1
      for (int s = 0; s < T; s += 2) {
        ld_ops(B, buf + (s + 1) * STEPF, vb + (s + 1) * STEPF);
        step(S0, S1, A, yw + s * 256);
        __builtin_amdgcn_sched_barrier(0);
        ld_ops(A, buf + (s + 2) * STEPF, vb + (s + 2) * STEPF);
        step(S0, S1, B, yw + (s + 1) * 256);
        __builtin_amdgcn_sched_barrier(0);
      }
      __syncthreads();
    }
    __builtin_amdgcn_s_setprio(0);
  }
}
}


namespace ml {
constexpr int PT = 136;
constexpr int OFF_Q = 0, OFF_K = 128 * PT * 2, OFF_KT = 2 * 128 * PT * 2, OFF_VT = 3 * 128 * PT * 2, OFF_CT = OFF_VT + 80 * PT * 2, OFF_SC = OFF_CT + 80 * PT * 2;
constexpr int LDS_NEED = OFF_SC + 6 * 512 + 256 + 64;
static_assert(LDS_NEED <= LDS_BYTES, "mLSTM LDS");
constexpr int NCH = L / 128;
#define MFMA16(a_, b_, c_) __builtin_amdgcn_mfma_f32_16x16x32_f16(a_, b_, c_, 0, 0, 0)
__device__ __forceinline__ void mlstm_unit(const Args& a, int l, int u, unsigned char* lds) {
  const int tid = ltid(), lane = tid & 63, w = __builtin_amdgcn_readfirstlane(tid >> 6), fr = lane & 15, fq = lane >> 4;
  const int dir = u & 1, vs = (u >> 1) & 3, bh = u >> 3, b = bh >> 2, h = bh & 3;
  const f16* P = (const f16*)(a.ws + WS_P) + (size_t)b * L * NP; const float* GP = (const float*)(a.ws + WS_GPRE) + (size_t)b * L * 16; const float* gb = a.in[20] + l * 16;
  f16* HM = (f16*)(a.ws + WS_HM) + (size_t)dir * M * 1024 + (size_t)b * L * 1024 + h * 256 + vs * 64;
  f16* Qs = (f16*)(lds + OFF_Q); f16* Ks = (f16*)(lds + OFF_K); f16* KTs = (f16*)(lds + OFF_KT); f16* VTs = (f16*)(lds + OFF_VT); f16* CTs = (f16*)(lds + OFF_CT);
  float* sc = (float*)(lds + OFF_SC); float* li = sc; float* bcs = sc + 128; float* uu = sc + 256; float* Mx = sc + 384; float* wint = sc + 512; float* emt = sc + 640; f16* wah = (f16*)(sc + 768);
  const float bi = gb[dir * 4 + h], bfg = gb[(2 + dir) * 4 + h];
  __syncthreads();
  for (int i = tid; i < 16 * PT; i += NT) VTs[64 * PT + i] = (f16)(i < PT ? 1.f : 0.f);
  for (int i = tid; i < 80 * PT; i += NT) CTs[i] = (f16)0.f;
  f32x4 CT[5];
#pragma unroll
  for (int n = 0; n < 5; ++n) CT[n] = (f32x4){0.f, 0.f, 0.f, 0.f};
  float mcar = 0.f;
  const int sgn = dir ? -1 : 1;
  f16x8 pq[4], pk[4], pv[2];
#define ML_LOAD(c) do { const int tb_ = scan_tok(dir, 128 * (c)); \
    _Pragma("unroll") for (int i = 0; i < 4; ++i) { const int un = tid + NT * i, j = un >> 4, d8 = un & 15; const f16* rp = P + (size_t)(tb_ + sgn * j) * NP; \
      pq[i] = *(const f16x8*)(rp + C_MLQ + h * 128 + d8 * 8); pk[i] = *(const f16x8*)(rp + C_MLK + h * 128 + d8 * 8); } \
    _Pragma("unroll") for (int i = 0; i < 2; ++i) { const int un = tid + NT * i, j = un >> 3, v8 = un & 7; \
      pv[i] = *(const f16x8*)(P + (size_t)(tb_ + sgn * j) * NP + C_MLV + h * 256 + vs * 64 + v8 * 8); } } while (0)
  ML_LOAD(0);
  for (int c = 0; c < NCH; ++c) {
    const int tb = scan_tok(dir, 128 * c);
    __syncthreads();
#pragma unroll
    for (int i = 0; i < 4; ++i) { const int un = tid + NT * i, j = un >> 4, d8 = un & 15;
      f16x8 qv;
#pragma unroll
      for (int e = 0; e < 8; ++e) qv[e] = (f16)((float)pq[i][e] * 0.08838834764831845f);
      *(f16x8*)(Qs + j * PT + d8 * 8) = qv; *(f16x8*)(Ks + j * PT + d8 * 8) = pk[i];
#pragma unroll
      for (int e = 0; e < 8; ++e) KTs[(d8 * 8 + e) * PT + (j ^ (d8 * 8))] = pk[i][e]; }
#pragma unroll
    for (int i = 0; i < 2; ++i) { const int un = tid + NT * i, j = un >> 3, v8 = un & 7;
#pragma unroll
      for (int e = 0; e < 8; ++e) VTs[(v8 * 8 + e) * PT + (j ^ (v8 * 8))] = pv[i][e]; }
    if (tid < 128) { const float* gp = GP + (size_t)(tb + sgn * tid) * 16;
      const float pi = gp[dir * 4 + h] + bi, pf = gp[(2 + dir) * 4 + h] + bfg;
      li[tid] = 15.f * tanhf(pi * (1.f / 15.f)); bcs[tid] = -softplus_f(-15.f * tanhf(pf * (1.f / 15.f))); }
    if (c + 1 < NCH) ML_LOAD(c + 1);
    __syncthreads();
    if (w == 0) {
      const float x0 = bcs[2 * lane], x1 = bcs[2 * lane + 1]; const float ps = x0 + x1; float inc = ps;
#pragma unroll
      for (int o = 1; o < 64; o <<= 1) { const float t = __shfl_up(inc, o); if (lane >= o) inc += t; }
      const float b0 = inc - ps + x0, b1 = b0 + x1;
      const float u0 = li[2 * lane] - b0, u1 = li[2 * lane + 1] - b1;
      float incm = fmaxf(u0, u1);
#pragma unroll
      for (int o = 1; o < 64; o <<= 1) { const float t = __shfl_up(incm, o); if (lane >= o) incm = fmaxf(incm, t); }
      float exm = __shfl_up(incm, 1); if (lane == 0) exm = -INFINITY;
      const float pm0 = fmaxf(exm, u0), pm1 = incm;
      const float M0 = fmaxf(mcar, pm0), M1 = fmaxf(mcar, pm1); const float Ml = __shfl(M1, 63);
      bcs[2 * lane] = b0; bcs[2 * lane + 1] = b1; uu[2 * lane] = u0; uu[2 * lane + 1] = u1; Mx[2 * lane] = M0; Mx[2 * lane + 1] = M1;
      wint[2 * lane] = expf(mcar - M0); wint[2 * lane + 1] = expf(mcar - M1); emt[2 * lane] = expf(-(b0 + M0)); emt[2 * lane + 1] = expf(-(b1 + M1));
      wah[2 * lane] = (f16)expf(u0 - Ml); wah[2 * lane + 1] = (f16)expf(u1 - Ml);
    }
    f16x8 af[4];
#pragma unroll
    for (int ks = 0; ks < 4; ++ks) af[ks] = *(const f16x8*)(Qs + (16 * w + fr) * PT + ks * 32 + fq * 8);
    f32x4 acc[8];
#pragma unroll
    for (int n = 0; n < 8; ++n) { acc[n] = (f32x4){0.f, 0.f, 0.f, 0.f};
#pragma unroll
      for (int ks = 0; ks < 4; ++ks) acc[n] = MFMA16(af[ks], *(const f16x8*)(Ks + (16 * n + fr) * PT + ks * 32 + fq * 8), acc[n]); }
    __syncthreads();
    const float Mlast = Mx[127], gsum = bcs[127]; const float cs = expf(mcar - Mlast);
    f16* Ss = Ks;
    { float Mt[4];
#pragma unroll
      for (int r = 0; r < 4; ++r) Mt[r] = Mx[16 * w + 4 * fq + r];
#pragma unroll
      for (int n = 0; n < 8; ++n) { const int s = 16 * n + fr; const float us = uu[s];
#pragma unroll
        for (int r = 0; r < 4; ++r) { const int t = 16 * w + 4 * fq + r; const float v = (s <= t) ? acc[n][r] * __expf(us - Mt[r]) : 0.f; Ss[t * PT + s] = (f16)v; } } }
    f32x4 QC[5], SV[5];
#pragma unroll
    for (int n = 0; n < 5; ++n) { QC[n] = (f32x4){0.f, 0.f, 0.f, 0.f}; SV[n] = (f32x4){0.f, 0.f, 0.f, 0.f};
#pragma unroll
      for (int ks = 0; ks < 4; ++ks) QC[n] = MFMA16(af[ks], *(const f16x8*)(CTs + (16 * n + fr) * PT + ks * 32 + fq * 8), QC[n]); }
#pragma unroll
    for (int ks = 0; ks < 4; ++ks) if (32 * ks <= 16 * w + 15) { const f16x8 sf = *(const f16x8*)(Ss + (16 * w + fr) * PT + ks * 32 + fq * 8);
#pragma unroll
      for (int n = 0; n < 5; ++n) SV[n] = MFMA16(sf, *(const f16x8*)(VTs + (16 * n + fr) * PT + ((ks * 32 + fq * 8) ^ ((((16 * n + fr) >> 3) & 7) * 8))), SV[n]); }
#pragma unroll
    for (int r = 0; r < 4; ++r) { const int t = 16 * w + 4 * fq + r; const float wi = wint[t];
      const float den = __shfl(wi * QC[4][r] + SV[4][r], lane & 48); const float inv = 1.f / fmaxf(fabsf(den), emt[t]);
      f16* hp = HM + (size_t)(tb + sgn * t) * 1024 + fr;
#pragma unroll
      for (int n = 0; n < 4; ++n) hp[16 * n] = (f16)((wi * QC[n][r] + SV[n][r]) * inv); }
#pragma unroll
    for (int n = 0; n < 5; ++n) CT[n] = CT[n] * cs;
#pragma unroll
    for (int ks = 0; ks < 4; ++ks) { const f16x8 bfr = *(const f16x8*)(KTs + (16 * w + fr) * PT + ((ks * 32 + fq * 8) ^ ((((16 * w + fr) >> 3) & 15) * 8))) * *(const f16x8*)(wah + ks * 32 + fq * 8);
#pragma unroll
      for (int n = 0; n < 5; ++n) CT[n] = MFMA16(*(const f16x8*)(VTs + (16 * n + fr) * PT + ((ks * 32 + fq * 8) ^ ((((16 * n + fr) >> 3) & 7) * 8))), bfr, CT[n]); }
    __syncthreads();
#pragma unroll
    for (int n = 0; n < 5; ++n)
#pragma unroll
      for (int r = 0; r < 4; ++r) CTs[(16 * n + 4 * fq + r) * PT + 16 * w + fr] = (f16)CT[n][r];
    mcar = gsum + Mlast;
  }
#undef ML_LOAD
}
#undef MFMA16
}

namespace att {
constexpr int AD = 128, NW = 8, QBLK = 32, KVBLK = 64;
constexpr float SCALE = 0.088388347648318440f;
constexpr float THR = 8.f;
constexpr int LDQ = 1024, LDK = 512, LDV = 512, LDO = 1024;
constexpr size_t SHM_V = KVBLK * AD * 2, SHM_K = KVBLK * AD * 2, SHM_ATTN = 2 * SHM_V + 2 * SHM_K + NW * 64 * 4;
using s16x4 = __attribute__((ext_vector_type(4))) short;
using f32x16 = __attribute__((ext_vector_type(16))) float;
#define KSWZ(row, colB) ((row) * 256 + ((colB) ^ (((row) & 7) << 4)))
#define SBAR() __builtin_amdgcn_sched_barrier(0)
__device__ __forceinline__ int crow(int r, int hi) { return (r & 3) + 8 * (r >> 2) + 4 * hi; }
__device__ __forceinline__ unsigned cvtpk(float lo, float hi) { unsigned r; asm volatile("v_cvt_pk_f16_f32 %0, %1, %2" : "=v"(r) : "v"(lo), "v"(hi)); return r; }
__device__ __forceinline__ void partialSM(f32x16& p0, f32x16& p1, float& m_reg, float& mn, float& alpha) {
  constexpr float C = SCALE * 1.4426950408889634f;
  float pmax = p0[0];
#pragma unroll
  for (int r = 1; r < 16; ++r) pmax = fmaxf(pmax, p0[r]);
#pragma unroll
  for (int r = 0; r < 16; ++r) pmax = fmaxf(pmax, p1[r]);
  { auto rr = __builtin_amdgcn_permlane32_swap(__float_as_uint(pmax), __float_as_uint(pmax), false, false);
    pmax = fmaxf(__uint_as_float(rr[0]), __uint_as_float(rr[1])); }
  if (__builtin_expect(__all(pmax - m_reg <= THR / SCALE), 1)) { mn = m_reg; alpha = 1.f; }
  else { mn = fmaxf(m_reg, pmax); alpha = __builtin_amdgcn_exp2f((m_reg - mn) * C); m_reg = mn; }
  float mnC = -mn * C;
#pragma unroll
  for (int r = 0; r < 16; ++r) p0[r] = fmaf(p0[r], C, mnC);
#pragma unroll
  for (int r = 0; r < 16; ++r) p1[r] = fmaf(p1[r], C, mnC);
#pragma unroll
  for (int r = 0; r < 16; ++r) p0[r] = __builtin_amdgcn_exp2f(p0[r]);
}
__device__ __forceinline__ void finishSM(f32x16& p0, f32x16& p1, float alpha, float& l_reg, f16x8& pa0, f16x8& pa1, f16x8& pa2, f16x8& pa3) {
#pragma unroll
  for (int r = 0; r < 16; ++r) p1[r] = __builtin_amdgcn_exp2f(p1[r]);
  float ps = 0;
#pragma unroll
  for (int r = 0; r < 16; ++r) ps += p0[r];
#pragma unroll
  for (int r = 0; r < 16; ++r) ps += p1[r];
  { auto rr = __builtin_amdgcn_permlane32_swap(__float_as_uint(ps), __float_as_uint(ps), false, false);
    ps = __uint_as_float(rr[0]) + __uint_as_float(rr[1]); }
  l_reg = l_reg * alpha + ps;
#define PK4(P, BASE, OUT) do { unsigned a0 = cvtpk(P[BASE + 0], P[BASE + 1]), a1 = cvtpk(P[BASE + 2], P[BASE + 3]);   \
    unsigned b0 = cvtpk(P[BASE + 4], P[BASE + 5]), b1 = cvtpk(P[BASE + 6], P[BASE + 7]);                              \
    auto r0 = __builtin_amdgcn_permlane32_swap(a0, b0, false, false); auto r1 = __builtin_amdgcn_permlane32_swap(a1, b1, false, false); \
    u32x4 w = {r0[0], r1[0], r0[1], r1[1]}; OUT = __builtin_bit_cast(f16x8, w); } while (0)
  PK4(p0, 0, pa0); PK4(p0, 8, pa1); PK4(p1, 0, pa2); PK4(p1, 8, pa3);
#undef PK4
}
__device__ __forceinline__ void qkt(f32x16& p0, f32x16& p1, const char* Ks, const f16x8* qr, int r32, int hi) {
  p0 = f32x16{}; p1 = f32x16{};
#pragma unroll
  for (int d0 = 0; d0 < 8; ++d0) { int cb = (d0 * 16 + hi * 8) * 2;
    f16x8 b0 = *reinterpret_cast<const f16x8*>(Ks + KSWZ(r32, cb));
    f16x8 b1 = *reinterpret_cast<const f16x8*>(Ks + KSWZ(32 + r32, cb));
    p0 = __builtin_amdgcn_mfma_f32_32x32x16_f16(b0, qr[d0], p0, 0, 0, 0);
    p1 = __builtin_amdgcn_mfma_f32_32x32x16_f16(b1, qr[d0], p1, 0, 0, 0); }
}
__device__ __forceinline__ int v_st(int k, int c) { const int kk = (k & ~0xC) | ((k & 4) << 1) | ((k & 8) >> 1); return ((kk >> 3) * 4 + (c >> 5)) * 512 + ((kk & 7) * 32 + (c & 31)) * 2; }
__device__ __forceinline__ int v_rd_base(int lane) { return ((lane & 3) << 3) | (((lane >> 2) & 3) << 6) | (((lane >> 4) & 1) << 5) | (((lane >> 5) & 1) << 8); }
constexpr int v_rd_off(int d0, int ks, int half) { return d0 * 512 + ks * 4096 + half * 2048; }
template <int OFF> __device__ __forceinline__ s16x4 tr_read(int vb) {
  s16x4 r; asm volatile("ds_read_b64_tr_b16 %0, %1 offset:%2" : "=&v"(r) : "v"(vb), "i"(OFF) : "memory"); return r;
}
template <int D0> __device__ __forceinline__ void pv_one(f32x16& od, int vb, f16x8 pa0, f16x8 pa1, f16x8 pa2, f16x8 pa3) {
  const s16x4 l0 = tr_read<v_rd_off(D0, 0, 0)>(vb), h0 = tr_read<v_rd_off(D0, 0, 1)>(vb), l1 = tr_read<v_rd_off(D0, 1, 0)>(vb), h1 = tr_read<v_rd_off(D0, 1, 1)>(vb);
  const s16x4 l2 = tr_read<v_rd_off(D0, 2, 0)>(vb), h2 = tr_read<v_rd_off(D0, 2, 1)>(vb), l3 = tr_read<v_rd_off(D0, 3, 0)>(vb), h3 = tr_read<v_rd_off(D0, 3, 1)>(vb);
  asm volatile("s_waitcnt lgkmcnt(0)" ::: "memory"); SBAR();
  typedef short s16x8 __attribute__((ext_vector_type(8)));
#define PK(Lo, Hi) __builtin_bit_cast(f16x8, (s16x8){Lo[0], Lo[1], Lo[2], Lo[3], Hi[0], Hi[1], Hi[2], Hi[3]})
  od = __builtin_amdgcn_mfma_f32_32x32x16_f16(pa0, PK(l0, h0), od, 0, 0, 0);
  od = __builtin_amdgcn_mfma_f32_32x32x16_f16(pa1, PK(l1, h1), od, 0, 0, 0);
  od = __builtin_amdgcn_mfma_f32_32x32x16_f16(pa2, PK(l2, h2), od, 0, 0, 0);
  od = __builtin_amdgcn_mfma_f32_32x32x16_f16(pa3, PK(l3, h3), od, 0, 0, 0);
#undef PK
}
__device__ __forceinline__ void pv_d0(f32x16* o, int vb, f16x8 pa0, f16x8 pa1, f16x8 pa2, f16x8 pa3) {
  pv_one<0>(o[0], vb, pa0, pa1, pa2, pa3); pv_one<1>(o[1], vb, pa0, pa1, pa2, pa3); pv_one<2>(o[2], vb, pa0, pa1, pa2, pa3); pv_one<3>(o[3], vb, pa0, pa1, pa2, pa3);
}
__device__ __forceinline__ void attn_dense_body(const f16* __restrict__ Qb, const f16* __restrict__ Kh, const f16* __restrict__ Vh, f16* __restrict__ Ob, int seq, char* lds) {
  const int tid = ltid(), wid = tid >> 6, lane = tid & 63, r32 = lane & 31, hi = lane >> 5;
  char* V_lds = lds; char* K_lds = lds + 2 * SHM_V;
  float* ws = (float*)(lds + 2 * SHM_V + 2 * SHM_K) + wid * 64; float* li_l = ws; float* al_l = ws + 32;
  float m_reg = -1e30f, l_reg = 0; f32x16 o[4] = {}; f16x8 qr[8];
  const f16* Qw = Qb + (long)(wid * QBLK + r32) * LDQ + hi * 8;
#pragma unroll
  for (int d0 = 0; d0 < 8; ++d0) qr[d0] = *reinterpret_cast<const f16x8*>(Qw + d0 * 16);
  const int sr = tid >> 4, sc = (tid & 15) * 8, vst0 = v_st(sr, sc), vst1 = v_st(32 + sr, sc);
  const int vb0 = (int)(uintptr_t)V_lds + v_rd_base(lane);
  struct { f16x8 vs0, vs1, ks0, ks1; } sr_[2];
#define SLOAD(i, k0) do { sr_[i].vs0 = *(const f16x8*)(&Vh[(long)((k0) + sr) * LDV + sc]); sr_[i].vs1 = *(const f16x8*)(&Vh[(long)((k0) + 32 + sr) * LDV + sc]); \
    sr_[i].ks0 = *(const f16x8*)(&Kh[(long)((k0) + sr) * LDK + sc]); sr_[i].ks1 = *(const f16x8*)(&Kh[(long)((k0) + 32 + sr) * LDK + sc]); } while (0)
#define SWRITE(b, i) do { *(f16x8*)(V_lds + (b) * SHM_V + vst0) = sr_[i].vs0;          \
    *(f16x8*)(V_lds + (b) * SHM_V + vst1) = sr_[i].vs1; int kc = sc * 2;               \
    *(f16x8*)(K_lds + (b) * SHM_K + KSWZ(sr, kc)) = sr_[i].ks0;                       \
    *(f16x8*)(K_lds + (b) * SHM_K + KSWZ(32 + sr, kc)) = sr_[i].ks1; } while (0)
#define SWAIT() asm volatile("s_waitcnt vmcnt(4)" ::: "memory")
#define RESC(a) do { if (__any((a) < 1.f)) { if (hi == 0) al_l[r32] = (a); asm volatile("s_waitcnt lgkmcnt(0)" ::: "memory"); \
    _Pragma("unroll") for (int d = 0; d < 4; ++d) _Pragma("unroll") for (int r = 0; r < 16; ++r) o[d][r] *= al_l[crow(r, hi)]; } } while (0)
  f32x16 pA0, pA1, pB0, pB1; float mnA, mnB, alA, alB; f16x8 pa0, pa1, pa2, pa3; const int NTl = seq / KVBLK;
  constexpr int SE = 0, SO = 1;
  SLOAD(SE, 0); asm volatile("s_waitcnt vmcnt(0)" ::: "memory"); SWRITE(0, SE); __syncthreads();
  qkt(pA0, pA1, K_lds, qr, r32, hi); partialSM(pA0, pA1, m_reg, mnA, alA);
  SLOAD(SO, KVBLK); if (2 < NTl) SLOAD(SE, 2 * KVBLK);
  SWAIT(); SWRITE(1, SO); __syncthreads();
  for (int j = 1; j + 1 < NTl; j += 2) {
    SBAR(); qkt(pB0, pB1, K_lds + SHM_K, qr, r32, hi);
    finishSM(pA0, pA1, alA, l_reg, pa0, pa1, pa2, pa3); SBAR();
    SLOAD(SO, (j + 2) * KVBLK); SBAR();
    pv_d0(o, vb0, pa0, pa1, pa2, pa3); partialSM(pB0, pB1, m_reg, mnB, alB);
    __syncthreads(); SWAIT(); SWRITE(0, SE);
    RESC(alB); __syncthreads();
    SBAR(); qkt(pA0, pA1, K_lds, qr, r32, hi);
    finishSM(pB0, pB1, alB, l_reg, pa0, pa1, pa2, pa3); SBAR();
    if (j + 3 < NTl) SLOAD(SE, (j + 3) * KVBLK); SBAR();
    pv_d0(o, vb0 + (int)SHM_V, pa0, pa1, pa2, pa3); partialSM(pA0, pA1, m_reg, mnA, alA);
    __syncthreads(); SWAIT(); SWRITE(1, SO);
    RESC(alA); __syncthreads();
  }
  SBAR(); qkt(pB0, pB1, K_lds + SHM_K, qr, r32, hi);
  finishSM(pA0, pA1, alA, l_reg, pa0, pa1, pa2, pa3); SBAR();
  pv_d0(o, vb0, pa0, pa1, pa2, pa3); partialSM(pB0, pB1, m_reg, mnB, alB);
  __syncthreads(); RESC(alB);
  finishSM(pB0, pB1, alB, l_reg, pa0, pa1, pa2, pa3); SBAR();
  pv_d0(o, vb0 + (int)SHM_V, pa0, pa1, pa2, pa3);
  if (hi == 0) li_l[r32] = l_reg; asm volatile("s_waitcnt lgkmcnt(0)" ::: "memory");
  float rli[16];
#pragma unroll
  for (int r = 0; r < 16; ++r) rli[r] = __builtin_amdgcn_rcpf(li_l[crow(r, hi)]);
  f16* Ow = Ob + (long)(wid * QBLK) * LDO;
#pragma unroll
  for (int r = 0; r < 16; ++r) { int orow = crow(r, hi);
#pragma unroll
    for (int d0 = 0; d0 < 4; ++d0) Ow[(long)orow * LDO + d0 * 32 + r32] = (f16)(o[d0][r] * rli[r]); }
#undef SLOAD
#undef SWRITE
#undef SWAIT
#undef RESC
}
#undef KSWZ
#undef SBAR
__device__ __forceinline__ void attn_unit(const Args& a, int u, char* lds) {
  int b, hq, t0, seq;
  if (u < 256) { const int qb = u & 15, r = (u >> 4) & 3, g = (u >> 6) & 1; b = u >> 7; hq = g * 4 + r; t0 = NCTX + 256 * qb; seq = L; }
  else { const int v = u - 256; b = v >> 3; hq = v & 7; t0 = 0; seq = NCTX; }
  const size_t m0 = (size_t)b * L + t0, k0 = (size_t)b * L; const int g = hq >> 2;
  const f16* Kh = (const f16*)(a.ws + WS_KN) + k0 * 512 + g * 128;
  attn_dense_body((const f16*)(a.ws + WS_QN) + m0 * 1024 + hq * 128, Kh, Kh + 256, (f16*)(a.ws + WS_AO) + m0 * 1024 + hq * 128, seq, lds);
}
}

__device__ __forceinline__ void ph_post(const Args& a, int l, int part = 3, int b0 = 0, int nb = 0) {
  const int tid = ltid(), lane = tid & 63, wave = tid >> 6;
  if (nb == 0) nb = gridDim.x;
  const int gw = (lbid() - b0) * 8 + wave, NGW = nb * 8;
  const f16* P = (const f16*)(a.ws + WS_P); f16* Y = (f16*)(a.ws + WS_Y);
  const f16* YRW = (const f16*)(a.ws + WS_YRW); const f16* AO = (const f16*)(a.ws + WS_AO); const f16* HM = (const f16*)(a.ws + WS_HM);
  const unsigned char* SIp = a.ws + WS_SI; const float* RKD = (const float*)(a.ws + WS_RKD);
  f32x4 lw[4], lb[4];
  if (part & 1) {
#pragma unroll
    for (int g = 0; g < 4; ++g) { const int c = (4 * g + (lane >> 4)) * 64 + (lane & 15) * 4; lw[g] = *(const f32x4*)(a.in[16] + l * 1024 + c); lb[g] = *(const f32x4*)(a.in[17] + l * 1024 + c); } }
  f32x4 ng[4];
  if (part & 2) {
#pragma unroll
    for (int h = 0; h < 4; ++h) ng[h] = *(const f32x4*)(a.in[21] + l * 1024 + h * 256 + lane * 4); }
  for (int m = gw; m < M; m += NGW) {
    const int lane = ltid() & 63, hq = lane >> 4, c4 = (lane & 15) * 4;
    const int b = m / L, t = m % L; const f16* pr = P + (size_t)m * NP; f16* yr = Y + (size_t)m * 3072;
    if (part & 1) {
    f16x4 ya[4], yb[4]; f32x4 vv[4]; f16x4 ga[4]; float rk[4];
#pragma unroll
    for (int g = 0; g < 4; ++g) { const int h = 4 * g + hq, c = h * 64 + c4;
      ya[g] = *(const f16x4*)(YRW + (size_t)m * 1024 + c); yb[g] = *(const f16x4*)(YRW + (size_t)(M + m) * 1024 + c);
      { const f16x4 vh = *(const f16x4*)(SIp + ((size_t)(b * 16 + h) * L + t) * SIR + 256 + c4 * 2); vv[g] = (f32x4){(float)vh[0], (float)vh[1], (float)vh[2], (float)vh[3]}; } ga[g] = *(const f16x4*)(pr + C_RWG + c);
      rk[g] = RKD[(size_t)m * 16 + h]; }
#pragma unroll
    for (int g = 0; g < 4; ++g) { const int c = (4 * g + hq) * 64 + c4; const f32x4 y = (f32x4){(float)ya[g][0] + (float)yb[g][0], (float)ya[g][1] + (float)yb[g][1], (float)ya[g][2] + (float)yb[g][2], (float)ya[g][3] + (float)yb[g][3]};
      const float mu = red16(y.x + y.y + y.z + y.w) * (1.f / 64.f); const f32x4 dv = y - mu;
      const float var = red16(dv.x * dv.x + dv.y * dv.y + dv.z * dv.z + dv.w * dv.w) * (1.f / 64.f); const float rs = rsqrtf(var + 64e-5f);
      float o[4];
#pragma unroll
      for (int e = 0; e < 4; ++e) o[e] = (dv[e] * rs * lw[g][e] + lb[g][e] + rk[g] * vv[g][e]) * silu_f((float)ga[g][e]);
      uint2 w; w.x = pkh(o[0], o[1]); w.y = pkh(o[2], o[3]); *(uint2*)(yr + c) = w; }
    }
    if (part & 2) {
    f16x4 ao[4]; f16x4 gb[4];
#pragma unroll
    for (int j = 0; j < 4; ++j) { const int c = j * 256 + lane * 4; ao[j] = *(const f16x4*)(AO + (size_t)m * 1024 + c); gb[j] = *(const f16x4*)(pr + C_ATG + c); }
    f32x4 ha[4]; f16x4 hha[4], hhb[4], go[4], gg[4];
#pragma unroll
    for (int h = 0; h < 4; ++h) { const int c = h * 256 + lane * 4; hha[h] = *(const f16x4*)(HM + (size_t)m * 1024 + c); hhb[h] = *(const f16x4*)(HM + (size_t)(M + m) * 1024 + c);
      go[h] = *(const f16x4*)(pr + C_MLO + c); gg[h] = *(const f16x4*)(pr + C_MLG + c); }
#pragma unroll
    for (int j = 0; j < 4; ++j) { const int c = j * 256 + lane * 4; float o[4];
#pragma unroll
      for (int e = 0; e < 4; ++e) o[e] = (float)ao[j][e] * silu_f((float)gb[j][e]);
      uint2 w; w.x = pkh(o[0], o[1]); w.y = pkh(o[2], o[3]); *(uint2*)(yr + 1024 + c) = w; }
    float ss[4];
#pragma unroll
    for (int h = 0; h < 4; ++h) { ha[h] = (f32x4){(float)hha[h][0] + (float)hhb[h][0], (float)hha[h][1] + (float)hhb[h][1], (float)hha[h][2] + (float)hhb[h][2], (float)hha[h][3] + (float)hhb[h][3]}; ss[h] = ha[h].x * ha[h].x + ha[h].y * ha[h].y + ha[h].z * ha[h].z + ha[h].w * ha[h].w; }
#pragma unroll
    for (int o = 32; o >= 1; o >>= 1) {
#pragma unroll
      for (int h = 0; h < 4; ++h) ss[h] += __shfl_xor(ss[h], o); }
#pragma unroll
    for (int h = 0; h < 4; ++h) { const int c = h * 256 + lane * 4; const float rstd = rsqrtf(ss[h] * (1.f / 256.f) + 1e-6f); float o[4];
#pragma unroll
      for (int e = 0; e < 4; ++e) o[e] = sigm_f((float)go[h][e]) * (ha[h][e] * rstd * ng[h][e]) * silu_f((float)gg[h][e]);
      uint2 w; w.x = pkh(o[0], o[1]); w.y = pkh(o[2], o[3]); *(uint2*)(yr + 2048 + c) = w; }
    }
  }
}

__device__ __forceinline__ void ph_sum3(const Args& a) {
  const f16* G3 = (const f16*)(a.ws + WS_G3); const f16* G3b = (const f16*)(a.ws + WS_G3B); f16* MG = (f16*)(a.ws + WS_MRG);
  const size_t n8 = (size_t)M * D / 8;
  for (size_t i = (size_t)lbid() * NT + ltid(); i < n8; i += (size_t)gridDim.x * NT) {
    const f16x8 x = *(const f16x8*)(G3 + i * 8), y = *(const f16x8*)(G3b + i * 8), z = *(const f16x8*)(G3b + (size_t)M * D + i * 8);
    f16x8 o;
#pragma unroll
    for (int e = 0; e < 8; ++e) o[e] = (f16)((float)x[e] + (float)y[e] + (float)z[e]);
    *(f16x8*)(MG + i * 8) = o; }
}

__device__ __forceinline__ void ph_final(const Args& a) {
  const int tid = ltid(), lane = tid & 63, wave = tid >> 6;
  const int gw = lbid() * 8 + wave, NGW = gridDim.x * 8;
  const float* Z = (const float*)(a.ws + WS_Z); const float* fg = a.in[24];
  f32x4 fgv[8];
#pragma unroll
  for (int j = 0; j < 8; ++j) fgv[j] = *(const f32x4*)(fg + 4 * (lane + 64 * j));
  for (int r = gw; r < BATCH * SEQ; r += NGW) {
    const int b = r / SEQ, t = r % SEQ; const float* zr = Z + ((size_t)b * L + NCTX + t) * D; float* o = a.out + (size_t)r * D;
    f32x4 v[8]; float ss = 0.f;
#pragma unroll
    for (int j = 0; j < 8; ++j) { v[j] = *(const f32x4*)(zr + 4 * (lane + 64 * j)); ss += v[j].x * v[j].x + v[j].y * v[j].y + v[j].z * v[j].z + v[j].w * v[j].w; }
    const float rstd = rsqrtf(wave_sum(ss) * (1.f / D) + 1e-6f);
#pragma unroll
    for (int j = 0; j < 8; ++j) { const int k = 4 * (lane + 64 * j); *(f32x4*)(o + k) = v[j] * rstd * fgv[j]; }
  }
}


#define XLAS __attribute__((address_space(3)))
#define XB_TMO      128
#define XB_XCNT(j)  (256  + 64 * (j))
#define XB_XSUB(j)  (1280 + 64 * (j))
#define XB_XGEN(j)  (2304 + 64 * (j))
#define XB_TOP      3328
#define XB_TOPGEN   3392
#define XCD_BAR_WORDS 3456
#define XB_SPIN_CAP (1u << 18)
__device__ __forceinline__ unsigned xb_ld(unsigned* p)              { return __hip_atomic_load(p, __ATOMIC_RELAXED, __HIP_MEMORY_SCOPE_AGENT); }
__device__ __forceinline__ unsigned xb_add(unsigned* p, unsigned v) { return __hip_atomic_fetch_add(p, v, __ATOMIC_RELAXED, __HIP_MEMORY_SCOPE_AGENT); }
__device__ __forceinline__ unsigned xb_xcc_id() { return (unsigned)__builtin_amdgcn_s_getreg((3 << 11) | 20) & 0xFu; }
#define XB_SPIN(cond, bar) do { unsigned _sp = 0; while (cond) { __builtin_amdgcn_s_sleep(1); \
    if ((++_sp & 255u) == 0u) { if (xb_ld(&(bar)[XB_TMO])) break; if (_sp > XB_SPIN_CAP) { atomicAdd(&(bar)[XB_TMO], 1u); break; } } } } while (0)
struct XcdBarrier { unsigned* bar; unsigned x; volatile XLAS unsigned* st; };
__device__ __forceinline__ XcdBarrier xcd_barrier_post(unsigned* bar, volatile XLAS unsigned* st) {
    XcdBarrier b; b.bar = bar; b.x = xb_xcc_id(); b.st = st;
    if (threadIdx.x == 0) (void)xb_add(&bar[XB_XCNT(b.x)], 1u);
    return b;
}
__device__ __forceinline__ void xcd_barrier_complete(unsigned* bar, unsigned x, unsigned& nloc, unsigned& nx) {
    const unsigned G = gridDim.x * gridDim.y * gridDim.z;
    unsigned sum, cnt, mine, sp = 0u;
    for (;;) {
        sum = 0u; cnt = 0u; mine = 0u;
#pragma unroll
        for (unsigned j = 0; j < 16; ++j) { const unsigned c = xb_ld(&bar[XB_XCNT(j)]); sum += c; cnt += (c > 0u) ? 1u : 0u; mine = (j == x) ? c : mine; }
        if (sum == G) break;
        __builtin_amdgcn_s_sleep(1);
        if ((++sp & 255u) == 0u) { if (xb_ld(&bar[XB_TMO])) break; if (sp > XB_SPIN_CAP) { atomicAdd(&bar[XB_TMO], 1u); break; } }
    }
    nloc = mine > 0u ? mine : 1u; nx = cnt > 0u ? cnt : 1u;
}
__device__ __forceinline__ void xcd_barrier(const XcdBarrier& b) {
    asm volatile("s_waitcnt vmcnt(0)" ::: "memory");
    __syncthreads();
    if (threadIdx.x == 0) {
        unsigned* bar = b.bar;
        __builtin_amdgcn_s_waitcnt(0);
        unsigned nloc = b.st[0], nx = b.st[1];
        if (nloc == 0u) { xcd_barrier_complete(bar, b.x, nloc, nx); b.st[0] = nloc; b.st[1] = nx; }
        const unsigned old = xb_add(&bar[XB_XSUB(b.x)], 1u);
        const unsigned gen = old / nloc;
        if (old + 1u == (gen + 1u) * nloc) {
            __builtin_amdgcn_fence(__ATOMIC_RELEASE, "agent");
            asm volatile("s_waitcnt vmcnt(0)" ::: "memory");
            const unsigned og = xb_add(&bar[XB_TOP], 1u);
            const unsigned tg = og / nx;
            if (og + 1u == (tg + 1u) * nx) xb_add(&bar[XB_TOPGEN], 1u);
            else XB_SPIN(xb_ld(&bar[XB_TOPGEN]) == tg, bar);
            __builtin_amdgcn_fence(__ATOMIC_ACQUIRE, "agent");
            xb_add(&bar[XB_XGEN(b.x)], 1u);
            asm volatile("s_waitcnt vmcnt(0)" ::: "memory");
        } else {
            XB_SPIN(xb_ld(&bar[XB_XGEN(b.x)]) == gen, bar);
            __builtin_amdgcn_fence(__ATOMIC_ACQUIRE, "agent");
            asm volatile("s_waitcnt vmcnt(0)" ::: "memory");
        }
    }
    __syncthreads();
}


__device__ __forceinline__ void sub_barrier(unsigned* bar, volatile XLAS unsigned* st, unsigned G) {
    asm volatile("s_waitcnt vmcnt(0)" ::: "memory");
    __syncthreads();
    if (threadIdx.x == 0) {
        const unsigned x = xb_xcc_id();
        __builtin_amdgcn_s_waitcnt(0);
        unsigned nloc = st[0], nx = st[1];
        if (nloc == 0u) {
            unsigned sum, cnt, mine, sp = 0u;
            for (;;) { sum = 0u; cnt = 0u; mine = 0u;
#pragma unroll
                for (unsigned j = 0; j < 16; ++j) { const unsigned c = xb_ld(&bar[XB_XCNT(j)]); sum += c; cnt += (c > 0u) ? 1u : 0u; mine = (j == x) ? c : mine; }
                if (sum == G) break;
                __builtin_amdgcn_s_sleep(1);
                if ((++sp & 255u) == 0u) { if (xb_ld(&bar[XB_TMO])) break; if (sp > XB_SPIN_CAP) { atomicAdd(&bar[XB_TMO], 1u); break; } } }
            nloc = mine > 0u ? mine : 1u; nx = cnt > 0u ? cnt : 1u; st[0] = nloc; st[1] = nx; }
        const unsigned old = xb_add(&bar[XB_XSUB(x)], 1u);
        const unsigned gen = old / nloc;
        if (old + 1u == (gen + 1u) * nloc) {
            __builtin_amdgcn_fence(__ATOMIC_RELEASE, "agent");
            asm volatile("s_waitcnt vmcnt(0)" ::: "memory");
            const unsigned og = xb_add(&bar[XB_TOP], 1u);
            const unsigned tg = og / nx;
            if (og + 1u == (tg + 1u) * nx) xb_add(&bar[XB_TOPGEN], 1u);
            else XB_SPIN(xb_ld(&bar[XB_TOPGEN]) == tg, bar);
            __builtin_amdgcn_fence(__ATOMIC_ACQUIRE, "agent");
            xb_add(&bar[XB_XGEN(x)], 1u);
            asm volatile("s_waitcnt vmcnt(0)" ::: "memory");
        } else {
            XB_SPIN(xb_ld(&bar[XB_XGEN(x)]) == gen, bar);
            __builtin_amdgcn_fence(__ATOMIC_ACQUIRE, "agent");
            asm volatile("s_waitcnt vmcnt(0)" ::: "memory");
        }
    }
    __syncthreads();
}

__device__ __forceinline__ int mix_grab(unsigned* ctr, volatile unsigned* slot) {
  __syncthreads();
  if (ltid() == 0) *slot = __hip_atomic_fetch_add(ctr, 1u, __ATOMIC_RELAXED, __HIP_MEMORY_SCOPE_AGENT);
  __syncthreads();
  return (int)*slot;
}
constexpr int MFULL = 8192;
constexpr int NSCAN = 64;
constexpr int NT_RW = 13;
__device__ __forceinline__ void ph_mix(const Args& a, int l, unsigned char* lds) {
  const int bx = lbid();
  if (bx < NSCAN) {
    if (ltid() == 0) { unsigned* pd = (unsigned*)(a.ws + WS_CTL) + 1024 + 64 * l + 32; while (xb_ld(pd) < gridDim.x) __builtin_amdgcn_s_sleep(2); __builtin_amdgcn_fence(__ATOMIC_ACQUIRE, "agent"); }
    __syncthreads();
    rw::scan_unit(a, l, bx, lds); return; }
  const int NB = gridDim.x - NSCAN;
  unsigned* bar2 = (unsigned*)(a.ws + WS_CTL) + 8192 + l * XCD_BAR_WORDS;
  volatile XLAS unsigned* st2 = (volatile XLAS unsigned*)((XLAS unsigned char*)lds + (LDS_BYTES - 48));
  if (ltid() < 2) st2[ltid()] = 0u;
  __syncthreads();
  if (ltid() == 0) (void)xb_add(&bar2[XB_XCNT(xb_xcc_id())], 1u);
  { pg8::Gemm g{(const f16*)(a.ws + WS_H), (const f16*)(a.ws + WS_WIN) + (size_t)NT_RW * 256 * D, D, D, D, 1 << 20, 0}; pg8::StaticOrder So; So.init(M, NP - NT_RW * 256, NB, bx - NSCAN);
    pg8::gemm_phase((PG8_LAS unsigned char*)lds, g, So, pg8::EpiP{(f16*)(a.ws + WS_P), NT_RW * 256}); }
  sub_barrier(bar2, st2, (unsigned)NB);
  ph_prep(a, l, lds, 2, NSCAN, NB);
  sub_barrier(bar2, st2, (unsigned)NB);
  unsigned* ctr = (unsigned*)(a.ws + WS_CTL) + 64 * (1 + l);
  volatile unsigned* slot = (volatile unsigned*)(lds + LDS_BYTES - 64);
  int u = mix_grab(ctr, slot);
  while (u < 64) { ml::mlstm_unit(a, l, u, lds); u = mix_grab(ctr, slot); }
  while (u < 336) { att::attn_unit(a, u - 64, (char*)lds); u = mix_grab(ctr, slot); }
  sub_barrier(bar2, st2, (unsigned)NB);
  ph_post(a, l, 2, NSCAN, NB);
  sub_barrier(bar2, st2, (unsigned)NB);
  { pg8::Gemm g{(const f16*)(a.ws + WS_Y), (const f16*)(a.ws + WS_WBR), 3072, BR, BR, 8, 1024}; pg8::StaticOrder So; So.init(M, 2 * D, NB, bx - NSCAN, 8);
    pg8::gemm_phase((PG8_LAS unsigned char*)lds, g, So, pg8::EpiBr{(f16*)(a.ws + WS_G3), (f16*)(a.ws + WS_G3B), (const f16*)(a.ws + WS_P), nullptr}); }
  if (l + 1 < DEPTH) ph_convert(a, l + 1, lds, 1, NSCAN, NB);
}

__global__ void __launch_bounds__(NT) mega(Args a) {
  extern __shared__ __attribute__((aligned(16))) unsigned char lds[];
  { volatile XLAS unsigned* st0 = (volatile XLAS unsigned*)((XLAS unsigned char*)lds + (LDS_BYTES - 48)); if (threadIdx.x < 6) st0[threadIdx.x] = 0u; }
  __syncthreads();
  (void)xcd_barrier_post((unsigned*)(a.ws + WS_CTL) + 4096, (volatile XLAS unsigned*)((XLAS unsigned char*)lds + (LDS_BYTES - 32)));
#define GRID_SYNC() do { XcdBarrier xb_; xb_.bar = (unsigned*)(a.ws + WS_CTL) + 4096; xb_.x = xb_xcc_id(); xb_.st = (volatile XLAS unsigned*)((XLAS unsigned char*)lds + (LDS_BYTES - 32)); xcd_barrier(xb_); } while (0)
  const f16* P = (const f16*)(a.ws + WS_P);
  ph_modv(a, lds); __syncthreads(); ph_convert(a, 0, lds, 3);
  GRID_SYNC();
#pragma unroll 1
  for (int l = 0; l < DEPTH; ++l) {
    if (l > 0) { ph_convert(a, l, lds, 2); __syncthreads(); }
    ph_norm(a, l, lds);
    GRID_SYNC();
    { pg8::Gemm g{(const f16*)(a.ws + WS_H), (const f16*)(a.ws + WS_WIN), D, D, D, 1 << 20, 0}; pg8::StaticOrder So; So.init(M, NT_RW * 256, gridDim.x, lbid());
      pg8::gemm_phase((PG8_LAS unsigned char*)lds, g, So, pg8::EpiP{(f16*)(a.ws + WS_P), 0}); }
    GRID_SYNC();
    ph_prep(a, l, lds, 1);
    asm volatile("s_waitcnt vmcnt(0)" ::: "memory"); __syncthreads();
    if (ltid() == 0) { __builtin_amdgcn_fence(__ATOMIC_RELEASE, "agent"); (void)xb_add((unsigned*)(a.ws + WS_CTL) + 1024 + 64 * l + 32, 1u); }
    ph_mix(a, l, lds);
    GRID_SYNC();
    ph_post(a, l, 1);
    GRID_SYNC();
    { pg8::Gemm g{(const f16*)(a.ws + WS_Y), (const f16*)(a.ws + WS_WBR), 3072, BR, BR, 8, 1024}; pg8::StaticOrder So; So.init(MFULL, D, gridDim.x, lbid());
      pg8::gemm_phase((PG8_LAS unsigned char*)lds, g, So, pg8::EpiBr{(f16*)(a.ws + WS_G3), (f16*)(a.ws + WS_G3B), P, (f16*)(a.ws + WS_MRG)});
      tail_gemm((const f16*)(a.ws + WS_Y), 3072, (const f16*)(a.ws + WS_WBR), BR, MFULL, M - MFULL, D, BR, lds, EpiBranchMerge{(f16*)(a.ws + WS_MRG), (const f16*)(a.ws + WS_G3B), P}); }
    GRID_SYNC();
    { pg8::Gemm g{(const f16*)(a.ws + WS_MRG), (const f16*)(a.ws + WS_WOUT), D, D, D, 1 << 20, 0}; pg8::StaticOrder So; So.init(MFULL, D, gridDim.x, lbid());
      pg8::gemm_phase((PG8_LAS unsigned char*)lds, g, So, pg8::EpiZ{a, l});
      tail_gemm((const f16*)(a.ws + WS_MRG), D, (const f16*)(a.ws + WS_WOUT), D, MFULL, M - MFULL, D, D, lds, EpiOut{a, l}); }
    GRID_SYNC();
  }
  ph_final(a);
}

extern "C" void kernel_launch(void* const* d_in, const int* in_sizes, int n_in, void* d_out, int out_size, void* d_ws, size_t ws_size, hipStream_t stream) {
  static int grid_blocks = 0;
  if (grid_blocks == 0) {
    if (n_in != 25 || out_size != BATCH * SEQ * D || ws_size < WS_END) { fprintf(stderr, "kernel_launch: bad shapes n_in %d out %d ws %zu (need %zu)\n", n_in, out_size, ws_size, (size_t)WS_END); grid_blocks = -1; return; }
    if (hipFuncSetAttribute((const void*)mega, hipFuncAttributeMaxDynamicSharedMemorySize, LDS_BYTES) != hipSuccess) { fprintf(stderr, "kernel_launch: LDS attribute failed\n"); grid_blocks = -1; return; }
    int dev = 0, cus = 0, per_cu = 0;
    hipGetDevice(&dev); hipDeviceGetAttribute(&cus, hipDeviceAttributeMultiprocessorCount, dev);
    if (hipOccupancyMaxActiveBlocksPerMultiprocessor(&per_cu, (const void*)mega, NT, LDS_BYTES) != hipSuccess || per_cu < 1) { fprintf(stderr, "kernel_launch: occupancy query says %d\n", per_cu); (void)hipGetLastError(); per_cu = 1; }
    grid_blocks = cus * 1;
    fprintf(stderr, "kernel_launch: cus %d per_cu %d grid %d\n", cus, per_cu, grid_blocks);
  }
  if (grid_blocks < 0) return;
  (void)hipMemsetAsync((char*)d_ws + WS_CTL, 0, 65536, stream);
  Args a{};
  for (int i = 0; i < 25; ++i) a.in[i] = (const float*)d_in[i];
  a.out = (float*)d_out; a.ws = (unsigned char*)d_ws;
  hipLaunchKernelGGL(mega, dim3(grid_blocks), dim3(NT), LDS_BYTES, stream, a);
  const hipError_t e = hipPeekAtLastError();
  if (e != hipSuccess) fprintf(stderr, "launch failed: %s (grid %d)\n", hipGetErrorString(e), grid_blocks);
}
```
